# Optimizing an MI355X kernel written in HIP

```python
import jax, jax.numpy as jnp
from jax import lax
import numpy as np

D_MODEL = 1024
BATCH = 16
SEQ = 2048
DEPTH = 1
DEC_BATCH = 16
DEC_SEQ = 16
PAST_LEN = 1024

CHUNK = 64
EPS = 1e-6
A_CHUNK = 128
A_GROUPS = 8
A_WIDTH = D_MODEL
A_GDIM = A_WIDTH // A_GROUPS
B_HEADS = 4
B_DK = 256
B_DV = 512
B_QK = B_HEADS * B_DK
B_V = B_HEADS * B_DV
ROPE_BASE = 10000.0
SPLITS = (A_WIDTH, 2 * A_WIDTH, 2 * A_WIDTH + B_QK, 2 * A_WIDTH + 2 * B_QK,
          2 * A_WIDTH + 2 * B_QK + B_V, 2 * A_WIDTH + 2 * B_QK + 2 * B_V)
IN_COLS = 2 * A_WIDTH + 2 * B_QK + 2 * B_V + 2 * D_MODEL
P_HEADS = 8
P_NKEYS = 128
P_EXPERTS = P_NKEYS * P_NKEYS
P_DKEY = 256
P_HALF = P_DKEY // 2
P_TOPK = 16
P_BLOCK = 256

kernel_name = "hybrid_sgu_retention_peer_stream_step"


def rmsnorm(x, g):
    xf = x.astype(jnp.float32)
    y = xf * lax.rsqrt(jnp.mean(xf * xf, axis=-1, keepdims=True) + EPS)
    return (y * g.astype(jnp.float32)).astype(x.dtype)


def _rms(x):
    xf = x.astype(jnp.float32)
    return (xf * lax.rsqrt(jnp.mean(xf * xf, axis=-1, keepdims=True) + EPS)).astype(x.dtype)


def _log_gamma():
    return jnp.log(1.0 - 2.0 ** (-5.0 - jnp.arange(B_HEADS, dtype=jnp.float32)))


def _rotary(x, pos):
    half = B_DK // 2
    inv = 1.0 / (ROPE_BASE ** jnp.linspace(0.0, 1.0, half, dtype=jnp.float32))
    ang = pos.astype(jnp.float32)[:, None] * inv[None, :]
    cos, sin = jnp.cos(ang), jnp.sin(ang)
    x1 = x[..., :half].astype(jnp.float32)
    x2 = x[..., half:].astype(jnp.float32)
    return jnp.concatenate([x1 * cos - x2 * sin, x1 * sin + x2 * cos], axis=-1).astype(x.dtype)


def _retention_block(q, k, v, s, log_g):
    L = q.shape[2]
    dt = q.dtype
    idx = jnp.arange(L, dtype=jnp.float32)
    diff = idx[:, None] - idx[None, :]
    lg = log_g[:, None]
    decay = jnp.where(diff[None] >= 0.0, jnp.exp(lg[:, :, None] * jnp.maximum(diff, 0.0)[None]), 0.0).astype(dt)
    scores = jnp.einsum('bhnd,bhmd->bhnm', q, k) * decay
    out = jnp.einsum('bhnm,bhmv->bhnv', scores, v)
    q_dec = jnp.exp(lg * (idx + 1.0)).astype(dt)
    out = out + jnp.einsum('bhnd,bhdv->bhnv', q * q_dec[None, :, :, None], s)
    k_dec = jnp.exp(lg * (L - 1.0 - idx)).astype(dt)
    s_new = jnp.exp(log_g * L).astype(dt)[None, :, None, None] * s + jnp.einsum(
        'bhmd,bhmv->bhdv', k * k_dec[None, :, :, None], v)
    return out, s_new


def _mixer(h, pos0, s0, log_g, w_in, w_s, b_s, g_sgu, w_proj_a, w_proj_b, b_gate, w_out):
    B, L, _ = h.shape
    z = h @ w_in
    u_a, v_a, q, k, v, g, gate = jnp.split(z, SPLITS, axis=-1)
    u_a = jax.nn.gelu(u_a)
    v_a = rmsnorm(jax.nn.gelu(v_a), g_sgu)
    ac = min(L, A_CHUNK)
    nc = L // ac
    vr = v_a.reshape(B, nc, ac, A_GROUPS, A_GDIM)
    ws = w_s[:, :ac, :ac] * jnp.tril(jnp.ones((ac, ac), h.dtype))[None]
    mixed = jnp.einsum('gnm,bcmgd->bcngd', ws, vr) + b_s[:, :ac].T[None, None, :, :, None]
    y_a = u_a * mixed.reshape(B, L, A_WIDTH)
    pos = pos0 + jnp.arange(L)
    qh = _rotary(q.reshape(B, L, B_HEADS, B_DK).transpose(0, 2, 1, 3), pos)
    kh = _rotary(k.reshape(B, L, B_HEADS, B_DK).transpose(0, 2, 1, 3), pos) * (B_DK ** -0.5)
    vh = v.reshape(B, L, B_HEADS, B_DV).transpose(0, 2, 1, 3)
    c = min(L, CHUNK)
    ncb = L // c
    to_blocks = lambda t: t.reshape(B, B_HEADS, ncb, c, t.shape[-1]).transpose(2, 0, 1, 3, 4)

    def step(s, blk):
        qc, kc, vc = blk
        o, s = _retention_block(qc, kc, vc, s, log_g)
        return s, o

    s_new, o = lax.scan(step, s0.astype(h.dtype), (to_blocks(qh), to_blocks(kh), to_blocks(vh)))
    o = o.transpose(1, 2, 0, 3, 4).reshape(B, B_HEADS, L, B_DV)
    o = _rms(o).transpose(0, 2, 1, 3).reshape(B, L, B_V)
    y_b = jax.nn.silu(g) * o
    gates = jax.nn.sigmoid(gate + b_gate)
    g_a, g_b = jnp.split(gates, 2, axis=-1)
    m = g_a * (y_a @ w_proj_a) + g_b * (y_b @ w_proj_b)
    return m @ w_out, s_new, v_a


def _peer_block(t, w_query, k1, k2, eu, ev):
    T = t.shape[0]
    q = (t @ w_query).reshape(T, P_HEADS, P_DKEY)
    s1 = jnp.einsum('thd,nd->thn', q[..., :P_HALF], k1).astype(jnp.float32)
    s2 = jnp.einsum('thd,nd->thn', q[..., P_HALF:], k2).astype(jnp.float32)
    v1, i1 = lax.top_k(s1, P_TOPK)
    v2, i2 = lax.top_k(s2, P_TOPK)
    cand = (v1[..., :, None] + v2[..., None, :]).reshape(T, P_HEADS, P_TOPK * P_TOPK)
    vals, flat = lax.top_k(cand, P_TOPK)
    e1 = jnp.take_along_axis(i1, flat // P_TOPK, axis=-1)
    e2 = jnp.take_along_axis(i2, flat % P_TOPK, axis=-1)
    experts = e1 * P_NKEYS + e2
    w = jax.nn.softmax(vals, axis=-1).astype(t.dtype)
    a = jax.nn.gelu(jnp.einsum('td,thkd->thk', t, eu[experts]))
    return jnp.einsum('thk,thkd->td', w * a, ev[experts])


def _peer(h, w_query, k1, k2, eu, ev):
    B, L, D = h.shape
    n = B * L
    blk = min(P_BLOCK, n)
    pad = (-n) % blk
    t = jnp.pad(h.reshape(n, D), ((0, pad), (0, 0))).reshape(-1, blk, D)
    out = lax.map(lambda tb: _peer_block(tb, w_query, k1, k2, eu, ev), t)
    return out.reshape(-1, D)[:n].reshape(B, L, D)


def _layer(x, pos0, s0, log_g, w_in, w_s, b_s, g_sgu, w_proj_a, w_proj_b, b_gate, w_out,
           g_mix, g_ffn, w_query, k1, k2, eu, ev):
    m, s_new, v_a = _mixer(rmsnorm(x, g_mix), pos0, s0, log_g, w_in, w_s, b_s, g_sgu,
                           w_proj_a, w_proj_b, b_gate, w_out)
    x = x + m
    x = x + _peer(rmsnorm(x, g_ffn), w_query, k1, k2, eu, ev)
    return x, s_new, v_a


def setup_inputs(seed: int = 0) -> dict:
    key = jax.random.key(seed)
    ks = jax.random.split(key, 21)
    f = jnp.float32
    nrm = lambda k, shape, scale: jax.random.normal(k, shape, f) * scale
    return {
        "x_prompt": nrm(ks[0], (BATCH, SEQ, D_MODEL), 1.0),
        "x_sample": nrm(ks[1], (DEC_BATCH, DEC_SEQ, D_MODEL), 1.0),
        "state_ret": nrm(ks[2], (DEPTH, DEC_BATCH, B_HEADS, B_DK, B_DV), 0.1),
        "w_in": nrm(ks[3], (DEPTH, D_MODEL, IN_COLS), D_MODEL ** -0.5),
        "w_s": nrm(ks[4], (DEPTH, A_GROUPS, A_CHUNK, A_CHUNK), A_CHUNK ** -0.5),
        "b_s": 1.0 + nrm(ks[5], (DEPTH, A_GROUPS, A_CHUNK), 0.02),
        "g_sgu": 1.0 + nrm(ks[6], (DEPTH, A_WIDTH), 0.02),
        "w_proj_a": nrm(ks[7], (DEPTH, A_WIDTH, D_MODEL), A_WIDTH ** -0.5),
        "w_proj_b": nrm(ks[8], (DEPTH, B_V, D_MODEL), B_V ** -0.5),
        "b_gate": nrm(ks[9], (DEPTH, 2 * D_MODEL), 0.01),
        "w_out": nrm(ks[10], (DEPTH, D_MODEL, D_MODEL), D_MODEL ** -0.5),
        "g_mix": 1.0 + nrm(ks[11], (DEPTH, D_MODEL), 0.02),
        "g_ffn": 1.0 + nrm(ks[12], (DEPTH, D_MODEL), 0.02),
        "w_query": nrm(ks[13], (DEPTH, D_MODEL, P_HEADS * P_DKEY), D_MODEL ** -0.5),
        "sub_keys_1": nrm(ks[14], (DEPTH, P_NKEYS, P_HALF), P_HALF ** -0.5),
        "sub_keys_2": nrm(ks[15], (DEPTH, P_NKEYS, P_HALF), P_HALF ** -0.5),
        "expert_u": nrm(ks[16], (DEPTH, P_EXPERTS, D_MODEL), D_MODEL ** -0.5),
        "expert_v": nrm(ks[17], (DEPTH, P_EXPERTS, D_MODEL), D_MODEL ** -0.5),
        "g_final": 1.0 + nrm(ks[18], (D_MODEL,), 0.02),
    }


def reference(x_prompt, x_sample, state_ret, w_in, w_s, b_s, g_sgu, w_proj_a, w_proj_b, b_gate,
              w_out, g_mix, g_ffn, w_query, sub_keys_1, sub_keys_2, expert_u, expert_v, g_final):
    log_g = _log_gamma()
    xp, xs = x_prompt, x_sample
    sp_list, ss_list, v_list = [], [], []
    for l in range(DEPTH):
        p = (w_in[l], w_s[l], b_s[l], g_sgu[l], w_proj_a[l], w_proj_b[l], b_gate[l], w_out[l],
             g_mix[l], g_ffn[l], w_query[l], sub_keys_1[l], sub_keys_2[l], expert_u[l], expert_v[l])
        s0p = jnp.zeros((xp.shape[0], B_HEADS, B_DK, B_DV), xp.dtype)
        xp, sp, _ = _layer(xp, 0, s0p, log_g, *p)
        xs, ss, vs = _layer(xs, PAST_LEN, state_ret[l], log_g, *p)
        sp_list.append(sp)
        ss_list.append(ss)
        v_list.append(vs)
    y_prompt = rmsnorm(xp, g_final)
    y_sample = rmsnorm(xs, g_final)
    state_ret_prompt = jnp.stack(sp_list)
    state_ret_sample = jnp.stack(ss_list)
    sgu_v_sample = jnp.stack(v_list)
    return (y_prompt, y_sample, state_ret_prompt, state_ret_sample, sgu_v_sample)
```

```cpp
#include <hip/hip_runtime.h>
#include <hip/hip_cooperative_groups.h>
#include <cstdio>
#include <cstring>
namespace cg = cooperative_groups;

#ifndef ONE_LAUNCH
#define ONE_LAUNCH 1
#endif

#define LAS __attribute__((address_space(3)))
typedef unsigned short bf16_t;
typedef short bf16x8 __attribute__((ext_vector_type(8)));
typedef float f32x4 __attribute__((ext_vector_type(4)));
typedef unsigned u32x4 __attribute__((ext_vector_type(4)));
typedef unsigned u32x2 __attribute__((ext_vector_type(2)));
typedef __bf16 bf16x2_t __attribute__((ext_vector_type(2)));

constexpr int DM = 1024, NTOK = 33024, NH0 = 16640, INC = 10240;
constexpr float EPS = 1e-6f;
constexpr int LDS_BYTES = 153600;
constexpr float EU_SCALE = 64.f, EV_SCALE = 64.f;

constexpr size_t OFF_WIN = 0;
constexpr size_t OFF_WA  = OFF_WIN + (size_t)10240 * 1024 * 2;
constexpr size_t OFF_WB  = OFF_WA + (size_t)1024 * 1024 * 2;
constexpr size_t OFF_WO  = OFF_WB + (size_t)1024 * 2048 * 2;
constexpr size_t OFF_WQ  = OFF_WO + (size_t)1024 * 1024 * 2;
constexpr size_t OFF_EU  = OFF_WQ + (size_t)2048 * 1024 * 2;
constexpr size_t OFF_EV  = OFF_EU + (size_t)16384 * 1024 * 2;
constexpr size_t OFF_K1  = OFF_EV + (size_t)16384 * 1024 * 2;
constexpr size_t OFF_K2  = OFF_K1 + 32768;
constexpr size_t OFF_M1  = OFF_K2 + 32768;
constexpr size_t OFF_R1  = OFF_M1 + (size_t)NTOK * 1024 * 2;
constexpr size_t OFF_SSV = OFF_R1 + (size_t)NTOK * 4;
constexpr size_t OFF_SS2 = OFF_SSV + (size_t)NTOK * 4;
constexpr size_t OFF_SSO = OFF_SS2 + (size_t)NTOK * 4;
constexpr size_t OFF_Z   = OFF_SSO + (size_t)NTOK * 16;
constexpr size_t Z_BYTES = (size_t)NH0 * INC * 2;
constexpr size_t OFF_BAR = OFF_Z + Z_BYTES;
constexpr size_t WS_NEED = OFF_BAR + 256;
constexpr size_t OFF_X2B = OFF_Z;
constexpr size_t OFF_QP  = OFF_X2B + (size_t)NTOK * 1024 * 2;
constexpr size_t OFF_IDS = OFF_QP + (size_t)NTOK * 2048 * 2;
constexpr size_t OFF_WTS = OFF_IDS + (size_t)NTOK * 128 * 4;
constexpr size_t OUT_XB = 0;
constexpr size_t OUT_T1 = (size_t)NTOK * 1024 * 2;
constexpr size_t O_YP = 0, O_YS = (size_t)32768 * 1024, O_SP = O_YS + (size_t)256 * 1024, O_SS = O_SP + (size_t)16 * 4 * 256 * 512,
                 O_SV = O_SS + (size_t)16 * 4 * 256 * 512;

struct Params {
    const float *xp, *xs, *state, *w_in, *w_s, *b_s, *g_sgu, *w_pa, *w_pb, *b_gate, *w_out, *g_mix, *g_ffn, *w_q, *k1, *k2, *eu, *ev, *g_final;
    float* out;
    unsigned char* ws;
};

struct Ctx { int tid, bid, nb; };

__device__ __forceinline__ float bf_lo(unsigned u) { return __uint_as_float(u << 16); }
__device__ __forceinline__ float bf_hi(unsigned u) { return __uint_as_float(u & 0xffff0000u); }
typedef float f32x2 __attribute__((ext_vector_type(2)));
__device__ __forceinline__ unsigned pk_bf16(float lo, float hi) {
    f32x2 v = {lo, hi}; bf16x2_t b = __builtin_convertvector(v, bf16x2_t); return __builtin_bit_cast(unsigned, b);
}
__device__ __forceinline__ bf16_t f2bf(float f) { return (bf16_t)(pk_bf16(f, 0.f) & 0xffffu); }
__device__ __forceinline__ float fexp2(float x) { return __builtin_amdgcn_exp2f(x); }
__device__ __forceinline__ float frcp(float x) { return __builtin_amdgcn_rcpf(x); }
__device__ __forceinline__ float sigm(float x) { return frcp(1.f + fexp2(-1.44269504f * x)); }
__device__ __forceinline__ float gelu_t(float x) { const float u = 0.7978845608f * (x + 0.044715f * x * x * x); return x * frcp(1.f + fexp2(-2.88539008f * u)); }
__device__ __forceinline__ float rsq(float x) { return __builtin_amdgcn_rsqf(x); }
__device__ __forceinline__ const float* xrow(const Params& p, int ir) {
    return ir < 16384 ? p.xp + (size_t)ir * 1024 : (ir < 16640 ? p.xs + (size_t)(ir - 16384) * 1024 : p.xp + (size_t)(ir - 256) * 1024);
}
__device__ __forceinline__ float* yrow(const Params& p, int ir) {
    return ir < 16384 ? p.out + O_YP + (size_t)ir * 1024 : (ir < 16640 ? p.out + O_YS + (size_t)(ir - 16384) * 1024 : p.out + O_YP + (size_t)(ir - 256) * 1024);
}
__device__ __forceinline__ float shx(float v, int m, int lane) { return __int_as_float(__builtin_amdgcn_ds_bpermute((lane ^ m) << 2, __float_as_int(v))); }
__device__ __forceinline__ float shl_(float v, int src) { return __int_as_float(__builtin_amdgcn_ds_bpermute(src << 2, __float_as_int(v))); }
__device__ __forceinline__ int shl_(int v, int src) { return __builtin_amdgcn_ds_bpermute(src << 2, v); }
__device__ __forceinline__ float wave_sum(float v, int lane) {
#pragma unroll
    for (int o = 32; o >= 1; o >>= 1) v += shx(v, o, lane);
    return v;
}
__device__ __forceinline__ float row16_sum(float s) {
    s += __int_as_float(__builtin_amdgcn_update_dpp(0, __float_as_int(s), 0xB1, 0xF, 0xF, true));
    s += __int_as_float(__builtin_amdgcn_update_dpp(0, __float_as_int(s), 0x4E, 0xF, 0xF, true));
    s += __int_as_float(__builtin_amdgcn_update_dpp(0, __float_as_int(s), 0x141, 0xF, 0xF, true));
    s += __int_as_float(__builtin_amdgcn_update_dpp(0, __float_as_int(s), 0x140, 0xF, 0xF, true));
    return s;
}
__device__ __forceinline__ float dot2bf(unsigned a, unsigned b, float c) {
    return __builtin_amdgcn_fdot2_f32_bf16(__builtin_bit_cast(bf16x2_t, a), __builtin_bit_cast(bf16x2_t, b), c, false);
}
typedef short s16x4 __attribute__((ext_vector_type(4)));
__device__ __forceinline__ bf16x8 tr_frag(const LAS bf16_t* tile, int stride, int lane) {
    const LAS bf16_t* a0 = tile + (8 * (lane >> 4) + ((lane >> 2) & 3)) * stride + 4 * (lane & 3);
    const s16x4 lo = __builtin_amdgcn_ds_read_tr16_b64_v4i16((LAS s16x4*)a0), hi = __builtin_amdgcn_ds_read_tr16_b64_v4i16((LAS s16x4*)(a0 + 4 * stride));
    return (bf16x8){lo[0], lo[1], lo[2], lo[3], hi[0], hi[1], hi[2], hi[3]};
}
#define MFMA16(a, b, c) __builtin_amdgcn_mfma_f32_16x16x32_bf16((a), (b), (c), 0, 0, 0)

namespace pg8 {
constexpr int BM = 256, BK = 64, HALF = 128, HTB = HALF * BK * 2, STAGE_BYTES = 8 * HTB, NXCD = 8, WGM = 8;
__device__ __forceinline__ int lds_byte(int r, int c) { const int st = (r >> 4) * 2 + (c >> 5), rr = r & 15, cc = c & 31, ob = rr * 64 + cc * 2; return st * 1024 + (ob ^ (((ob >> 9) & 1) << 5)); }
__device__ __forceinline__ void stage_rc(int b, int& R, int& C) { const int st = b / 1024, sb = b % 1024, swz = sb ^ (((sb >> 9) & 1) << 5); R = (st >> 1) * 16 + swz / 64; C = (st & 1) * 32 + (swz % 64) / 2; }
__device__ __forceinline__ int perm32(int rho) { const int n = rho >> 4, i = rho & 15; return 8 * (i >> 2) + 4 * n + (i & 3); }
struct Unit { int pm, pn; };
struct Gemm { const bf16_t* A; const bf16_t* Bt; int lda, ldb, K; };
struct StaticOrder {
    int nM, nN, nwg, G, c, skip;
    __device__ void init(int nM_, int nN_, int G_, int c_, int skip_ = 1 << 30) { nM = nM_; nN = nN_; nwg = nM * nN; G = G_; c = c_; skip = skip_; }
    __device__ bool next(int i, Unit& u) const {
        const long L = (long)i * G + c; if (L >= nwg) return false;
        int wgid = (int)L; { const int q = nwg / NXCD, r = nwg % NXCD, xcd = wgid % NXCD, off = wgid / NXCD; wgid = (xcd < r ? xcd * (q + 1) : r * (q + 1) + (xcd - r) * q) + off; }
        const int nig = WGM * nN, gid = wgid / nig, fm = gid * WGM, gsz = (nM - fm) < WGM ? (nM - fm) : WGM;
        u.pm = fm + ((wgid % nig) % gsz); u.pn = (wgid % nig) / gsz; if (u.pm >= skip) ++u.pm; return true;
    }
};

template <class Epi>
__device__ __forceinline__ void gemm_phase(const Ctx& cx, LAS unsigned char* lds, const Gemm g, const StaticOrder& S, const Epi& E) {
    const int tid = cx.tid, wid = __builtin_amdgcn_readfirstlane(tid >> 6), lane = tid & 63, wr = wid >> 2, wc = wid & 3, fr = lane & 15, fq = lane >> 4;
    const int K = g.K, nt = K / BK;
    unsigned voffA[2], voffB[2];
#pragma unroll
    for (int i = 0; i < 2; ++i) { int R, C; stage_rc(tid * 16 + i * 8192, R, C); const int Rb = (R & ~31) + perm32(R & 31);
        voffA[i] = (unsigned)(R * g.lda + C) * 2u; voffB[i] = (unsigned)(Rb * g.ldb + C) * 2u; }
    const size_t kstep = (size_t)(BK * 2);
    const size_t hstepA = (size_t)HALF * g.lda * 2, hstepB = (size_t)HALF * g.ldb * 2;
    const size_t tstepA = 2 * hstepA, tstepB = 2 * hstepB;
    const unsigned ldsw = (unsigned)wid * 1024u;
    const int aoff = lds_byte(wr * 64 + fr, fq * 8), boff = lds_byte(wc * 32 + fr, fq * 8);
#define PG8_SA(b, h) (((b) * 2 + (h)) * HTB)
#define PG8_SB(b, h) ((4 + (b) * 2 + (h)) * HTB)
#define PG8_STAGE(bufoff, gbase, voff) do { _Pragma("unroll") for (int _i = 0; _i < 2; ++_i) \
        __builtin_amdgcn_global_load_lds((const unsigned*)((const char*)(gbase) + (voff)[_i]), (LAS unsigned*)(lds + (bufoff) + ldsw + _i * 8192), 16, 0, 0); } while (0)
#define PG8_LDA(dst, b, h) do { _Pragma("unroll") for (int m = 0; m < 4; ++m) _Pragma("unroll") for (int k = 0; k < 2; ++k) dst[m][k] = *(const LAS bf16x8*)(lds + PG8_SA(b, h) + aoff + m * 2048 + k * 1024); } while (0)
#define PG8_LDB(dst, b, h) do { _Pragma("unroll") for (int n = 0; n < 2; ++n) _Pragma("unroll") for (int k = 0; k < 2; ++k) dst[n][k] = *(const LAS bf16x8*)(lds + PG8_SB(b, h) + boff + n * 2048 + k * 1024); } while (0)
#define PG8_MMA(ai, bj, At, Bt) do { __builtin_amdgcn_s_setprio(1); _Pragma("unroll") for (int m = 0; m < 4; ++m) _Pragma("unroll") for (int n = 0; n < 2; ++n) _Pragma("unroll") for (int k = 0; k < 2; ++k) \
        acc[ai][bj][m][n] = __builtin_amdgcn_mfma_f32_16x16x32_bf16(Bt[n][k], At[m][k], acc[ai][bj][m][n], 0, 0, 0); __builtin_amdgcn_s_setprio(0); } while (0)
#define PG8_WAIT_V(n) asm volatile("s_waitcnt vmcnt(" #n ")" ::: "memory")
#define PG8_WAIT_L(n) asm volatile("s_waitcnt lgkmcnt(" #n ")" ::: "memory")
#define PG8_BAR __builtin_amdgcn_s_barrier()
#define PG8_SCHED __builtin_amdgcn_sched_barrier(0)
    Unit cur, nxt; int ui = 0;
    if (!S.next(0, cur)) return;
    f32x4 acc[2][2][4][2];
#pragma unroll
    for (int a = 0; a < 2; ++a)
#pragma unroll
        for (int b = 0; b < 2; ++b)
#pragma unroll
            for (int m = 0; m < 4; ++m)
#pragma unroll
                for (int n = 0; n < 2; ++n) acc[a][b][m][n] = (f32x4){0.f, 0.f, 0.f, 0.f};
    bf16x8 At[4][2], B0[2][2], B1[2][2];
    const char* cA = (const char*)g.A + (size_t)cur.pm * tstepA; const char* cB = (const char*)g.Bt + (size_t)cur.pn * tstepB;
    if constexpr (Epi::RESCALE) E.prep((LAS float*)(lds + STAGE_BYTES), cur, tid);
    PG8_STAGE(PG8_SB(0, 0), cB, voffB); PG8_STAGE(PG8_SA(0, 0), cA, voffA); PG8_STAGE(PG8_SB(0, 1), cB + hstepB, voffB); PG8_STAGE(PG8_SA(0, 1), cA + hstepA, voffA);
    if (wr == 1) PG8_BAR;
    PG8_WAIT_V(4); PG8_BAR;
    PG8_STAGE(PG8_SB(1, 0), cB + kstep, voffB); PG8_STAGE(PG8_SA(1, 0), cA + kstep, voffA); PG8_STAGE(PG8_SB(1, 1), cB + hstepB + kstep, voffB);
    PG8_WAIT_V(6); PG8_BAR;
    for (;;) {
        const bool has_next = S.next(ui + 1, nxt);
        if constexpr (Epi::RESCALE) { if (has_next) E.prep((LAS float*)(lds + STAGE_BYTES) + ((ui + 1) & 1) * 1024, nxt, tid); }
        const char* nA = has_next ? (const char*)g.A + (size_t)nxt.pm * tstepA : cA; const char* nB = has_next ? (const char*)g.Bt + (size_t)nxt.pn * tstepB : cB;
        for (int t = 0; t < nt; t += 2) {
            const bool last = (t == nt - 2);
            const char* a1 = cA + (size_t)(t + 1) * kstep;
            const char* a2 = last ? nA : cA + (size_t)(t + 2) * kstep; const char* b2 = last ? nB : cB + (size_t)(t + 2) * kstep;
            const char* a3 = a2 + kstep; const char* b3 = b2 + kstep;
            PG8_LDB(B0, 0, 0); PG8_SCHED; PG8_LDA(At, 0, 0); PG8_STAGE(PG8_SA(1, 1), a1 + hstepA, voffA);
            PG8_WAIT_L(8); PG8_BAR; PG8_WAIT_L(0); PG8_MMA(0, 0, At, B0); PG8_BAR; PG8_SCHED;
            PG8_LDB(B1, 0, 1); PG8_STAGE(PG8_SB(0, 0), b2, voffB);
            PG8_BAR; PG8_WAIT_L(0); PG8_MMA(0, 1, At, B1); PG8_BAR;
            PG8_LDA(At, 0, 1); PG8_STAGE(PG8_SA(0, 0), a2, voffA);
            PG8_BAR; PG8_WAIT_L(0); PG8_MMA(1, 0, At, B0); PG8_BAR; PG8_SCHED;
            PG8_STAGE(PG8_SB(0, 1), b2 + hstepB, voffB);
            PG8_WAIT_V(6); PG8_BAR; PG8_MMA(1, 1, At, B1); PG8_BAR;
            PG8_LDB(B0, 1, 0); PG8_SCHED; PG8_LDA(At, 1, 0); PG8_STAGE(PG8_SA(0, 1), a2 + hstepA, voffA);
            PG8_WAIT_L(8); PG8_BAR; PG8_WAIT_L(0); PG8_MMA(0, 0, At, B0); PG8_BAR; PG8_SCHED;
            PG8_LDB(B1, 1, 1); PG8_STAGE(PG8_SB(1, 0), b3, voffB);
            PG8_BAR; PG8_WAIT_L(0); PG8_MMA(0, 1, At, B1); PG8_BAR;
            PG8_LDA(At, 1, 1); PG8_STAGE(PG8_SA(1, 0), a3, voffA);
            PG8_BAR; PG8_WAIT_L(0); PG8_MMA(1, 0, At, B0); PG8_BAR; PG8_SCHED;
            PG8_STAGE(PG8_SB(1, 1), b3 + hstepB, voffB);
            PG8_WAIT_V(6); PG8_BAR; PG8_MMA(1, 1, At, B1); PG8_BAR;
            if constexpr (Epi::RESCALE) { if (((t + 2) & 7) == 0 && t + 2 < nt) E.mid(acc, (const LAS float*)(lds + STAGE_BYTES) + (ui & 1) * 1024, ((t + 2) >> 3) - 1, wr, fr); }
        }
        if constexpr (Epi::RESCALE) E.fin(acc, (const LAS float*)(lds + STAGE_BYTES) + (ui & 1) * 1024, cur, wr, wc, fr, fq); else E(acc, cur, wr, wc, fr, fq);
        if (!has_next) break;
#pragma unroll
        for (int a = 0; a < 2; ++a)
#pragma unroll
            for (int b = 0; b < 2; ++b)
#pragma unroll
                for (int m = 0; m < 4; ++m)
#pragma unroll
                    for (int n = 0; n < 2; ++n) acc[a][b][m][n] = (f32x4){0.f, 0.f, 0.f, 0.f};
        cur = nxt; cA = nA; cB = nB; ++ui;
    }
    PG8_WAIT_V(0);
    if (wr == 0) PG8_BAR;
    PG8_BAR;
#undef PG8_SA
#undef PG8_SB
#undef PG8_STAGE
#undef PG8_LDA
#undef PG8_LDB
#undef PG8_MMA
#undef PG8_WAIT_V
#undef PG8_WAIT_L
#undef PG8_BAR
#undef PG8_SCHED
}
}
using pg8::Unit;

__device__ __forceinline__ u32x4 pack8(const float (&v)[8]) { return (u32x4){pk_bf16(v[0], v[1]), pk_bf16(v[2], v[3]), pk_bf16(v[4], v[5]), pk_bf16(v[6], v[7])}; }
__device__ __forceinline__ void unpack8(const u32x4 u, float (&v)[8]) {
#pragma unroll
    for (int q = 0; q < 4; ++q) { v[2 * q] = bf_lo(u[q]); v[2 * q + 1] = bf_hi(u[q]); }
}

struct EpiIn {
    static constexpr bool RESCALE = false;
    bf16_t* Z; const float* r1; float* ssv; const float* b_gate; int rowbase;
    __device__ __forceinline__ void operator()(const f32x4 (&acc)[2][2][4][2], const Unit& u, int wr, int wc, int fr, int fq) const {
        const int pn = u.pn, lane = fr + 16 * fq;
        const int kind = pn < 4 ? 0 : pn < 8 ? 1 : pn < 12 ? 2 : pn < 16 ? 3 : pn < 24 ? 4 : pn < 32 ? 5 : 6;
        const int row0 = u.pm * 256 + wr * 64 + fr, col0 = pn * 256 + wc * 32 + 8 * fq;
        if (kind == 2 || kind == 3) {
            const float ksc = kind == 3 ? 0.0625f : 1.f;
            float inv8[8];
#pragma unroll
            for (int e = 0; e < 8; ++e) inv8[e] = fexp2(-(float)(wc * 32 + 8 * fq + e) * (13.287712379549449f / 127.f)) * 0.15915494309189535f;
#pragma unroll
            for (int ai = 0; ai < 2; ++ai)
#pragma unroll
                for (int m = 0; m < 4; ++m) {
                    const int row = row0 + ai * 128 + m * 16, gr = rowbase + row;
                    const float pos = (float)(gr < 16384 ? (gr & 2047) : (gr < 16640 ? 1024 + ((gr - 16384) & 15) : ((gr - 16640) & 2047)));
                    float v0[8], v1[8], o0[8], o1[8];
#pragma unroll
                    for (int e = 0; e < 4; ++e) { v0[e] = acc[ai][0][m][0][e]; v0[4 + e] = acc[ai][0][m][1][e]; v1[e] = acc[ai][1][m][0][e]; v1[4 + e] = acc[ai][1][m][1][e]; }
#pragma unroll
                    for (int e = 0; e < 8; ++e) {
                        float t = pos * inv8[e]; t -= floorf(t);
                        const float sn = __builtin_amdgcn_sinf(t) * ksc, cs = __builtin_amdgcn_cosf(t) * ksc;
                        o0[e] = v0[e] * cs - v1[e] * sn; o1[e] = v0[e] * sn + v1[e] * cs;
                    }
                    *(u32x4*)(Z + (size_t)row * INC + col0) = pack8(o0); *(u32x4*)(Z + (size_t)row * INC + col0 + 128) = pack8(o1);
                }
            return;
        }
#pragma unroll
        for (int ai = 0; ai < 2; ++ai)
#pragma unroll
            for (int m = 0; m < 4; ++m) {
                const int row = row0 + ai * 128 + m * 16; float ss = 0.f;
#pragma unroll
                for (int bj = 0; bj < 2; ++bj) {
                    const int col = col0 + bj * 128; float v[8];
#pragma unroll
                    for (int e = 0; e < 4; ++e) { v[e] = acc[ai][bj][m][0][e]; v[4 + e] = acc[ai][bj][m][1][e]; }
                    if (kind == 0) {
#pragma unroll
                        for (int e = 0; e < 8; ++e) v[e] = gelu_t(v[e]);
                    } else if (kind == 1) {
#pragma unroll
                        for (int e = 0; e < 8; ++e) { v[e] = gelu_t(v[e]); ss += v[e] * v[e]; }
                    } else if (kind == 3) {
#pragma unroll
                        for (int e = 0; e < 8; ++e) v[e] *= 0.0625f;
                    } else if (kind == 5) {
#pragma unroll
                        for (int e = 0; e < 8; ++e) v[e] = v[e] * sigm(v[e]);
                    } else if (kind == 6) {
                        const f32x4 b0 = *(const f32x4*)(b_gate + col - 8192), b1 = *(const f32x4*)(b_gate + col - 8192 + 4);
#pragma unroll
                        for (int e = 0; e < 4; ++e) { v[e] = sigm(v[e] + b0[e]); v[4 + e] = sigm(v[4 + e] + b1[e]); }
                    }
                    *(u32x4*)(Z + (size_t)row * INC + col) = pack8(v);
                }
                if (kind == 1) { ss += shx(ss, 16, lane); ss += shx(ss, 32, lane); if (fq == 0) atomicAdd(ssv + rowbase + row, ss); }
            }
    }
};
struct EpiT1 {
    static constexpr bool RESCALE = false;
    bf16_t* T1; const bf16_t* Z;
    __device__ __forceinline__ void operator()(const f32x4 (&acc)[2][2][4][2], const Unit& u, int wr, int wc, int fr, int fq) const {
        const int row0 = u.pm * 256 + wr * 64 + fr, col0 = u.pn * 256 + wc * 32 + 8 * fq;
#pragma unroll
        for (int ai = 0; ai < 2; ++ai)
#pragma unroll
            for (int m = 0; m < 4; ++m) {
                const int row = row0 + ai * 128 + m * 16;
#pragma unroll
                for (int bj = 0; bj < 2; ++bj) {
                    const int col = col0 + bj * 128; float v[8], gt[8];
                    unpack8(*(const u32x4*)(Z + (size_t)row * INC + 8192 + col), gt);
#pragma unroll
                    for (int e = 0; e < 4; ++e) { v[e] = acc[ai][bj][m][0][e] * gt[e]; v[4 + e] = acc[ai][bj][m][1][e] * gt[4 + e]; }
                    *(u32x4*)(T1 + (size_t)row * 1024 + col) = pack8(v);
                }
            }
    }
};
struct EpiM1 {
    static constexpr bool RESCALE = true;
    const bf16_t* T1; const bf16_t* Z; bf16_t* M1; int rowbase; const float* sso;
    __device__ __forceinline__ void prep(LAS float* tab, const Unit& u, int tid) const {
        if (tid < 256) {
            const f32x4 sv = *(const f32x4*)(sso + (size_t)(rowbase + u.pm * 256 + tid) * 4);
            const float c0 = sv[0] * (1.f / 512.f) + EPS, c1 = sv[1] * (1.f / 512.f) + EPS, c2 = sv[2] * (1.f / 512.f) + EPS, c3 = sv[3] * (1.f / 512.f) + EPS;
            *(LAS f32x4*)(tab + tid * 4) = (f32x4){__builtin_sqrtf(c1 * frcp(c0)), __builtin_sqrtf(c2 * frcp(c1)), __builtin_sqrtf(c3 * frcp(c2)), rsq(c3)};
        }
    }
    __device__ __forceinline__ void mid(f32x4 (&acc)[2][2][4][2], const LAS float* tab, int seg, int wr, int fr) const {
#pragma unroll
        for (int ai = 0; ai < 2; ++ai)
#pragma unroll
            for (int m = 0; m < 4; ++m) {
                const float f = tab[(ai * 128 + wr * 64 + m * 16 + fr) * 4 + seg];
#pragma unroll
                for (int bj = 0; bj < 2; ++bj)
#pragma unroll
                    for (int n = 0; n < 2; ++n) acc[ai][bj][m][n] = acc[ai][bj][m][n] * f;
            }
    }
    __device__ __forceinline__ void operator()(const f32x4 (&acc)[2][2][4][2], const Unit& u, int wr, int wc, int fr, int fq) const {}
    __device__ __forceinline__ void fin(const f32x4 (&acc)[2][2][4][2], const LAS float* tab, const Unit& u, int wr, int wc, int fr, int fq) const {
        const int row0 = u.pm * 256 + wr * 64 + fr, col0 = u.pn * 256 + wc * 32 + 8 * fq;
#pragma unroll
        for (int ai = 0; ai < 2; ++ai)
#pragma unroll
            for (int m = 0; m < 4; ++m) {
                const int row = row0 + ai * 128 + m * 16; const float rn3 = tab[(ai * 128 + wr * 64 + m * 16 + fr) * 4 + 3];
#pragma unroll
                for (int bj = 0; bj < 2; ++bj) {
                    const int col = col0 + bj * 128; float v[8], gt[8], t1[8];
                    unpack8(*(const u32x4*)(Z + (size_t)row * INC + 9216 + col), gt);
                    unpack8(*(const u32x4*)(T1 + (size_t)row * 1024 + col), t1);
#pragma unroll
                    for (int e = 0; e < 4; ++e) { v[e] = t1[e] + acc[ai][bj][m][0][e] * rn3 * gt[e]; v[4 + e] = t1[4 + e] + acc[ai][bj][m][1][e] * rn3 * gt[4 + e]; }
                    *(u32x4*)(M1 + (size_t)(rowbase + row) * 1024 + col) = pack8(v);
                }
            }
    }
};
struct EpiX2 {
    static constexpr bool RESCALE = false;
    const float* xp; const float* xs; float* out; bf16_t* X2b; float* ss2;
    __device__ __forceinline__ void operator()(const f32x4 (&acc)[2][2][4][2], const Unit& u, int wr, int wc, int fr, int fq) const {
        const int row0 = u.pm * 256 + wr * 64 + fr, col0 = u.pn * 256 + wc * 32 + 8 * fq, lane = fr + 16 * fq;
#pragma unroll
        for (int ai = 0; ai < 2; ++ai)
#pragma unroll
            for (int m = 0; m < 4; ++m) {
                const int row = row0 + ai * 128 + m * 16;
                const float* xr = row < 16384 ? xp + (size_t)row * 1024 : (row < 16640 ? xs + (size_t)(row - 16384) * 1024 : xp + (size_t)(row - 256) * 1024);
                float* yr = row < 16384 ? out + O_YP + (size_t)row * 1024 : (row < 16640 ? out + O_YS + (size_t)(row - 16384) * 1024 : out + O_YP + (size_t)(row - 256) * 1024);
                float ss = 0.f;
#pragma unroll
                for (int bj = 0; bj < 2; ++bj) {
                    const int col = col0 + bj * 128; float v[8];
                    const f32x4 x0 = *(const f32x4*)(xr + col), x1 = *(const f32x4*)(xr + col + 4);
#pragma unroll
                    for (int e = 0; e < 4; ++e) { v[e] = acc[ai][bj][m][0][e] + x0[e]; v[4 + e] = acc[ai][bj][m][1][e] + x1[e]; }
#pragma unroll
                    for (int e = 0; e < 8; ++e) ss += v[e] * v[e];
                    *(f32x4*)(yr + col) = (f32x4){v[0], v[1], v[2], v[3]}; *(f32x4*)(yr + col + 4) = (f32x4){v[4], v[5], v[6], v[7]};
                    *(u32x4*)(X2b + (size_t)row * 1024 + col) = pack8(v);
                }
                ss += shx(ss, 16, lane); ss += shx(ss, 32, lane); if (fq == 0) atomicAdd(ss2 + row, ss);
            }
    }
};
struct EpiQP {
    static constexpr bool RESCALE = false;
    bf16_t* QP; const float* ss2;
    __device__ __forceinline__ void operator()(const f32x4 (&acc)[2][2][4][2], const Unit& u, int wr, int wc, int fr, int fq) const {
        const int row0 = u.pm * 256 + wr * 64 + fr, col0 = u.pn * 256 + wc * 32 + 8 * fq;
#pragma unroll
        for (int ai = 0; ai < 2; ++ai)
#pragma unroll
            for (int m = 0; m < 4; ++m) {
                const int row = row0 + ai * 128 + m * 16; const float rs = rsq(ss2[row] * (1.f / 1024.f) + EPS);
#pragma unroll
                for (int bj = 0; bj < 2; ++bj) {
                    const int col = col0 + bj * 128; float v[8];
#pragma unroll
                    for (int e = 0; e < 4; ++e) { v[e] = acc[ai][bj][m][0][e] * rs; v[4 + e] = acc[ai][bj][m][1][e] * rs; }
                    *(u32x4*)(QP + (size_t)row * 2048 + col) = pack8(v);
                }
            }
    }
};

__device__ __forceinline__ void convert_item(const Params& p, unsigned char* ws, size_t i) {
        const int d = (int)((i * 16) & 1023);
        unsigned ou[4], ov[4];
#pragma unroll
        for (int q = 0; q < 4; ++q) {
            const f32x4 a = *(const f32x4*)(p.eu + i * 16 + q * 4), g0 = *(const f32x4*)(p.g_ffn + d + q * 4), c = *(const f32x4*)(p.ev + i * 16 + q * 4);
            int u = __builtin_amdgcn_cvt_pk_fp8_f32(a[0] * g0[0] * EU_SCALE, a[1] * g0[1] * EU_SCALE, 0, false);
            u = __builtin_amdgcn_cvt_pk_fp8_f32(a[2] * g0[2] * EU_SCALE, a[3] * g0[3] * EU_SCALE, u, true);
            int v = __builtin_amdgcn_cvt_pk_fp8_f32(c[0] * EV_SCALE, c[1] * EV_SCALE, 0, false);
            v = __builtin_amdgcn_cvt_pk_fp8_f32(c[2] * EV_SCALE, c[3] * EV_SCALE, v, true);
            ou[q] = (unsigned)u; ov[q] = (unsigned)v;
        }
        *(u32x4*)(ws + OFF_EU + (i >> 6) * 2048 + (i & 63) * 16) = (u32x4){ou[0], ou[1], ou[2], ou[3]};
        *(u32x4*)(ws + OFF_EU + (i >> 6) * 2048 + 1024 + (i & 63) * 16) = (u32x4){ov[0], ov[1], ov[2], ov[3]};
    }
constexpr size_t CONV_ITEMS = (size_t)16384 * 64;

__device__ __forceinline__ void transpose_tile(const Ctx& cx, const float* src, bf16_t* dst, const float* scale, int K, int N, int tile, LAS float* tl) {
    const int tn = N / 64, k0 = (tile / tn) * 64, n0 = (tile % tn) * 64, tid = cx.tid;
    const int nn = tid & 63, kk0 = tid >> 6;
#pragma unroll
    for (int i = 0; i < 8; ++i) { const int kk = kk0 + 8 * i; float v = src[(size_t)(k0 + kk) * N + n0 + nn]; if (scale) v *= scale[k0 + kk]; tl[kk * 65 + nn] = v; }
    __syncthreads();
    const int kp = (tid & 31) * 2, nb = tid >> 5;
#pragma unroll
    for (int i = 0; i < 4; ++i) { const int n = nb + 16 * i; *(unsigned*)(dst + (size_t)(n0 + n) * K + k0 + kp) = pk_bf16(tl[kp * 65 + n], tl[(kp + 1) * 65 + n]); }
    __syncthreads();
}
__device__ __forceinline__ void phase0(const Ctx& cx, const Params& p, LAS unsigned char* lds) {
    unsigned char* ws = p.ws; LAS float* tl = (LAS float*)lds;
    for (int j = cx.bid; j < 4096; j += cx.nb) {
        if (j < 2560) transpose_tile(cx, p.w_in, (bf16_t*)(ws + OFF_WIN), p.g_mix, 1024, 10240, j, tl);
        else if (j < 2816) transpose_tile(cx, p.w_pa, (bf16_t*)(ws + OFF_WA), nullptr, 1024, 1024, j - 2560, tl);
        else if (j < 3328) transpose_tile(cx, p.w_pb, (bf16_t*)(ws + OFF_WB), nullptr, 2048, 1024, j - 2816, tl);
        else if (j < 3584) transpose_tile(cx, p.w_out, (bf16_t*)(ws + OFF_WO), nullptr, 1024, 1024, j - 3328, tl);
        else transpose_tile(cx, p.w_q, (bf16_t*)(ws + OFF_WQ), p.g_ffn, 1024, 2048, j - 3584, tl);
    }
    const size_t gtid = (size_t)cx.bid * 512 + cx.tid, nth = (size_t)cx.nb * 512;
    for (size_t i = gtid; i < 16384; i += nth) { ((bf16_t*)(ws + OFF_K1))[i] = f2bf(p.k1[i]); ((bf16_t*)(ws + OFF_K2))[i] = f2bf(p.k2[i]); }
    for (size_t i = gtid; i < (size_t)NTOK * 6; i += nth) ((float*)(ws + OFF_SSV))[i] = 0.f;
    const int wid = __builtin_amdgcn_readfirstlane(cx.tid >> 6), lane = cx.tid & 63;
    bf16_t* xb = (bf16_t*)((unsigned char*)p.out + OUT_XB);
    for (int r = cx.bid * 8 + wid; r < NTOK; r += cx.nb * 8) {
        const float* xr = xrow(p, r); f32x4 v[4]; float ss = 0.f;
#pragma unroll
        for (int j = 0; j < 4; ++j) { v[j] = *(const f32x4*)(xr + lane * 4 + j * 256); ss += v[j][0] * v[j][0] + v[j][1] * v[j][1] + v[j][2] * v[j][2] + v[j][3] * v[j][3]; }
        ss = wave_sum(ss, lane);
        const float rs = rsq(ss * (1.f / 1024.f) + EPS);
#pragma unroll
        for (int j = 0; j < 4; ++j) *(u32x2*)(xb + (size_t)r * 1024 + lane * 4 + j * 256) = (u32x2){pk_bf16(v[j][0] * rs, v[j][1] * rs), pk_bf16(v[j][2] * rs, v[j][3] * rs)};
    }
}

__device__ __forceinline__ void retention_unit(const Ctx& cx, LAS unsigned char* lds, bf16_t* Z, int zrow0, int grow0, int nchunks, int Lc, int pos0, int h, int slice,
                               const float* s0, float* s_out, float* sso) {
    LAS bf16_t* Qs = (LAS bf16_t*)lds; LAS bf16_t* Ks = (LAS bf16_t*)(lds + 33792); LAS bf16_t* ST = (LAS bf16_t*)(lds + 67584);
    LAS bf16_t* VT = (LAS bf16_t*)(lds + 101376); LAS bf16_t* Ps = (LAS bf16_t*)(lds + 110592);
    const int tid = cx.tid, wid = __builtin_amdgcn_readfirstlane(tid >> 6), lane = tid & 63, fr = lane & 15, fq = lane >> 4;
    const float l2g = log2f(1.f - exp2f(-5.f - (float)h));
    f32x4 accS[2][4];
#pragma unroll
    for (int dt = 0; dt < 2; ++dt)
#pragma unroll
        for (int dvt = 0; dvt < 4; ++dvt) {
#pragma unroll
            for (int j = 0; j < 4; ++j) { const int d = (2 * wid + dt) * 16 + fq * 4 + j; accS[dt][dvt][j] = s0 ? s0[(size_t)d * 512 + slice * 64 + dvt * 16 + fr] : 0.f; }
            *(LAS u32x2*)(ST + (dvt * 16 + fr) * 264 + (2 * wid + dt) * 16 + fq * 4) = (u32x2){pk_bf16(accS[dt][dvt][0], accS[dt][dvt][1]), pk_bf16(accS[dt][dvt][2], accS[dt][dvt][3])};
        }
    const float sdec = fexp2(l2g * (float)Lc);
    __syncthreads();
    u32x4 rq1[2], rq2[2], rk1[2], rk2[2], rv; u32x2 rsg[2];
    const int vm = tid >> 3, vc0 = (tid & 7) * 8;
    auto fetch = [&](int c) {
        const size_t zr = (size_t)(zrow0 + c * 64);
#pragma unroll
        for (int it = 0; it < 2; ++it) {
            const int item = tid + 512 * it, n = item >> 4, dc = (item & 15) * 8;
            rq1[it] = (u32x4){0, 0, 0, 0}; rq2[it] = rq1[it]; rk1[it] = rq1[it]; rk2[it] = rq1[it];
            if (n < Lc) {
                const bf16_t* zp = Z + (zr + n) * INC + 2048 + h * 256 + dc;
                rq1[it] = *(const u32x4*)zp; rq2[it] = *(const u32x4*)(zp + 128); rk1[it] = *(const u32x4*)(zp + 1024); rk2[it] = *(const u32x4*)(zp + 1152);
            }
        }
        rv = (u32x4){0, 0, 0, 0};
        if (vm < Lc) rv = *(const u32x4*)(Z + (zr + vm) * INC + 4096 + h * 512 + slice * 64 + vc0);
#pragma unroll
        for (int i = 0; i < 2; ++i) {
            rsg[i] = (u32x2){0, 0};
            const int n = (wid >> 1) * 16 + fr;
            if (n < Lc) rsg[i] = *(const u32x2*)(Z + (zr + n) * INC + 6144 + h * 512 + slice * 64 + (2 * (wid & 1) + i) * 16 + fq * 4);
        }
    };
    fetch(0);
    for (int c = 0; c < nchunks; ++c) {
        const size_t zr = (size_t)(zrow0 + c * 64);
#pragma unroll
        for (int it = 0; it < 2; ++it) {
            const int item = tid + 512 * it, n = item >> 4, dc = (item & 15) * 8;
            *(LAS u32x4*)(Qs + n * 264 + dc) = rq1[it]; *(LAS u32x4*)(Qs + n * 264 + 128 + dc) = rq2[it];
            *(LAS u32x4*)(Ks + n * 264 + dc) = rk1[it]; *(LAS u32x4*)(Ks + n * 264 + 128 + dc) = rk2[it];
        }
        {
            float v[8]; unpack8(rv, v);
            const float kd = fexp2(l2g * (float)(Lc - 1 - vm));
#pragma unroll
            for (int e = 0; e < 8; ++e) v[e] *= kd;
            *(LAS u32x4*)(VT + vm * 72 + vc0) = pack8(v);
        }
        __syncthreads();
        u32x2 sgc[2] = {rsg[0], rsg[1]};
        if (c + 1 < nchunks) fetch(c + 1);
        const int nt = wid >> 1;
#pragma unroll
        for (int mi = 0; mi < 2; ++mi) {
            const int mt = 2 * (wid & 1) + mi; f32x4 acc = (f32x4){0.f, 0.f, 0.f, 0.f};
            if (mt <= nt) {
#pragma unroll
                for (int ks = 0; ks < 8; ++ks) {
                    const bf16x8 a = *(const LAS bf16x8*)(Ks + (mt * 16 + fr) * 264 + ks * 32 + fq * 8), b = *(const LAS bf16x8*)(Qs + (nt * 16 + fr) * 264 + ks * 32 + fq * 8);
                    acc = MFMA16(a, b, acc);
                }
            }
            const int n = nt * 16 + fr, m0 = mt * 16 + fq * 4; const float sc = fexp2(l2g * (float)(n - (Lc - 1)));
            float pv[4];
#pragma unroll
            for (int j = 0; j < 4; ++j) pv[j] = (m0 + j <= n) ? acc[j] * sc : 0.f;
            *(LAS u32x2*)(Ps + n * 72 + m0) = (u32x2){pk_bf16(pv[0], pv[1]), pk_bf16(pv[2], pv[3])};
        }
        f32x4 accO[2];
#pragma unroll
        for (int i = 0; i < 2; ++i) {
            const int dvt = 2 * (wid & 1) + i; accO[i] = (f32x4){0.f, 0.f, 0.f, 0.f};
#pragma unroll
            for (int ks = 0; ks < 8; ++ks) {
                const bf16x8 a = *(const LAS bf16x8*)(ST + (dvt * 16 + fr) * 264 + ks * 32 + fq * 8), b = *(const LAS bf16x8*)(Qs + (nt * 16 + fr) * 264 + ks * 32 + fq * 8);
                accO[i] = MFMA16(a, b, accO[i]);
            }
            const float qd = fexp2(l2g * (float)(nt * 16 + fr + 1));
            accO[i] = accO[i] * qd;
        }
        __syncthreads();
#pragma unroll
        for (int i = 0; i < 2; ++i) {
            const int dvt = 2 * (wid & 1) + i;
#pragma unroll
            for (int ks = 0; ks < 2; ++ks) {
                const bf16x8 a = tr_frag(VT + ks * 32 * 72 + dvt * 16, 72, lane), b = *(const LAS bf16x8*)(Ps + (nt * 16 + fr) * 72 + ks * 32 + fq * 8);
                accO[i] = MFMA16(a, b, accO[i]);
            }
        }
#pragma unroll
        for (int dt = 0; dt < 2; ++dt)
#pragma unroll
            for (int dvt = 0; dvt < 4; ++dvt) accS[dt][dvt] = accS[dt][dvt] * sdec;
#pragma unroll
        for (int ks = 0; ks < 2; ++ks) {
            bf16x8 bv[4];
#pragma unroll
            for (int dvt = 0; dvt < 4; ++dvt) bv[dvt] = tr_frag(VT + ks * 32 * 72 + dvt * 16, 72, lane);
#pragma unroll
            for (int dt = 0; dt < 2; ++dt) {
                const bf16x8 a = tr_frag(Ks + ks * 32 * 264 + (2 * wid + dt) * 16, 264, lane);
#pragma unroll
                for (int dvt = 0; dvt < 4; ++dvt) accS[dt][dvt] = MFMA16(a, bv[dvt], accS[dt][dvt]);
            }
        }
#pragma unroll
        for (int dt = 0; dt < 2; ++dt)
#pragma unroll
            for (int dvt = 0; dvt < 4; ++dvt)
                *(LAS u32x2*)(ST + (dvt * 16 + fr) * 264 + (2 * wid + dt) * 16 + fq * 4) = (u32x2){pk_bf16(accS[dt][dvt][0], accS[dt][dvt][1]), pk_bf16(accS[dt][dvt][2], accS[dt][dvt][3])};
        {
            float ss = 0.f; const int n = nt * 16 + fr;
#pragma unroll
            for (int i = 0; i < 2; ++i) {
                const int dvt = 2 * (wid & 1) + i;
                ss += accO[i][0] * accO[i][0] + accO[i][1] * accO[i][1] + accO[i][2] * accO[i][2] + accO[i][3] * accO[i][3];
                if (n < Lc) *(u32x2*)(Z + (zr + n) * INC + 4096 + h * 512 + slice * 64 + dvt * 16 + fq * 4) =
                    (u32x2){pk_bf16(accO[i][0] * bf_lo(sgc[i][0]), accO[i][1] * bf_hi(sgc[i][0])), pk_bf16(accO[i][2] * bf_lo(sgc[i][1]), accO[i][3] * bf_hi(sgc[i][1]))};
            }
            ss += shx(ss, 16, lane); ss += shx(ss, 32, lane);
            if (fq == 0 && n < Lc) atomicAdd(sso + (size_t)(grow0 + c * 64 + n) * 4 + h, ss);
        }
        __syncthreads();
    }
#pragma unroll
    for (int dt = 0; dt < 2; ++dt)
#pragma unroll
        for (int dvt = 0; dvt < 4; ++dvt)
#pragma unroll
            for (int j = 0; j < 4; ++j) { const int d = (2 * wid + dt) * 16 + fq * 4 + j; s_out[(size_t)d * 512 + slice * 64 + dvt * 16 + fr] = accS[dt][dvt][j]; }
}

__device__ __forceinline__ void sgu_unit(const Ctx& cx, const Params& p, LAS unsigned char* lds, bf16_t* Z, int zrow0, int grow0, int rows, int g, float* vout, const float* ssv, bool load_w) {
    LAS bf16_t* WS = (LAS bf16_t*)lds; LAS bf16_t* VT = (LAS bf16_t*)(lds + 34816);
    const int tid = cx.tid, wid = __builtin_amdgcn_readfirstlane(tid >> 6), lane = tid & 63, fr = lane & 15, fq = lane >> 4;
    if (load_w)
#pragma unroll
    for (int it = 0; it < 4; ++it) {
        const int item = tid + 512 * it, n = item >> 4, m0 = (item & 15) * 8;
        const float* src = p.w_s + ((size_t)g * 128 + n) * 128 + m0;
        const f32x4 a = *(const f32x4*)src, b = *(const f32x4*)(src + 4); float v[8];
#pragma unroll
        for (int e = 0; e < 4; ++e) { v[e] = (m0 + e <= n) ? a[e] : 0.f; v[4 + e] = (m0 + 4 + e <= n) ? b[e] : 0.f; }
        *(LAS u32x4*)(WS + n * 136 + m0) = pack8(v);
    }
#pragma unroll
    for (int it = 0; it < 4; ++it) {
        const int item = tid + 512 * it, m = item >> 4, d0 = (item & 15) * 8; float v[8];
#pragma unroll
        for (int e = 0; e < 8; ++e) v[e] = 0.f;
        if (m < rows) {
            unpack8(*(const u32x4*)(Z + (size_t)(zrow0 + m) * INC + 1024 + g * 128 + d0), v);
            const float rs = rsq(ssv[grow0 + m] * (1.f / 1024.f) + EPS);
            const f32x4 g0 = *(const f32x4*)(p.g_sgu + g * 128 + d0), g1 = *(const f32x4*)(p.g_sgu + g * 128 + d0 + 4);
#pragma unroll
            for (int e = 0; e < 4; ++e) { v[e] *= rs * g0[e]; v[4 + e] *= rs * g1[e]; }
            if (vout) { *(f32x4*)(vout + (size_t)m * 1024 + g * 128 + d0) = (f32x4){v[0], v[1], v[2], v[3]}; *(f32x4*)(vout + (size_t)m * 1024 + g * 128 + d0 + 4) = (f32x4){v[4], v[5], v[6], v[7]}; }
        }
        *(LAS u32x4*)(VT + m * 136 + d0) = pack8(v);
    }
    u32x2 uu[8]; float bias = 0.f;
    if (wid * 16 < rows) {
        bias = p.b_s[g * 128 + wid * 16 + fr];
#pragma unroll
        for (int dt = 0; dt < 8; ++dt) uu[dt] = *(const u32x2*)(Z + (size_t)(zrow0 + wid * 16 + fr) * INC + g * 128 + dt * 16 + fq * 4);
    }
    __syncthreads();
    if (wid * 16 < rows) {
        const int nks = (wid >> 1) + 1;
        f32x4 acc[8];
#pragma unroll
        for (int dt = 0; dt < 8; ++dt) acc[dt] = (f32x4){0.f, 0.f, 0.f, 0.f};
        for (int ks = 0; ks < nks; ++ks) {
            const bf16x8 b = *(const LAS bf16x8*)(WS + (wid * 16 + fr) * 136 + ks * 32 + fq * 8);
#pragma unroll
            for (int dt = 0; dt < 8; ++dt) { const bf16x8 a = tr_frag(VT + ks * 32 * 136 + dt * 16, 136, lane); acc[dt] = MFMA16(a, b, acc[dt]); }
        }
        const int n = wid * 16 + fr;
#pragma unroll
        for (int dt = 0; dt < 8; ++dt) {
            bf16_t* up = Z + (size_t)(zrow0 + n) * INC + g * 128 + dt * 16 + fq * 4;
            *(u32x2*)up = (u32x2){pk_bf16(bf_lo(uu[dt][0]) * (acc[dt][0] + bias), bf_hi(uu[dt][0]) * (acc[dt][1] + bias)), pk_bf16(bf_lo(uu[dt][1]) * (acc[dt][2] + bias), bf_hi(uu[dt][1]) * (acc[dt][3] + bias))};
        }
    }
    __syncthreads();
}

__device__ __forceinline__ void phase2(const Ctx& cx, const Params& p, LAS unsigned char* lds, int hf) {
    unsigned char* ws = p.ws; bf16_t* Z = (bf16_t*)(ws + OFF_Z); float* sso = (float*)(ws + OFF_SSO); const float* ssv = (const float*)(ws + OFF_SSV);
    const int rowbase = hf ? NH0 : 0;
    for (int u = cx.bid; u < 256; u += cx.nb) {
        const int slice = u & 7, h = (u >> 3) & 3, bl = u >> 5, b = hf * 8 + bl;
        retention_unit(cx, lds, Z, bl * 2048, rowbase + bl * 2048, 32, 64, 0, h, slice, nullptr, p.out + O_SP + ((size_t)b * 4 + h) * 256 * 512, sso);
    }
    if (hf == 0) {
        for (int u = cx.bid; u < 512; u += cx.nb) {
            const int slice = u & 7, h = (u >> 3) & 3, b = u >> 5;
            retention_unit(cx, lds, Z, 16384 + b * 16, 16384 + b * 16, 1, 16, 1024, h, slice, p.state + ((size_t)b * 4 + h) * 256 * 512,
                           p.out + O_SS + ((size_t)b * 4 + h) * 256 * 512, sso);
        }
    }
    const int nprompt = 128 * 8, nsgu = nprompt + (hf == 0 ? 16 * 8 : 0);
    int last_g = -1;
    for (int u = cx.bid; u < nsgu; u += cx.nb) {
        if (u < nprompt) { const int g = u & 7, ci = u >> 3; sgu_unit(cx, p, lds, Z, ci * 128, rowbase + ci * 128, 128, g, nullptr, ssv, g != last_g); last_g = g; }
        else { const int v = u - nprompt, g = v & 7, b = v >> 3; sgu_unit(cx, p, lds, Z, 16384 + b * 16, 16384 + b * 16, 16, g, p.out + O_SV + (size_t)b * 16 * 1024, ssv, g != last_g); last_g = g; }
    }
}

#define CE_DESC(x, i, l) do { const float _a = fmaxf(x[i], x[l]), _b = fminf(x[i], x[l]); x[i] = _a; x[l] = _b; } while (0)
__device__ __forceinline__ void bitonic_sort16_desc(float (&x)[16]) {
#pragma unroll
    for (int k = 2; k <= 16; k <<= 1)
#pragma unroll
        for (int j = k >> 1; j > 0; j >>= 1)
#pragma unroll
            for (int i = 0; i < 16; ++i) {
                const int l = i ^ j;
                if (l > i) { if ((i & k) == 0 || k == 16) CE_DESC(x, i, l); else CE_DESC(x, l, i); }
            }
}
__device__ __forceinline__ void bitonic_merge16_desc(float (&x)[16]) {
#pragma unroll
    for (int j = 8; j > 0; j >>= 1)
#pragma unroll
        for (int i = 0; i < 16; ++i) { const int l = i ^ j; if (l > i) CE_DESC(x, i, l); }
}
#define TOPK_INS_FROM(L, x, S0) do { float _v = (x); _Pragma("unroll") for (int _i = (S0); _i < 16; ++_i) { const float _h = fmaxf(L[_i], _v); _v = fminf(L[_i], _v); L[_i] = _h; } } while (0)
__device__ __forceinline__ void phase7(const Ctx& cx, const Params& p, LAS unsigned char* lds) {
    unsigned char* ws = p.ws; const bf16_t* QP = (const bf16_t*)(ws + OFF_QP); int* ids = (int*)(ws + OFF_IDS); float* wts = (float*)(ws + OFF_WTS);
    LAS bf16_t* KEYS = (LAS bf16_t*)lds;
    LAS float* SC = (LAS float*)(lds + 69632);
    LAS float* TP = (LAS float*)(lds + 69632 + 67584);
    const int tid = cx.tid, wid = __builtin_amdgcn_readfirstlane(tid >> 6), lane = tid & 63, fr = lane & 15, fq = lane >> 4;
#pragma unroll
    for (int it = 0; it < 8; ++it) {
        const int idx = tid + 512 * it, tab = idx >> 11, row = (idx >> 4) & 127, c8 = (idx & 15) * 8;
        *(LAS u32x4*)(KEYS + tab * 17408 + row * 136 + c8) = *(const u32x4*)((const bf16_t*)(ws + (tab ? OFF_K2 : OFF_K1)) + row * 128 + c8);
    }
    bf16x8 a[2][4], an[2][4];
    auto load_a = [&](int tile, bf16x8 (&d)[2][4]) {
#pragma unroll
        for (int half = 0; half < 2; ++half)
#pragma unroll
            for (int ks = 0; ks < 4; ++ks) d[half][ks] = *(const bf16x8*)(QP + (size_t)(tile * 16 + fr) * 2048 + wid * 256 + half * 128 + ks * 32 + fq * 8);
    };
    if (cx.bid < NTOK / 16) load_a(cx.bid, an);
    __syncthreads();
    const size_t cv_end = CONV_ITEMS * (size_t)(cx.bid + 1) / (size_t)cx.nb; size_t cv_pos = CONV_ITEMS * (size_t)cx.bid / (size_t)cx.nb;
    for (int tile = cx.bid; tile < NTOK / 16; tile += cx.nb) {
        const int row0 = tile * 16;
#pragma unroll
        for (int half = 0; half < 2; ++half)
#pragma unroll
            for (int ks = 0; ks < 4; ++ks) a[half][ks] = an[half][ks];
        if (tile + cx.nb < NTOK / 16) load_a(tile + cx.nb, an);
#pragma unroll
        for (int half = 0; half < 2; ++half) {
#pragma unroll
            for (int nt = 0; nt < 8; ++nt) {
                f32x4 acc = (f32x4){0.f, 0.f, 0.f, 0.f};
#pragma unroll
                for (int ks = 0; ks < 4; ++ks) acc = MFMA16(a[half][ks], *(const LAS bf16x8*)(KEYS + half * 17408 + (nt * 16 + fr) * 136 + ks * 32 + fq * 8), acc);
#pragma unroll
                for (int j = 0; j < 4; ++j) {
                    const int t = fq * 4 + j, list = t * 8 + wid, n = nt * 16 + fr;
                    SC[list * 132 + ((n + 8 * fq) & 127)] = __uint_as_float((__float_as_uint(acc[j]) & ~127u) | (unsigned)n);
                }
            }
            __syncthreads();
            if (tid < 256) {
                const int list = tid >> 1, part = tid & 1; const LAS float* sp = SC + list * 132 + part * 64;
                float T[16];
#pragma unroll
                for (int i = 0; i < 4; ++i) { const f32x4 v = *(const LAS f32x4*)(sp + i * 4); T[4 * i] = v[0]; T[4 * i + 1] = v[1]; T[4 * i + 2] = v[2]; T[4 * i + 3] = v[3]; }
                bitonic_sort16_desc(T);
#pragma unroll 1
                for (int grp = 1; grp < 4; ++grp) {
                    float G[16];
#pragma unroll
                    for (int i = 0; i < 4; ++i) { const f32x4 v = *(const LAS f32x4*)(sp + grp * 16 + i * 4); G[4 * i] = v[0]; G[4 * i + 1] = v[1]; G[4 * i + 2] = v[2]; G[4 * i + 3] = v[3]; }
                    bitonic_sort16_desc(G);
#pragma unroll
                    for (int i = 0; i < 16; ++i) T[i] = fmaxf(T[i], G[15 - i]);
                    bitonic_merge16_desc(T);
                }
                float O[16];
#pragma unroll
                for (int i = 0; i < 16; ++i) O[i] = __int_as_float(__builtin_amdgcn_update_dpp(0, __float_as_int(T[i]), 0xB1, 0xF, 0xF, true));
#pragma unroll
                for (int i = 0; i < 16; ++i) T[i] = fmaxf(T[i], O[15 - i]);
                bitonic_merge16_desc(T);
                if (part == 0) {
#pragma unroll
                    for (int i = 0; i < 4; ++i) *(LAS f32x4*)(TP + (list * 2 + half) * 16 + i * 4) = (f32x4){T[4 * i], T[4 * i + 1], T[4 * i + 2], T[4 * i + 3]};
                }
            } else if (cv_pos + (size_t)(tid - 256) < cv_end) convert_item(p, ws, cv_pos + (size_t)(tid - 256));
            cv_pos += 256;
            __syncthreads();
        }
        if (tid < 128) {
            float v1[16], v2[16], L[16];
#pragma unroll
            for (int i = 0; i < 4; ++i) {
                const f32x4 va = *(const LAS f32x4*)(TP + (tid * 2) * 16 + i * 4), vb = *(const LAS f32x4*)(TP + (tid * 2 + 1) * 16 + i * 4);
#pragma unroll
                for (int e = 0; e < 4; ++e) { v1[4 * i + e] = va[e]; v2[4 * i + e] = vb[e]; }
            }
#pragma unroll
            for (int jj = 0; jj < 16; ++jj) { const float c = v1[0] + v2[jj]; L[jj] = __uint_as_float((__float_as_uint(c) & ~255u) | (unsigned)jj); }
#pragma unroll
            for (int i = 1; i < 16; ++i)
#pragma unroll
                for (int jj = 0; jj < 16; ++jj)
                    if ((i + 1) * (jj + 1) <= 16) { const float c = v1[i] + v2[jj]; TOPK_INS_FROM(L, __uint_as_float((__float_as_uint(c) & ~255u) | (unsigned)(i * 16 + jj)), (i + 1) * (jj + 1) - 1); }
            float ex[16], sum = 0.f;
#pragma unroll
            for (int k = 0; k < 16; ++k) { ex[k] = fexp2((L[k] - L[0]) * 1.44269504f); sum += ex[k]; }
            const float rinv = 1.f / sum;
#pragma unroll
            for (int k = 0; k < 16; ++k) {
                const unsigned code = __float_as_uint(L[k]) & 255u;
                const unsigned e1 = __float_as_uint(TP[(tid * 2) * 16 + (code >> 4)]) & 127u, e2 = __float_as_uint(TP[(tid * 2 + 1) * 16 + (code & 15u)]) & 127u;
                ((LAS int*)SC)[tid * 16 + k] = (int)(e1 * 128u + e2); SC[2048 + tid * 16 + k] = ex[k] * rinv;
            }
        }
        __syncthreads();
        *(u32x4*)(ids + (size_t)row0 * 128 + tid * 4) = *(const LAS u32x4*)((LAS int*)SC + tid * 4);
        *(f32x4*)(wts + (size_t)row0 * 128 + tid * 4) = *(const LAS f32x4*)(SC + 2048 + tid * 4);
        __syncthreads();
    }
    for (size_t it = cv_pos + tid; it < cv_end; it += 512) convert_item(p, ws, it);
}

__device__ __forceinline__ void phase8(const Ctx& cx, const Params& p, LAS unsigned char* lds) {
    unsigned char* ws = p.ws; const unsigned char* EU = ws + OFF_EU; const unsigned char* EV = ws + OFF_EV;
    const int* ids = (const int*)(ws + OFF_IDS); const float* wts = (const float*)(ws + OFF_WTS);
    const float* ss2 = (const float*)(ws + OFF_SS2);
    const int tid = cx.tid, wid = __builtin_amdgcn_readfirstlane(tid >> 6), lane = tid & 63, fr = lane & 15, fq = lane >> 4;
    const int nfull = (NTOK / (cx.nb * 8)) * (cx.nb * 8);
    const unsigned char* ET = ws + OFF_EU;
    int nid0 = 0, nid1 = 0; float nw0 = 0.f, nw1 = 0.f, nr2 = 0.f;
    auto fetch_ids = [&](int r, int& i0_, int& i1_, float& a0, float& a1, float& rr) {
        i0_ = ids[(size_t)r * 128 + lane] & 16383; i1_ = ids[(size_t)r * 128 + 64 + lane] & 16383;
        a0 = wts[(size_t)r * 128 + lane]; a1 = wts[(size_t)r * 128 + 64 + lane];
        rr = rsq(ss2[r] * (1.f / 1024.f) + EPS) * (1.f / EU_SCALE);
    };
    if (cx.bid * 8 + wid < nfull) fetch_ids(cx.bid * 8 + wid, nid0, nid1, nw0, nw1, nr2);
    for (int r = cx.bid * 8 + wid; r < nfull; r += cx.nb * 8) {
        const int id0 = nid0, id1 = nid1; const float w0 = nw0, w1 = nw1, r2 = nr2;
        float* yr = yrow(p, r);
        f32x2 tq[4][8];
#pragma unroll
        for (int j = 0; j < 4; ++j)
#pragma unroll
            for (int q = 0; q < 4; ++q) { const f32x4 v = *(const f32x4*)(yr + (fr + 16 * j) * 16 + q * 4); tq[j][2 * q] = (f32x2){v[0], v[1]}; tq[j][2 * q + 1] = (f32x2){v[2], v[3]}; }
        if (r + cx.nb * 8 < nfull) fetch_ids(r + cx.nb * 8, nid0, nid1, nw0, nw1, nr2);
        f32x2 acc[4][8];
#pragma unroll
        for (int j = 0; j < 4; ++j)
#pragma unroll
            for (int q = 0; q < 8; ++q) acc[j][q] = (f32x2){0.f, 0.f};
#pragma unroll 2
        for (int it = 0; it < 32; ++it) {
            const int src = ((it & 15) << 2) + fq;
            const int e = it < 16 ? shl_(id0, src) : shl_(id1, src);
            const float w = it < 16 ? shl_(w0, src) : shl_(w1, src);
            const unsigned char* rp = ET + (size_t)e * 2048 + fr * 16;
            u32x4 du[4], dv[4];
#pragma unroll
            for (int j = 0; j < 4; ++j) { du[j] = *(const u32x4*)(rp + j * 256); dv[j] = *(const u32x4*)(rp + 1024 + j * 256); }
            f32x2 s2 = (f32x2){0.f, 0.f};
#pragma unroll
            for (int j = 0; j < 4; ++j)
#pragma unroll
                for (int q = 0; q < 4; ++q) {
                    s2 = __builtin_amdgcn_cvt_pk_f32_fp8((int)du[j][q], false) * tq[j][2 * q] + s2;
                    s2 = __builtin_amdgcn_cvt_pk_f32_fp8((int)du[j][q], true) * tq[j][2 * q + 1] + s2;
                }
            const float sd = row16_sum(s2[0] + s2[1]);
            const float c = w * gelu_t(r2 * sd) * (1.f / EV_SCALE); const f32x2 cc = (f32x2){c, c};
#pragma unroll
            for (int j = 0; j < 4; ++j)
#pragma unroll
                for (int q = 0; q < 4; ++q) {
                    acc[j][2 * q] = __builtin_amdgcn_cvt_pk_f32_fp8((int)dv[j][q], false) * cc + acc[j][2 * q];
                    acc[j][2 * q + 1] = __builtin_amdgcn_cvt_pk_f32_fp8((int)dv[j][q], true) * cc + acc[j][2 * q + 1];
                }
        }
        float ss = 0.f;
#pragma unroll
        for (int j = 0; j < 4; ++j)
#pragma unroll
            for (int q = 0; q < 8; ++q)
#pragma unroll
                for (int h2 = 0; h2 < 2; ++h2) { float v = acc[j][q][h2]; v += shx(v, 16, lane); v += shx(v, 32, lane); acc[j][q][h2] = v; }
        if (fq == 0) {
#pragma unroll
            for (int j = 0; j < 4; ++j)
#pragma unroll
                for (int q = 0; q < 4; ++q) {
                    const f32x4 xv = *(const f32x4*)(yr + (fr + 16 * j) * 16 + q * 4);
                    acc[j][2 * q][0] += xv[0]; acc[j][2 * q][1] += xv[1]; acc[j][2 * q + 1][0] += xv[2]; acc[j][2 * q + 1][1] += xv[3];
                    ss += acc[j][2 * q][0] * acc[j][2 * q][0] + acc[j][2 * q][1] * acc[j][2 * q][1] + acc[j][2 * q + 1][0] * acc[j][2 * q + 1][0] + acc[j][2 * q + 1][1] * acc[j][2 * q + 1][1];
                }
        }
        ss = wave_sum(ss, lane);
        const float rs = rsq(ss * (1.f / 1024.f) + EPS);
        if (fq == 0) {
#pragma unroll
            for (int j = 0; j < 4; ++j)
#pragma unroll
                for (int q = 0; q < 4; ++q) {
                    const f32x4 g0 = *(const f32x4*)(p.g_final + (fr + 16 * j) * 16 + q * 4);
                    *(f32x4*)(yr + (fr + 16 * j) * 16 + q * 4) = (f32x4){acc[j][2 * q][0], acc[j][2 * q][1], acc[j][2 * q + 1][0], acc[j][2 * q + 1][1]} * rs * g0;
                }
        }
    }
    LAS float* cfb = (LAS float*)lds; LAS float* part = (LAS float*)(lds + 4096);
    __syncthreads();
    for (int r = nfull + cx.bid; r < NTOK; r += cx.nb) {
        const int id0 = ids[(size_t)r * 128 + lane] & 16383, id1 = ids[(size_t)r * 128 + 64 + lane] & 16383;
        const float w0 = wts[(size_t)r * 128 + lane], w1 = wts[(size_t)r * 128 + 64 + lane];
        const float r2 = rsq(ss2[r] * (1.f / 1024.f) + EPS) * (1.f / EU_SCALE);
        float* yr = yrow(p, r);
        f32x2 tq[4][8];
#pragma unroll
        for (int j = 0; j < 4; ++j)
#pragma unroll
            for (int q = 0; q < 4; ++q) { const f32x4 v = *(const f32x4*)(yr + (fr + 16 * j) * 16 + q * 4); tq[j][2 * q] = (f32x2){v[0], v[1]}; tq[j][2 * q + 1] = (f32x2){v[2], v[3]}; }
#pragma unroll
        for (int i4 = 0; i4 < 4; ++i4) {
            const int it = wid * 4 + i4, src = ((it & 15) << 2) + fq;
            const int e = it < 16 ? shl_(id0, src) : shl_(id1, src);
            const float w = it < 16 ? shl_(w0, src) : shl_(w1, src);
            const unsigned char* rp = ET + (size_t)e * 2048 + fr * 16;
            u32x4 d[4];
#pragma unroll
            for (int j = 0; j < 4; ++j) d[j] = *(const u32x4*)(rp + j * 256);
            f32x2 s2 = (f32x2){0.f, 0.f};
#pragma unroll
            for (int j = 0; j < 4; ++j)
#pragma unroll
                for (int q = 0; q < 4; ++q) {
                    s2 = __builtin_amdgcn_cvt_pk_f32_fp8((int)d[j][q], false) * tq[j][2 * q] + s2;
                    s2 = __builtin_amdgcn_cvt_pk_f32_fp8((int)d[j][q], true) * tq[j][2 * q + 1] + s2;
                }
            const float sd = row16_sum(s2[0] + s2[1]);
            if (fr == 0) cfb[it * 4 + fq] = w * gelu_t(r2 * sd) * (1.f / EV_SCALE);
        }
        __syncthreads();
        const float c0 = cfb[lane], c1 = cfb[64 + lane];
        const int idsel = wid < 4 ? id0 : id1; const float csel = wid < 4 ? c0 : c1;
        f32x2 acc[8];
#pragma unroll
        for (int i = 0; i < 8; ++i) acc[i] = (f32x2){0.f, 0.f};
#pragma unroll
        for (int k16 = 0; k16 < 16; ++k16) {
            const int kk = (wid & 3) * 16 + k16;
            const int e = __builtin_amdgcn_readlane(idsel, kk); const float c = __int_as_float(__builtin_amdgcn_readlane(__float_as_int(csel), kk));
            const u32x4 v = *(const u32x4*)(ET + (size_t)e * 2048 + 1024 + lane * 16); const f32x2 cc = (f32x2){c, c};
#pragma unroll
            for (int q = 0; q < 4; ++q) { acc[2 * q] = __builtin_amdgcn_cvt_pk_f32_fp8((int)v[q], false) * cc + acc[2 * q]; acc[2 * q + 1] = __builtin_amdgcn_cvt_pk_f32_fp8((int)v[q], true) * cc + acc[2 * q + 1]; }
        }
#pragma unroll
        for (int q = 0; q < 4; ++q) *(LAS f32x4*)(part + (wid * 64 + lane) * 16 + q * 4) = (f32x4){acc[2 * q][0], acc[2 * q][1], acc[2 * q + 1][0], acc[2 * q + 1][1]};
        __syncthreads();
        if (wid == 0) {
            float ss = 0.f; f32x4 x[4];
#pragma unroll
            for (int j = 0; j < 4; ++j) {
                x[j] = *(const f32x4*)(yr + lane * 16 + j * 4);
#pragma unroll
                for (int w8 = 0; w8 < 8; ++w8) x[j] += *(const LAS f32x4*)(part + (w8 * 64 + lane) * 16 + j * 4);
                ss += x[j][0] * x[j][0] + x[j][1] * x[j][1] + x[j][2] * x[j][2] + x[j][3] * x[j][3];
            }
            ss = wave_sum(ss, lane);
            const float rs = rsq(ss * (1.f / 1024.f) + EPS);
#pragma unroll
            for (int j = 0; j < 4; ++j) { const f32x4 g0 = *(const f32x4*)(p.g_final + lane * 16 + j * 4); *(f32x4*)(yr + lane * 16 + j * 4) = x[j] * rs * g0; }
        }
        __syncthreads();
    }
}

__device__ __forceinline__ void strip_mma(const bf16_t* A, int lda, const bf16_t* Bt, int ldb, int K, int c, int wid, int fr, int fq, f32x4 (&acc)[2]) {
#pragma unroll 2
    for (int ks = 0; ks < K / 32; ks += 4) {
        bf16x8 a[2][4], b[4];
#pragma unroll
        for (int u = 0; u < 4; ++u) {
            b[u] = *(const bf16x8*)(Bt + (size_t)(16 * c + fr) * ldb + (ks + u) * 32 + fq * 8);
#pragma unroll
            for (int i = 0; i < 2; ++i) a[i][u] = *(const bf16x8*)(A + (size_t)((2 * wid + i) * 16 + fr) * lda + (ks + u) * 32 + fq * 8);
        }
#pragma unroll
        for (int u = 0; u < 4; ++u)
#pragma unroll
            for (int i = 0; i < 2; ++i) acc[i] = MFMA16(a[i][u], b[u], acc[i]);
    }
}
__device__ __forceinline__ void sample_merge(const Ctx& cx, const Params& p) {
    unsigned char* ws = p.ws; const bf16_t* Zs = (const bf16_t*)(ws + OFF_Z) + (size_t)16384 * INC; bf16_t* M1 = (bf16_t*)(ws + OFF_M1) + (size_t)16384 * 1024;
    const int tid = cx.tid, wid = __builtin_amdgcn_readfirstlane(tid >> 6), lane = tid & 63, fr = lane & 15, fq = lane >> 4;
    for (int c = cx.bid; c < 64; c += cx.nb) {
        f32x4 aa[2] = {(f32x4){0.f, 0.f, 0.f, 0.f}, (f32x4){0.f, 0.f, 0.f, 0.f}}, ab[2] = {(f32x4){0.f, 0.f, 0.f, 0.f}, (f32x4){0.f, 0.f, 0.f, 0.f}};
        strip_mma(Zs, INC, (const bf16_t*)(ws + OFF_WA), 1024, 1024, c, wid, fr, fq, aa);
#pragma unroll 1
        for (int hh = 0; hh < 4; ++hh) {
            f32x4 ah[2] = {(f32x4){0.f, 0.f, 0.f, 0.f}, (f32x4){0.f, 0.f, 0.f, 0.f}};
            strip_mma(Zs + 4096 + hh * 512, INC, (const bf16_t*)(ws + OFF_WB) + hh * 512, 2048, 512, c, wid, fr, fq, ah);
#pragma unroll
            for (int i = 0; i < 2; ++i)
#pragma unroll
                for (int j = 0; j < 4; ++j) ab[i][j] += ah[i][j] * rsq(((const float*)(ws + OFF_SSO))[(size_t)(16384 + (2 * wid + i) * 16 + fq * 4 + j) * 4 + hh] * (1.f / 512.f) + EPS);
        }
#pragma unroll
        for (int i = 0; i < 2; ++i)
#pragma unroll
            for (int j = 0; j < 4; ++j) {
                const int row = (2 * wid + i) * 16 + fq * 4 + j, col = 16 * c + fr;
                const float ga = bf_lo((unsigned)Zs[(size_t)row * INC + 8192 + col]), gb = bf_lo((unsigned)Zs[(size_t)row * INC + 9216 + col]);
                M1[(size_t)row * 1024 + col] = f2bf(ga * aa[i][j] + gb * ab[i][j]);
            }
    }
}
__device__ __forceinline__ void sample_x2(const Ctx& cx, const Params& p) {
    unsigned char* ws = p.ws; bf16_t* X2b = (bf16_t*)(ws + OFF_X2B) + (size_t)16384 * 1024; float* ss2 = (float*)(ws + OFF_SS2) + 16384;
    const int tid = cx.tid, wid = __builtin_amdgcn_readfirstlane(tid >> 6), lane = tid & 63, fr = lane & 15, fq = lane >> 4;
    for (int c = cx.bid; c < 64; c += cx.nb) {
        f32x4 acc[2] = {(f32x4){0.f, 0.f, 0.f, 0.f}, (f32x4){0.f, 0.f, 0.f, 0.f}};
        strip_mma((const bf16_t*)(ws + OFF_M1) + (size_t)16384 * 1024, 1024, (const bf16_t*)(ws + OFF_WO), 1024, 1024, c, wid, fr, fq, acc);
#pragma unroll
        for (int i = 0; i < 2; ++i)
#pragma unroll
            for (int j = 0; j < 4; ++j) {
                const int row = (2 * wid + i) * 16 + fq * 4 + j, col = 16 * c + fr;
                const float v = p.xs[(size_t)row * 1024 + col] + acc[i][j];
                p.out[O_YS + (size_t)row * 1024 + col] = v; X2b[(size_t)row * 1024 + col] = f2bf(v);
                const float sq = row16_sum(v * v);
                if (fr == 0) atomicAdd(ss2 + row, sq);
            }
    }
}
__device__ __forceinline__ void sample_query(const Ctx& cx, const Params& p) {
    unsigned char* ws = p.ws; bf16_t* QP = (bf16_t*)(ws + OFF_QP) + (size_t)16384 * 2048; const float* ss2 = (const float*)(ws + OFF_SS2) + 16384;
    const int tid = cx.tid, wid = __builtin_amdgcn_readfirstlane(tid >> 6), lane = tid & 63, fr = lane & 15, fq = lane >> 4;
    for (int c = cx.bid; c < 128; c += cx.nb) {
        f32x4 acc[2] = {(f32x4){0.f, 0.f, 0.f, 0.f}, (f32x4){0.f, 0.f, 0.f, 0.f}};
        strip_mma((const bf16_t*)(ws + OFF_X2B) + (size_t)16384 * 1024, 1024, (const bf16_t*)(ws + OFF_WQ), 1024, 1024, c, wid, fr, fq, acc);
#pragma unroll
        for (int i = 0; i < 2; ++i)
#pragma unroll
            for (int j = 0; j < 4; ++j) {
                const int row = (2 * wid + i) * 16 + fq * 4 + j, col = 16 * c + fr;
                QP[(size_t)row * 2048 + col] = f2bf(acc[i][j] * rsq(ss2[row] * (1.f / 1024.f) + EPS));
            }
    }
}

__device__ __forceinline__ void run_phase(const Params& p, LAS unsigned char* lds, int ph, const Ctx& cx) {
    unsigned char* ws = p.ws; pg8::StaticOrder S; pg8::Gemm g;
    bf16_t* Z = (bf16_t*)(ws + OFF_Z); bf16_t* T1 = (bf16_t*)((unsigned char*)p.out + OUT_T1);
    if (ph == 0) { phase0(cx, p, lds); return; }
    if (ph >= 1 && ph <= 8) {
        const int hf = (ph - 1) >> 2, sub = (ph - 1) & 3, rowbase = hf ? NH0 : 0, nM = hf ? 64 : 65;
        if (sub == 0) {
            g.A = (const bf16_t*)((unsigned char*)p.out + OUT_XB) + (size_t)rowbase * 1024; g.Bt = (const bf16_t*)(ws + OFF_WIN); g.lda = 1024; g.ldb = 1024; g.K = 1024;
            S.init(nM, 40, cx.nb, cx.bid);
            EpiIn E{Z, (const float*)(ws + OFF_R1), (float*)(ws + OFF_SSV), p.b_gate, rowbase};
            pg8::gemm_phase(cx, lds, g, S, E);
        } else if (sub == 1) phase2(cx, p, lds, hf);
#ifdef DBG_SKIP_P3
        else if (sub == 2) { }
#else
        else if (sub == 2) { }
#endif
        else {
            S.init(64, 4, cx.nb, cx.bid);
            g.A = Z; g.Bt = (const bf16_t*)(ws + OFF_WA); g.lda = INC; g.ldb = 1024; g.K = 1024;
            EpiT1 E1{T1, Z}; pg8::gemm_phase(cx, lds, g, S, E1);
            g.A = Z + 4096; g.Bt = (const bf16_t*)(ws + OFF_WB); g.lda = INC; g.ldb = 2048; g.K = 2048;
            EpiM1 E2{T1, Z, (bf16_t*)(ws + OFF_M1), rowbase, (const float*)(ws + OFF_SSO)}; pg8::gemm_phase(cx, lds, g, S, E2);
            if (hf == 0) sample_merge(cx, p);
        }
        return;
    }
#ifdef DBG_YCONST
    if (ph >= 9 && ph <= 11) return;
#endif
    if (ph == 9) {
        g.A = (const bf16_t*)(ws + OFF_M1); g.Bt = (const bf16_t*)(ws + OFF_WO); g.lda = 1024; g.ldb = 1024; g.K = 1024;
        S.init(128, 4, cx.nb, cx.bid, 64);
        EpiX2 E{p.xp, p.xs, p.out, (bf16_t*)(ws + OFF_X2B), (float*)(ws + OFF_SS2)}; pg8::gemm_phase(cx, lds, g, S, E);
        sample_x2(cx, p); return;
    }
    if (ph == 10) {
        g.A = (const bf16_t*)(ws + OFF_X2B); g.Bt = (const bf16_t*)(ws + OFF_WQ); g.lda = 1024; g.ldb = 1024; g.K = 1024;
        S.init(128, 8, cx.nb, cx.bid, 64);
        EpiQP E{(bf16_t*)(ws + OFF_QP), (const float*)(ws + OFF_SS2)}; pg8::gemm_phase(cx, lds, g, S, E);
        sample_query(cx, p); return;
    }
    if (ph == 11) { phase7(cx, p, lds); return; }
    if (ph == 12) { phase8(cx, p, lds); return; }
}
constexpr int NPHASE = 13;

extern __shared__ __attribute__((aligned(16))) unsigned char dyn_smem[];

#if ONE_LAUNCH
__device__ __forceinline__ void grid_barrier(unsigned* ctr, unsigned target, int tid) {
    asm volatile("s_waitcnt vmcnt(0)" ::: "memory");
    __syncthreads();
    if (tid == 0) {
        __builtin_amdgcn_fence(__ATOMIC_RELEASE, "agent");
        asm volatile("s_waitcnt vmcnt(0)" ::: "memory");
        __hip_atomic_fetch_add(ctr, 1u, __ATOMIC_RELAXED, __HIP_MEMORY_SCOPE_AGENT);
        while (__hip_atomic_load(ctr, __ATOMIC_RELAXED, __HIP_MEMORY_SCOPE_AGENT) < target) __builtin_amdgcn_s_sleep(2);
        __builtin_amdgcn_fence(__ATOMIC_ACQUIRE, "agent");
        asm volatile("s_waitcnt vmcnt(0)" ::: "memory");
    }
    __syncthreads();
}
__global__ __launch_bounds__(512, 2) void mega_kernel(Params p) {
#if defined(__HIP_DEVICE_COMPILE__)
    LAS unsigned char* lds = (LAS unsigned char*)dyn_smem;
    cg::grid_group grid = cg::this_grid();
    const int wave0 = __builtin_amdgcn_readfirstlane((int)threadIdx.x >> 6);
    unsigned nbar = 0;
    { int never = 0; asm volatile("" : "+s"(never));
      if (never == 1000) grid.sync(); }
#pragma nounroll
    for (int ph = 0; ph < NPHASE; ++ph) {
        int phv = ph; asm volatile("" : "+s"(phv));
        int wv = wave0; asm volatile("" : "+s"(wv));
        int ln = (int)__builtin_amdgcn_mbcnt_hi(~0u, __builtin_amdgcn_mbcnt_lo(~0u, 0u)); asm volatile("" : "+v"(ln));
        Ctx cx; cx.tid = wv * 64 + ln; cx.bid = blockIdx.x; cx.nb = gridDim.x;
        asm volatile("" : "+s"(cx.bid)); asm volatile("" : "+s"(cx.nb));
        auto ka = __builtin_amdgcn_kernarg_segment_ptr(); asm volatile("" : "+s"(ka));
        const Params pl = *(const Params __attribute__((address_space(4)))*)(unsigned long long)ka;
        unsigned lo = 0; asm volatile("" : "+s"(lo));
        if (ph == 3 || ph == 7) continue;
        run_phase(pl, lds + lo, phv, cx);
        if (ph + 1 < NPHASE) { ++nbar; grid_barrier((unsigned*)(pl.ws + OFF_BAR), nbar * (unsigned)cx.nb, cx.tid); }
    }
#endif
}
#else
__global__ __launch_bounds__(512, 2) void stage_kernel(Params p, int ph) {
    LAS unsigned char* lds = (LAS unsigned char*)dyn_smem;
    Ctx cx; cx.tid = threadIdx.x; cx.bid = blockIdx.x; cx.nb = gridDim.x;
    run_phase(p, lds, ph, cx);
}
#endif

extern "C" void kernel_launch(void* const* d_in, const int* in_sizes, int n_in, void* d_out, int out_size, void* d_ws, size_t ws_size, hipStream_t stream) {
    Params p; memset(&p, 0, sizeof(p));
    p.xp = (const float*)d_in[0]; p.xs = (const float*)d_in[1]; p.state = (const float*)d_in[2]; p.w_in = (const float*)d_in[3]; p.w_s = (const float*)d_in[4];
    p.b_s = (const float*)d_in[5]; p.g_sgu = (const float*)d_in[6]; p.w_pa = (const float*)d_in[7]; p.w_pb = (const float*)d_in[8]; p.b_gate = (const float*)d_in[9];
    p.w_out = (const float*)d_in[10]; p.g_mix = (const float*)d_in[11]; p.g_ffn = (const float*)d_in[12]; p.w_q = (const float*)d_in[13]; p.k1 = (const float*)d_in[14];
    p.k2 = (const float*)d_in[15]; p.eu = (const float*)d_in[16]; p.ev = (const float*)d_in[17]; p.g_final = (const float*)d_in[18];
    p.out = (float*)d_out; p.ws = (unsigned char*)d_ws;
    if (ws_size < WS_NEED) { fprintf(stderr, "workspace too small: %zu < %zu\n", ws_size, (size_t)WS_NEED); return; }
#if ONE_LAUNCH
    static int grid_blocks = 0;
    if (!grid_blocks) {
        (void)hipFuncSetAttribute((const void*)mega_kernel, hipFuncAttributeMaxDynamicSharedMemorySize, LDS_BYTES);
        int dev = 0, cus = 0, per_cu = 0;
        hipGetDevice(&dev); hipDeviceGetAttribute(&cus, hipDeviceAttributeMultiprocessorCount, dev);
        hipOccupancyMaxActiveBlocksPerMultiprocessor(&per_cu, mega_kernel, 512, LDS_BYTES);
        if (per_cu < 1) per_cu = 1;
        grid_blocks = cus * 1;
    }
    (void)hipMemsetAsync((unsigned char*)d_ws + OFF_BAR, 0, 256, stream);
    void* args[] = {&p};
    hipError_t e = hipLaunchCooperativeKernel((const void*)mega_kernel, dim3(grid_blocks), dim3(512), args, LDS_BYTES, stream);
    if (e != hipSuccess) fprintf(stderr, "cooperative launch failed: %s (grid %d)\n", hipGetErrorString(e), grid_blocks);
#else
    static bool attr = false;
    if (!attr) { (void)hipFuncSetAttribute((const void*)stage_kernel, hipFuncAttributeMaxDynamicSharedMemorySize, LDS_BYTES); attr = true; }
    for (int ph = 0; ph < NPHASE; ++ph) hipLaunchKernelGGL(stage_kernel, dim3(256), dim3(512), LDS_BYTES, stream, p, ph);
#endif
}
```

```cpp
#include <hip/hip_runtime.h>
#include <hip/hip_cooperative_groups.h>
#include <cstdio>
#include <cstring>
namespace cg = cooperative_groups;

#ifndef ONE_LAUNCH
#define ONE_LAUNCH 1
#endif

#define LAS __attribute__((address_space(3)))
typedef unsigned short bf16_t;
typedef short bf16x8 __attribute__((ext_vector_type(8)));
typedef float f32x4 __attribute__((ext_vector_type(4)));
typedef unsigned u32x4 __attribute__((ext_vector_type(4)));
typedef unsigned u32x2 __attribute__((ext_vector_type(2)));
typedef __bf16 bf16x2_t __attribute__((ext_vector_type(2)));

constexpr int DM = 1024, NTOK = 33024, NH0 = 16640, INC = 10240;
constexpr float EPS = 1e-6f;
constexpr int LDS_BYTES = 153600;
constexpr float EU_SCALE = 64.f, EV_SCALE = 64.f;

constexpr size_t OFF_WIN = 0;
constexpr size_t OFF_WA  = OFF_WIN + (size_t)10240 * 1024 * 2;
constexpr size_t OFF_WB  = OFF_WA + (size_t)1024 * 1024 * 2;
constexpr size_t OFF_WO  = OFF_WB + (size_t)1024 * 2048 * 2;
constexpr size_t OFF_WQ  = OFF_WO + (size_t)1024 * 1024 * 2;
constexpr size_t OFF_EU  = OFF_WQ + (size_t)2048 * 1024 * 2;
constexpr size_t OFF_EV  = OFF_EU + (size_t)16384 * 1024 * 2;
constexpr size_t OFF_K1  = OFF_EV + (size_t)16384 * 1024 * 2;
constexpr size_t OFF_K2  = OFF_K1 + 32768;
constexpr size_t OFF_M1  = OFF_K2 + 32768;
constexpr size_t OFF_R1  = OFF_M1 + (size_t)NTOK * 1024 * 2;
constexpr size_t OFF_SSV = OFF_R1 + (size_t)NTOK * 4;
constexpr size_t OFF_SS2 = OFF_SSV + (size_t)NTOK * 4;
constexpr size_t OFF_SSO = OFF_SS2 + (size_t)NTOK * 4;
constexpr size_t OFF_Z   = OFF_SSO + (size_t)NTOK * 16;
constexpr size_t Z_BYTES = (size_t)NH0 * INC * 2;
constexpr size_t OFF_BAR = OFF_Z + Z_BYTES;
constexpr size_t WS_NEED = OFF_BAR + 256;
constexpr size_t OFF_X2B = OFF_Z;
constexpr size_t OFF_QP  = OFF_X2B + (size_t)NTOK * 1024 * 2;
constexpr size_t OFF_IDS = OFF_QP + (size_t)NTOK * 2048 * 2;
constexpr size_t OFF_WTS = OFF_IDS + (size_t)NTOK * 128 * 4;
constexpr size_t OUT_XB = 0;
constexpr size_t OUT_T1 = (size_t)NTOK * 1024 * 2;
constexpr size_t O_YP = 0, O_YS = (size_t)32768 * 1024, O_SP = O_YS + (size_t)256 * 1024, O_SS = O_SP + (size_t)16 * 4 * 256 * 512,
                 O_SV = O_SS + (size_t)16 * 4 * 256 * 512;

struct Params {
    const float *xp, *xs, *state, *w_in, *w_s, *b_s, *g_sgu, *w_pa, *w_pb, *b_gate, *w_out, *g_mix, *g_ffn, *w_q, *k1, *k2, *eu, *ev, *g_final;
    float* out;
    unsigned char* ws;
};

struct Ctx { int tid, bid, nb; };

__device__ __forceinline__ float bf_lo(unsigned u) { return __uint_as_float(u << 16); }
__device__ __forceinline__ float bf_hi(unsigned u) { return __uint_as_float(u & 0xffff0000u); }
typedef float f32x2 __attribute__((ext_vector_type(2)));
__device__ __forceinline__ unsigned pk_bf16(float lo, float hi) {
    f32x2 v = {lo, hi}; bf16x2_t b = __builtin_convertvector(v, bf16x2_t); return __builtin_bit_cast(unsigned, b);
}
__device__ __forceinline__ bf16_t f2bf(float f) { return (bf16_t)(pk_bf16(f, 0.f) & 0xffffu); }
__device__ __forceinline__ float fexp2(float x) { return __builtin_amdgcn_exp2f(x); }
__device__ __forceinline__ float frcp(float x) { return __builtin_amdgcn_rcpf(x); }
__device__ __forceinline__ float sigm(float x) { return frcp(1.f + fexp2(-1.44269504f * x)); }
__device__ __forceinline__ float gelu_t(float x) { const float u = 0.7978845608f * (x + 0.044715f * x * x * x); return x * frcp(1.f + fexp2(-2.88539008f * u)); }
__device__ __forceinline__ float rsq(float x) { return __builtin_amdgcn_rsqf(x); }
__device__ __forceinline__ const float* xrow(const Params& p, int ir) {
    return ir < 16384 ? p.xp + (size_t)ir * 1024 : (ir < 16640 ? p.xs + (size_t)(ir - 16384) * 1024 : p.xp + (size_t)(ir - 256) * 1024);
}
__device__ __forceinline__ float* yrow(const Params& p, int ir) {
    return ir < 16384 ? p.out + O_YP + (size_t)ir * 1024 : (ir < 16640 ? p.out + O_YS + (size_t)(ir - 16384) * 1024 : p.out + O_YP + (size_t)(ir - 256) * 1024);
}
__device__ __forceinline__ float shx(float v, int m, int lane) { return __int_as_float(__builtin_amdgcn_ds_bpermute((lane ^ m) << 2, __float_as_int(v))); }
__device__ __forceinline__ float shl_(float v, int src) { return __int_as_float(__builtin_amdgcn_ds_bpermute(src << 2, __float_as_int(v))); }
__device__ __forceinline__ int shl_(int v, int src) { return __builtin_amdgcn_ds_bpermute(src << 2, v); }
__device__ __forceinline__ float wave_sum(float v, int lane) {
#pragma unroll
    for (int o = 32; o >= 1; o >>= 1) v += shx(v, o, lane);
    return v;
}
__device__ __forceinline__ float row16_sum(float s) {
    s += __int_as_float(__builtin_amdgcn_update_dpp(0, __float_as_int(s), 0xB1, 0xF, 0xF, true));
    s += __int_as_float(__builtin_amdgcn_update_dpp(0, __float_as_int(s), 0x4E, 0xF, 0xF, true));
    s += __int_as_float(__builtin_amdgcn_update_dpp(0, __float_as_int(s), 0x141, 0xF, 0xF, true));
    s += __int_as_float(__builtin_amdgcn_update_dpp(0, __float_as_int(s), 0x140, 0xF, 0xF, true));
    return s;
}
__device__ __forceinline__ float dot2bf(unsigned a, unsigned b, float c) {
    return __builtin_amdgcn_fdot2_f32_bf16(__builtin_bit_cast(bf16x2_t, a), __builtin_bit_cast(bf16x2_t, b), c, false);
}
typedef short s16x4 __attribute__((ext_vector_type(4)));
__device__ __forceinline__ bf16x8 tr_frag(const LAS bf16_t* tile, int stride, int lane) {
    const LAS bf16_t* a0 = tile + (8 * (lane >> 4) + ((lane >> 2) & 3)) * stride + 4 * (lane & 3);
    const s16x4 lo = __builtin_amdgcn_ds_read_tr16_b64_v4i16((LAS s16x4*)a0), hi = __builtin_amdgcn_ds_read_tr16_b64_v4i16((LAS s16x4*)(a0 + 4 * stride));
    return (bf16x8){lo[0], lo[1], lo[2], lo[3], hi[0], hi[1], hi[2], hi[3]};
}
#define MFMA16(a, b, c) __builtin_amdgcn_mfma_f32_16x16x32_bf16((a), (b), (c), 0, 0, 0)

namespace pg8 {
constexpr int BM = 256, BK = 64, HALF = 128, HTB = HALF * BK * 2, STAGE_BYTES = 8 * HTB, NXCD = 8, WGM = 8;
__device__ __forceinline__ int lds_byte(int r, int c) { const int st = (r >> 4) * 2 + (c >> 5), rr = r & 15, cc = c & 31, ob = rr * 64 + cc * 2; return st * 1024 + (ob ^ (((ob >> 9) & 1) << 5)); }
__device__ __forceinline__ void stage_rc(int b, int& R, int& C) { const int st = b / 1024, sb = b % 1024, swz = sb ^ (((sb >> 9) & 1) << 5); R = (st >> 1) * 16 + swz / 64; C = (st & 1) * 32 + (swz % 64) / 2; }
__device__ __forceinline__ int perm32(int rho) { const int n = rho >> 4, i = rho & 15; return 8 * (i >> 2) + 4 * n + (i & 3); }
struct Unit { int pm, pn; };
struct Gemm { const bf16_t* A; const bf16_t* Bt; int lda, ldb, K; };
struct StaticOrder {
    int nM, nN, nwg, G, c, skip;
    __device__ void init(int nM_, int nN_, int G_, int c_, int skip_ = 1 << 30) { nM = nM_; nN = nN_; nwg = nM * nN; G = G_; c = c_; skip = skip_; }
    __device__ bool next(int i, Unit& u) const {
        const long L = (long)i * G + c; if (L >= nwg) return false;
        int wgid = (int)L; { const int q = nwg / NXCD, r = nwg % NXCD, xcd = wgid % NXCD, off = wgid / NXCD; wgid = (xcd < r ? xcd * (q + 1) : r * (q + 1) + (xcd - r) * q) + off; }
        const int nig = WGM * nN, gid = wgid / nig, fm = gid * WGM, gsz = (nM - fm) < WGM ? (nM - fm) : WGM;
        u.pm = fm + ((wgid % nig) % gsz); u.pn = (wgid % nig) / gsz; if (u.pm >= skip) ++u.pm; return true;
    }
};

template <class Epi>
__device__ __forceinline__ void gemm_phase(const Ctx& cx, LAS unsigned char* lds, const Gemm g, const StaticOrder& S, const Epi& E) {
    const int tid = cx.tid, wid = __builtin_amdgcn_readfirstlane(tid >> 6), lane = tid & 63, wr = wid >> 2, wc = wid & 3, fr = lane & 15, fq = lane >> 4;
    const int K = g.K, nt = K / BK;
    unsigned voffA[2], voffB[2];
#pragma unroll
    for (int i = 0; i < 2; ++i) { int R, C; stage_rc(tid * 16 + i * 8192, R, C); const int Rb = (R & ~31) + perm32(R & 31);
        voffA[i] = (unsigned)(R * g.lda + C) * 2u; voffB[i] = (unsigned)(Rb * g.ldb + C) * 2u; }
    const size_t kstep = (size_t)(BK * 2);
    const size_t hstepA = (size_t)HALF * g.lda * 2, hstepB = (size_t)HALF * g.ldb * 2;
    const size_t tstepA = 2 * hstepA, tstepB = 2 * hstepB;
    const unsigned ldsw = (unsigned)wid * 1024u;
    const int aoff = lds_byte(wr * 64 + fr, fq * 8), boff = lds_byte(wc * 32 + fr, fq * 8);
#define PG8_SA(b, h) (((b) * 2 + (h)) * HTB)
#define PG8_SB(b, h) ((4 + (b) * 2 + (h)) * HTB)
#define PG8_STAGE(bufoff, gbase, voff) do { _Pragma("unroll") for (int _i = 0; _i < 2; ++_i) \
        __builtin_amdgcn_global_load_lds((const unsigned*)((const char*)(gbase) + (voff)[_i]), (LAS unsigned*)(lds + (bufoff) + ldsw + _i * 8192), 16, 0, 0); } while (0)
#define PG8_LDA(dst, b, h) do { _Pragma("unroll") for (int m = 0; m < 4; ++m) _Pragma("unroll") for (int k = 0; k < 2; ++k) dst[m][k] = *(const LAS bf16x8*)(lds + PG8_SA(b, h) + aoff + m * 2048 + k * 1024); } while (0)
#define PG8_LDB(dst, b, h) do { _Pragma("unroll") for (int n = 0; n < 2; ++n) _Pragma("unroll") for (int k = 0; k < 2; ++k) dst[n][k] = *(const LAS bf16x8*)(lds + PG8_SB(b, h) + boff + n * 2048 + k * 1024); } while (0)
#define PG8_MMA(ai, bj, At, Bt) do { __builtin_amdgcn_s_setprio(1); _Pragma("unroll") for (int m = 0; m < 4; ++m) _Pragma("unroll") for (int n = 0; n < 2; ++n) _Pragma("unroll") for (int k = 0; k < 2; ++k) \
        acc[ai][bj][m][n] = __builtin_amdgcn_mfma_f32_16x16x32_bf16(Bt[n][k], At[m][k], acc[ai][bj][m][n], 0, 0, 0); __builtin_amdgcn_s_setprio(0); } while (0)
#define PG8_WAIT_V(n) asm volatile("s_waitcnt vmcnt(" #n ")" ::: "memory")
#define PG8_WAIT_L(n) asm volatile("s_waitcnt lgkmcnt(" #n ")" ::: "memory")
#define PG8_BAR __builtin_amdgcn_s_barrier()
#define PG8_SCHED __builtin_amdgcn_sched_barrier(0)
    Unit cur, nxt; int ui = 0;
    if (!S.next(0, cur)) return;
    f32x4 acc[2][2][4][2];
#pragma unroll
    for (int a = 0; a < 2; ++a)
#pragma unroll
        for (int b = 0; b < 2; ++b)
#pragma unroll
            for (int m = 0; m < 4; ++m)
#pragma unroll
                for (int n = 0; n < 2; ++n) acc[a][b][m][n] = (f32x4){0.f, 0.f, 0.f, 0.f};
    bf16x8 At[4][2], B0[2][2], B1[2][2];
    const char* cA = (const char*)g.A + (size_t)cur.pm * tstepA; const char* cB = (const char*)g.Bt + (size_t)cur.pn * tstepB;
    if constexpr (Epi::RESCALE) E.prep((LAS float*)(lds + STAGE_BYTES), cur, tid);
    PG8_STAGE(PG8_SB(0, 0), cB, voffB); PG8_STAGE(PG8_SA(0, 0), cA, voffA); PG8_STAGE(PG8_SB(0, 1), cB + hstepB, voffB); PG8_STAGE(PG8_SA(0, 1), cA + hstepA, voffA);
    if (wr == 1) PG8_BAR;
    PG8_WAIT_V(4); PG8_BAR;
    PG8_STAGE(PG8_SB(1, 0), cB + kstep, voffB); PG8_STAGE(PG8_SA(1, 0), cA + kstep, voffA); PG8_STAGE(PG8_SB(1, 1), cB + hstepB + kstep, voffB);
    PG8_WAIT_V(6); PG8_BAR;
    for (;;) {
        const bool has_next = S.next(ui + 1, nxt);
        if constexpr (Epi::RESCALE) { if (has_next) E.prep((LAS float*)(lds + STAGE_BYTES) + ((ui + 1) & 1) * 1024, nxt, tid); }
        const char* nA = has_next ? (const char*)g.A + (size_t)nxt.pm * tstepA : cA; const char* nB = has_next ? (const char*)g.Bt + (size_t)nxt.pn * tstepB : cB;
        for (int t = 0; t < nt; t += 2) {
            const bool last = (t == nt - 2);
            const char* a1 = cA + (size_t)(t + 1) * kstep;
            const char* a2 = last ? nA : cA + (size_t)(t + 2) * kstep; const char* b2 = last ? nB : cB + (size_t)(t + 2) * kstep;
            const char* a3 = a2 + kstep; const char* b3 = b2 + kstep;
            PG8_LDB(B0, 0, 0); PG8_SCHED; PG8_LDA(At, 0, 0); PG8_STAGE(PG8_SA(1, 1), a1 + hstepA, voffA);
            PG8_WAIT_L(8); PG8_BAR; PG8_WAIT_L(0); PG8_MMA(0, 0, At, B0); PG8_BAR; PG8_SCHED;
            PG8_LDB(B1, 0, 1); PG8_STAGE(PG8_SB(0, 0), b2, voffB);
            PG8_BAR; PG8_WAIT_L(0); PG8_MMA(0, 1, At, B1); PG8_BAR;
            PG8_LDA(At, 0, 1); PG8_STAGE(PG8_SA(0, 0), a2, voffA);
            PG8_BAR; PG8_WAIT_L(0); PG8_MMA(1, 0, At, B0); PG8_BAR; PG8_SCHED;
            PG8_STAGE(PG8_SB(0, 1), b2 + hstepB, voffB);
            PG8_WAIT_V(6); PG8_BAR; PG8_MMA(1, 1, At, B1); PG8_BAR;
            PG8_LDB(B0, 1, 0); PG8_SCHED; PG8_LDA(At, 1, 0); PG8_STAGE(PG8_SA(0, 1), a2 + hstepA, voffA);
            PG8_WAIT_L(8); PG8_BAR; PG8_WAIT_L(0); PG8_MMA(0, 0, At, B0); PG8_BAR; PG8_SCHED;
            PG8_LDB(B1, 1, 1); PG8_STAGE(PG8_SB(1, 0), b3, voffB);
            PG8_BAR; PG8_WAIT_L(0); PG8_MMA(0, 1, At, B1); PG8_BAR;
            PG8_LDA(At, 1, 1); PG8_STAGE(PG8_SA(1, 0), a3, voffA);
            PG8_BAR; PG8_WAIT_L(0); PG8_MMA(1, 0, At, B0); PG8_BAR; PG8_SCHED;
            PG8_STAGE(PG8_SB(1, 1), b3 + hstepB, voffB);
            PG8_WAIT_V(6); PG8_BAR; PG8_MMA(1, 1, At, B1); PG8_BAR;
            if constexpr (Epi::RESCALE) { if (((t + 2) & 7) == 0 && t + 2 < nt) E.mid(acc, (const LAS float*)(lds + STAGE_BYTES) + (ui & 1) * 1024, ((t + 2) >> 3) - 1, wr, fr); }
        }
        if constexpr (Epi::RESCALE) E.fin(acc, (const LAS float*)(lds + STAGE_BYTES) + (ui & 1) * 1024, cur, wr, wc, fr, fq); else E(acc, cur, wr, wc, fr, fq);
        if (!has_next) break;
#pragma unroll
        for (int a = 0; a < 2; ++a)
#pragma unroll
            for (int b = 0; b < 2; ++b)
#pragma unroll
                for (int m = 0; m < 4; ++m)
#pragma unroll
                    for (int n = 0; n < 2; ++n) acc[a][b][m][n] = (f32x4){0.f, 0.f, 0.f, 0.f};
        cur = nxt; cA = nA; cB = nB; ++ui;
    }
    PG8_WAIT_V(0);
    if (wr == 0) PG8_BAR;
    PG8_BAR;
#undef PG8_SA
#undef PG8_SB
#undef PG8_STAGE
#undef PG8_LDA
#undef PG8_LDB
#undef PG8_MMA
#undef PG8_WAIT_V
#undef PG8_WAIT_L
#undef PG8_BAR
#undef PG8_SCHED
}
}
using pg8::Unit;

__device__ __forceinline__ u32x4 pack8(const float (&v)[8]) { return (u32x4){pk_bf16(v[0], v[1]), pk_bf16(v[2], v[3]), pk_bf16(v[4], v[5]), pk_bf16(v[6], v[7])}; }
__device__ __forceinline__ void unpack8(const u32x4 u, float (&v)[8]) {
#pragma unroll
    for (int q = 0; q < 4; ++q) { v[2 * q] = bf_lo(u[q]); v[2 * q + 1] = bf_hi(u[q]); }
}

struct EpiIn {
    static constexpr bool RESCALE = false;
    bf16_t* Z; const float* r1; float* ssv; const float* b_gate; int rowbase;
    __device__ __forceinline__ void operator()(const f32x4 (&acc)[2][2][4][2], const Unit& u, int wr, int wc, int fr, int fq) const {
        const int pn = u.pn, lane = fr + 16 * fq;
        const int kind = pn < 4 ? 0 : pn < 8 ? 1 : pn < 12 ? 2 : pn < 16 ? 3 : pn < 24 ? 4 : pn < 32 ? 5 : 6;
        const int row0 = u.pm * 256 + wr * 64 + fr, col0 = pn * 256 + wc * 32 + 8 * fq;
        if (kind == 2 || kind == 3) {
            const float ksc = kind == 3 ? 0.0625f : 1.f;
            float inv8[8];
#pragma unroll
            for (int e = 0; e < 8; ++e) inv8[e] = fexp2(-(float)(wc * 32 + 8 * fq + e) * (13.287712379549449f / 127.f)) * 0.15915494309189535f;
#pragma unroll
            for (int ai = 0; ai < 2; ++ai)
#pragma unroll
                for (int m = 0; m < 4; ++m) {
                    const int row = row0 + ai * 128 + m * 16, gr = rowbase + row;
                    const float pos = (float)(gr < 16384 ? (gr & 2047) : (gr < 16640 ? 1024 + ((gr - 16384) & 15) : ((gr - 16640) & 2047)));
                    float v0[8], v1[8], o0[8], o1[8];
#pragma unroll
                    for (int e = 0; e < 4; ++e) { v0[e] = acc[ai][0][m][0][e]; v0[4 + e] = acc[ai][0][m][1][e]; v1[e] = acc[ai][1][m][0][e]; v1[4 + e] = acc[ai][1][m][1][e]; }
#pragma unroll
                    for (int e = 0; e < 8; ++e) {
                        float t = pos * inv8[e]; t -= floorf(t);
                        const float sn = __builtin_amdgcn_sinf(t) * ksc, cs = __builtin_amdgcn_cosf(t) * ksc;
                        o0[e] = v0[e] * cs - v1[e] * sn; o1[e] = v0[e] * sn + v1[e] * cs;
                    }
                    *(u32x4*)(Z + (size_t)row * INC + col0) = pack8(o0); *(u32x4*)(Z + (size_t)row * INC + col0 + 128) = pack8(o1);
                }
            return;
        }
#pragma unroll
        for (int ai = 0; ai < 2; ++ai)
#pragma unroll
            for (int m = 0; m < 4; ++m) {
                const int row = row0 + ai * 128 + m * 16; float ss = 0.f;
#pragma unroll
                for (int bj = 0; bj < 2; ++bj) {
                    const int col = col0 + bj * 128; float v[8];
#pragma unroll
                    for (int e = 0; e < 4; ++e) { v[e] = acc[ai][bj][m][0][e]; v[4 + e] = acc[ai][bj][m][1][e]; }
                    if (kind == 0) {
#pragma unroll
                        for (int e = 0; e < 8; ++e) v[e] = gelu_t(v[e]);
                    } else if (kind == 1) {
#pragma unroll
                        for (int e = 0; e < 8; ++e) { v[e] = gelu_t(v[e]); ss += v[e] * v[e]; }
                    } else if (kind == 3) {
#pragma unroll
                        for (int e = 0; e < 8; ++e) v[e] *= 0.0625f;
                    } else if (kind == 5) {
#pragma unroll
                        for (int e = 0; e < 8; ++e) v[e] = v[e] * sigm(v[e]);
                    } else if (kind == 6) {
                        const f32x4 b0 = *(const f32x4*)(b_gate + col - 8192), b1 = *(const f32x4*)(b_gate + col - 8192 + 4);
#pragma unroll
                        for (int e = 0; e < 4; ++e) { v[e] = sigm(v[e] + b0[e]); v[4 + e] = sigm(v[4 + e] + b1[e]); }
                    }
                    *(u32x4*)(Z + (size_t)row * INC + col) = pack8(v);
                }
                if (kind == 1) { ss += shx(ss, 16, lane); ss += shx(ss, 32, lane); if (fq == 0) atomicAdd(ssv + rowbase + row, ss); }
            }
    }
};
struct EpiT1 {
    static constexpr bool RESCALE = false;
    bf16_t* T1; const bf16_t* Z;
    __device__ __forceinline__ void operator()(const f32x4 (&acc)[2][2][4][2], const Unit& u, int wr, int wc, int fr, int fq) const {
        const int row0 = u.pm * 256 + wr * 64 + fr, col0 = u.pn * 256 + wc * 32 + 8 * fq;
#pragma unroll
        for (int ai = 0; ai < 2; ++ai)
#pragma unroll
            for (int m = 0; m < 4; ++m) {
                const int row = row0 + ai * 128 + m * 16;
#pragma unroll
                for (int bj = 0; bj < 2; ++bj) {
                    const int col = col0 + bj * 128; float v[8], gt[8];
                    unpack8(*(const u32x4*)(Z + (size_t)row * INC + 8192 + col), gt);
#pragma unroll
                    for (int e = 0; e < 4; ++e) { v[e] = acc[ai][bj][m][0][e] * gt[e]; v[4 + e] = acc[ai][bj][m][1][e] * gt[4 + e]; }
                    *(u32x4*)(T1 + (size_t)row * 1024 + col) = pack8(v);
                }
            }
    }
};
struct EpiM1 {
    static constexpr bool RESCALE = true;
    const bf16_t* T1; const bf16_t* Z; bf16_t* M1; int rowbase; const float* sso;
    __device__ __forceinline__ void prep(LAS float* tab, const Unit& u, int tid) const {
        if (tid < 256) {
            const f32x4 sv = *(const f32x4*)(sso + (size_t)(rowbase + u.pm * 256 + tid) * 4);
            const float c0 = sv[0] * (1.f / 512.f) + EPS, c1 = sv[1] * (1.f / 512.f) + EPS, c2 = sv[2] * (1.f / 512.f) + EPS, c3 = sv[3] * (1.f / 512.f) + EPS;
            *(LAS f32x4*)(tab + tid * 4) = (f32x4){__builtin_sqrtf(c1 * frcp(c0)), __builtin_sqrtf(c2 * frcp(c1)), __builtin_sqrtf(c3 * frcp(c2)), rsq(c3)};
        }
    }
    __device__ __forceinline__ void mid(f32x4 (&acc)[2][2][4][2], const LAS float* tab, int seg, int wr, int fr) const {
#pragma unroll
        for (int ai = 0; ai < 2; ++ai)
#pragma unroll
            for (int m = 0; m < 4; ++m) {
                const float f = tab[(ai * 128 + wr * 64 + m * 16 + fr) * 4 + seg];
#pragma unroll
                for (int bj = 0; bj < 2; ++bj)
#pragma unroll
                    for (int n = 0; n < 2; ++n) acc[ai][bj][m][n] = acc[ai][bj][m][n] * f;
            }
    }
    __device__ __forceinline__ void operator()(const f32x4 (&acc)[2][2][4][2], const Unit& u, int wr, int wc, int fr, int fq) const {}
    __device__ __forceinline__ void fin(const f32x4 (&acc)[2][2][4][2], const LAS float* tab, const Unit& u, int wr, int wc, int fr, int fq) const {
        const int row0 = u.pm * 256 + wr * 64 + fr, col0 = u.pn * 256 + wc * 32 + 8 * fq;
#pragma unroll
        for (int ai = 0; ai < 2; ++ai)
#pragma unroll
            for (int m = 0; m < 4; ++m) {
                const int row = row0 + ai * 128 + m * 16; const float rn3 = tab[(ai * 128 + wr * 64 + m * 16 + fr) * 4 + 3];
#pragma unroll
                for (int bj = 0; bj < 2; ++bj) {
                    const int col = col0 + bj * 128; float v[8], gt[8], t1[8];
                    unpack8(*(const u32x4*)(Z + (size_t)row * INC + 9216 + col), gt);
                    unpack8(*(const u32x4*)(T1 + (size_t)row * 1024 + col), t1);
#pragma unroll
                    for (int e = 0; e < 4; ++e) { v[e] = t1[e] + acc[ai][bj][m][0][e] * rn3 * gt[e]; v[4 + e] = t1[4 + e] + acc[ai][bj][m][1][e] * rn3 * gt[4 + e]; }
                    *(u32x4*)(M1 + (size_t)(rowbase + row) * 1024 + col) = pack8(v);
                }
            }
    }
};
struct EpiX2 {
    static constexpr bool RESCALE = false;
    const float* xp; const float* xs; float* out; bf16_t* X2b; float* ss2;
    __device__ __forceinline__ void operator()(const f32x4 (&acc)[2][2][4][2], const Unit& u, int wr, int wc, int fr, int fq) const {
        const int row0 = u.pm * 256 + wr * 64 + fr, col0 = u.pn * 256 + wc * 32 + 8 * fq, lane = fr + 16 * fq;
#pragma unroll
        for (int ai = 0; ai < 2; ++ai)
#pragma unroll
            for (int m = 0; m < 4; ++m) {
                const int row = row0 + ai * 128 + m * 16;
                const float* xr = row < 16384 ? xp + (size_t)row * 1024 : (row < 16640 ? xs + (size_t)(row - 16384) * 1024 : xp + (size_t)(row - 256) * 1024);
                float* yr = row < 16384 ? out + O_YP + (size_t)row * 1024 : (row < 16640 ? out + O_YS + (size_t)(row - 16384) * 1024 : out + O_YP + (size_t)(row - 256) * 1024);
                float ss = 0.f;
#pragma unroll
                for (int bj = 0; bj < 2; ++bj) {
                    const int col = col0 + bj * 128; float v[8];
                    const f32x4 x0 = *(const f32x4*)(xr + col), x1 = *(const f32x4*)(xr + col + 4);
#pragma unroll
                    for (int e = 0; e < 4; ++e) { v[e] = acc[ai][bj][m][0][e] + x0[e]; v[4 + e] = acc[ai][bj][m][1][e] + x1[e]; }
#pragma unroll
                    for (int e = 0; e < 8; ++e) ss += v[e] * v[e];
                    *(f32x4*)(yr + col) = (f32x4){v[0], v[1], v[2], v[3]}; *(f32x4*)(yr + col + 4) = (f32x4){v[4], v[5], v[6], v[7]};
                    *(u32x4*)(X2b + (size_t)row * 1024 + col) = pack8(v);
                }
                ss += shx(ss, 16, lane); ss += shx(ss, 32, lane); if (fq == 0) atomicAdd(ss2 + row, ss);
            }
    }
};
struct EpiQP {
    static constexpr bool RESCALE = false;
    bf16_t* QP; const float* ss2;
    __device__ __forceinline__ void operator()(const f32x4 (&acc)[2][2][4][2], const Unit& u, int wr, int wc, int fr, int fq) const {
        const int row0 = u.pm * 256 + wr * 64 + fr, col0 = u.pn * 256 + wc * 32 + 8 * fq;
#pragma unroll
        for (int ai = 0; ai < 2; ++ai)
#pragma unroll
            for (int m = 0; m < 4; ++m) {
                const int row = row0 + ai * 128 + m * 16; const float rs = rsq(ss2[row] * (1.f / 1024.f) + EPS);
#pragma unroll
                for (int bj = 0; bj < 2; ++bj) {
                    const int col = col0 + bj * 128; float v[8];
#pragma unroll
                    for (int e = 0; e < 4; ++e) { v[e] = acc[ai][bj][m][0][e] * rs; v[4 + e] = acc[ai][bj][m][1][e] * rs; }
                    *(u32x4*)(QP + (size_t)row * 2048 + col) = pack8(v);
                }
            }
    }
};

__device__ __forceinline__ void convert_item(const Params& p, unsigned char* ws, size_t i) {
        const int d = (int)((i * 16) & 1023);
        unsigned ou[4], ov[4];
#pragma unroll
        for (int q = 0; q < 4; ++q) {
            const f32x4 a = *(const f32x4*)(p.eu + i * 16 + q * 4), g0 = *(const f32x4*)(p.g_ffn + d + q * 4), c = *(const f32x4*)(p.ev + i * 16 + q * 4);
            int u = __builtin_amdgcn_cvt_pk_fp8_f32(a[0] * g0[0] * EU_SCALE, a[1] * g0[1] * EU_SCALE, 0, false);
            u = __builtin_amdgcn_cvt_pk_fp8_f32(a[2] * g0[2] * EU_SCALE, a[3] * g0[3] * EU_SCALE, u, true);
            int v = __builtin_amdgcn_cvt_pk_fp8_f32(c[0] * EV_SCALE, c[1] * EV_SCALE, 0, false);
            v = __builtin_amdgcn_cvt_pk_fp8_f32(c[2] * EV_SCALE, c[3] * EV_SCALE, v, true);
            ou[q] = (unsigned)u; ov[q] = (unsigned)v;
        }
        *(u32x4*)(ws + OFF_EU + (i >> 6) * 2048 + (i & 63) * 16) = (u32x4){ou[0], ou[1], ou[2], ou[3]};
        *(u32x4*)(ws + OFF_EU + (i >> 6) * 2048 + 1024 + (i & 63) * 16) = (u32x4){ov[0], ov[1], ov[2], ov[3]};
    }
constexpr size_t CONV_ITEMS = (size_t)16384 * 64;

__device__ __forceinline__ void transpose_tile(const Ctx& cx, const float* src, bf16_t* dst, const float* scale, int K, int N, int tile, LAS float* tl) {
    const int tn = N / 64, k0 = (tile / tn) * 64, n0 = (tile % tn) * 64, tid = cx.tid;
    const int n4 = (tid & 15) * 4, kr = tid >> 4;
#pragma unroll
    for (int i = 0; i < 2; ++i) {
        const int kk = kr + 32 * i; f32x4 v = *(const f32x4*)(src + (size_t)(k0 + kk) * N + n0 + n4);
        if (scale) v = v * scale[k0 + kk];
        tl[kk * 65 + n4] = v[0]; tl[kk * 65 + n4 + 1] = v[1]; tl[kk * 65 + n4 + 2] = v[2]; tl[kk * 65 + n4 + 3] = v[3];
    }
    __syncthreads();
    const int n = tid >> 3, kc = (tid & 7) * 8; float o[8];
#pragma unroll
    for (int e = 0; e < 8; ++e) o[e] = tl[(kc + e) * 65 + n];
    *(u32x4*)(dst + (size_t)(n0 + n) * K + k0 + kc) = pack8(o);
    __syncthreads();
}
__device__ __forceinline__ void phase0(const Ctx& cx, const Params& p, LAS unsigned char* lds) {
    unsigned char* ws = p.ws; LAS float* tl = (LAS float*)lds;
    for (int j = cx.bid; j < 4096; j += cx.nb) {
        if (j < 2560) transpose_tile(cx, p.w_in, (bf16_t*)(ws + OFF_WIN), p.g_mix, 1024, 10240, j, tl);
        else if (j < 2816) transpose_tile(cx, p.w_pa, (bf16_t*)(ws + OFF_WA), nullptr, 1024, 1024, j - 2560, tl);
        else if (j < 3328) transpose_tile(cx, p.w_pb, (bf16_t*)(ws + OFF_WB), nullptr, 2048, 1024, j - 2816, tl);
        else if (j < 3584) transpose_tile(cx, p.w_out, (bf16_t*)(ws + OFF_WO), nullptr, 1024, 1024, j - 3328, tl);
        else transpose_tile(cx, p.w_q, (bf16_t*)(ws + OFF_WQ), p.g_ffn, 1024, 2048, j - 3584, tl);
    }
    const size_t gtid = (size_t)cx.bid * 512 + cx.tid, nth = (size_t)cx.nb * 512;
    for (size_t i = gtid; i < 16384; i += nth) { ((bf16_t*)(ws + OFF_K1))[i] = f2bf(p.k1[i]); ((bf16_t*)(ws + OFF_K2))[i] = f2bf(p.k2[i]); }
    for (size_t i = gtid; i < (size_t)NTOK * 6; i += nth) ((float*)(ws + OFF_SSV))[i] = 0.f;
    const int wid = __builtin_amdgcn_readfirstlane(cx.tid >> 6), lane = cx.tid & 63;
    bf16_t* xb = (bf16_t*)((unsigned char*)p.out + OUT_XB);
    for (int r = cx.bid * 8 + wid; r < NTOK; r += cx.nb * 8) {
        const float* xr = xrow(p, r); f32x4 v[4]; float ss = 0.f;
#pragma unroll
        for (int j = 0; j < 4; ++j) { v[j] = *(const f32x4*)(xr + lane * 4 + j * 256); ss += v[j][0] * v[j][0] + v[j][1] * v[j][1] + v[j][2] * v[j][2] + v[j][3] * v[j][3]; }
        ss = wave_sum(ss, lane);
        const float rs = rsq(ss * (1.f / 1024.f) + EPS);
#pragma unroll
        for (int j = 0; j < 4; ++j) *(u32x2*)(xb + (size_t)r * 1024 + lane * 4 + j * 256) = (u32x2){pk_bf16(v[j][0] * rs, v[j][1] * rs), pk_bf16(v[j][2] * rs, v[j][3] * rs)};
    }
}

__device__ __forceinline__ void retention_unit(const Ctx& cx, LAS unsigned char* lds, bf16_t* Z, int zrow0, int grow0, int nchunks, int Lc, int pos0, int h, int slice,
                               const float* s0, float* s_out, float* sso) {
    LAS bf16_t* Qs = (LAS bf16_t*)lds; LAS bf16_t* Ks = (LAS bf16_t*)(lds + 33792); LAS bf16_t* ST = (LAS bf16_t*)(lds + 67584);
    LAS bf16_t* VT = (LAS bf16_t*)(lds + 101376); LAS bf16_t* Ps = (LAS bf16_t*)(lds + 110592);
    const int tid = cx.tid, wid = __builtin_amdgcn_readfirstlane(tid >> 6), lane = tid & 63, fr = lane & 15, fq = lane >> 4;
    const float l2g = log2f(1.f - exp2f(-5.f - (float)h));
    f32x4 accS[2][4];
#pragma unroll
    for (int dt = 0; dt < 2; ++dt)
#pragma unroll
        for (int dvt = 0; dvt < 4; ++dvt) {
#pragma unroll
            for (int j = 0; j < 4; ++j) { const int d = (2 * wid + dt) * 16 + fq * 4 + j; accS[dt][dvt][j] = s0 ? s0[(size_t)d * 512 + slice * 64 + dvt * 16 + fr] : 0.f; }
            *(LAS u32x2*)(ST + (dvt * 16 + fr) * 264 + (2 * wid + dt) * 16 + fq * 4) = (u32x2){pk_bf16(accS[dt][dvt][0], accS[dt][dvt][1]), pk_bf16(accS[dt][dvt][2], accS[dt][dvt][3])};
        }
    const float sdec = fexp2(l2g * (float)Lc);
    __syncthreads();
    u32x4 rq1[2], rq2[2], rk1[2], rk2[2], rv; u32x2 rsg[2];
    const int vm = tid >> 3, vc0 = (tid & 7) * 8;
    auto fetch = [&](int c) {
        const size_t zr = (size_t)(zrow0 + c * 64);
#pragma unroll
        for (int it = 0; it < 2; ++it) {
            const int item = tid + 512 * it, n = item >> 4, dc = (item & 15) * 8;
            rq1[it] = (u32x4){0, 0, 0, 0}; rq2[it] = rq1[it]; rk1[it] = rq1[it]; rk2[it] = rq1[it];
            if (n < Lc) {
                const bf16_t* zp = Z + (zr + n) * INC + 2048 + h * 256 + dc;
                rq1[it] = *(const u32x4*)zp; rq2[it] = *(const u32x4*)(zp + 128); rk1[it] = *(const u32x4*)(zp + 1024); rk2[it] = *(const u32x4*)(zp + 1152);
            }
        }
        rv = (u32x4){0, 0, 0, 0};
        if (vm < Lc) rv = *(const u32x4*)(Z + (zr + vm) * INC + 4096 + h * 512 + slice * 64 + vc0);
#pragma unroll
        for (int i = 0; i < 2; ++i) {
            rsg[i] = (u32x2){0, 0};
            const int n = (wid >> 1) * 16 + fr;
            if (n < Lc) rsg[i] = *(const u32x2*)(Z + (zr + n) * INC + 6144 + h * 512 + slice * 64 + (2 * (wid & 1) + i) * 16 + fq * 4);
        }
    };
    fetch(0);
    for (int c = 0; c < nchunks; ++c) {
        const size_t zr = (size_t)(zrow0 + c * 64);
#pragma unroll
        for (int it = 0; it < 2; ++it) {
            const int item = tid + 512 * it, n = item >> 4, dc = (item & 15) * 8;
            *(LAS u32x4*)(Qs + n * 264 + dc) = rq1[it]; *(LAS u32x4*)(Qs + n * 264 + 128 + dc) = rq2[it];
            *(LAS u32x4*)(Ks + n * 264 + dc) = rk1[it]; *(LAS u32x4*)(Ks + n * 264 + 128 + dc) = rk2[it];
        }
        {
            float v[8]; unpack8(rv, v);
            const float kd = fexp2(l2g * (float)(Lc - 1 - vm));
#pragma unroll
            for (int e = 0; e < 8; ++e) v[e] *= kd;
            *(LAS u32x4*)(VT + vm * 72 + vc0) = pack8(v);
        }
        __syncthreads();
        u32x2 sgc[2] = {rsg[0], rsg[1]};
        if (c + 1 < nchunks) fetch(c + 1);
        const int nt = wid >> 1;
#pragma unroll
        for (int mi = 0; mi < 2; ++mi) {
            const int mt = 2 * (wid & 1) + mi; f32x4 acc = (f32x4){0.f, 0.f, 0.f, 0.f};
            if (mt <= nt) {
#pragma unroll
                for (int ks = 0; ks < 8; ++ks) {
                    const bf16x8 a = *(const LAS bf16x8*)(Qs + (nt * 16 + fr) * 264 + ks * 32 + fq * 8), b = *(const LAS bf16x8*)(Ks + (mt * 16 + fr) * 264 + ks * 32 + fq * 8);
                    acc = MFMA16(a, b, acc);
                }
            }
#pragma unroll
            for (int j = 0; j < 4; ++j) {
                const int n = nt * 16 + fq * 4 + j, m = mt * 16 + fr;
                const float val = (m <= n) ? acc[j] * fexp2(l2g * (float)(n - (Lc - 1))) : 0.f;
                Ps[n * 72 + m] = f2bf(val);
            }
        }
        f32x4 accO[2];
#pragma unroll
        for (int i = 0; i < 2; ++i) {
            const int dvt = 2 * (wid & 1) + i; accO[i] = (f32x4){0.f, 0.f, 0.f, 0.f};
#pragma unroll
            for (int ks = 0; ks < 8; ++ks) {
                const bf16x8 a = *(const LAS bf16x8*)(ST + (dvt * 16 + fr) * 264 + ks * 32 + fq * 8), b = *(const LAS bf16x8*)(Qs + (nt * 16 + fr) * 264 + ks * 32 + fq * 8);
                accO[i] = MFMA16(a, b, accO[i]);
            }
            const float qd = fexp2(l2g * (float)(nt * 16 + fr + 1));
            accO[i] = accO[i] * qd;
        }
        __syncthreads();
#pragma unroll
        for (int i = 0; i < 2; ++i) {
            const int dvt = 2 * (wid & 1) + i;
#pragma unroll
            for (int ks = 0; ks < 2; ++ks) {
                const bf16x8 a = tr_frag(VT + ks * 32 * 72 + dvt * 16, 72, lane), b = *(const LAS bf16x8*)(Ps + (nt * 16 + fr) * 72 + ks * 32 + fq * 8);
                accO[i] = MFMA16(a, b, accO[i]);
            }
        }
#pragma unroll
        for (int dt = 0; dt < 2; ++dt)
#pragma unroll
            for (int dvt = 0; dvt < 4; ++dvt) accS[dt][dvt] = accS[dt][dvt] * sdec;
#pragma unroll
        for (int ks = 0; ks < 2; ++ks) {
            bf16x8 bv[4];
#pragma unroll
            for (int dvt = 0; dvt < 4; ++dvt) bv[dvt] = tr_frag(VT + ks * 32 * 72 + dvt * 16, 72, lane);
#pragma unroll
            for (int dt = 0; dt < 2; ++dt) {
                const bf16x8 a = tr_frag(Ks + ks * 32 * 264 + (2 * wid + dt) * 16, 264, lane);
#pragma unroll
                for (int dvt = 0; dvt < 4; ++dvt) accS[dt][dvt] = MFMA16(a, bv[dvt], accS[dt][dvt]);
            }
        }
#pragma unroll
        for (int dt = 0; dt < 2; ++dt)
#pragma unroll
            for (int dvt = 0; dvt < 4; ++dvt)
                *(LAS u32x2*)(ST + (dvt * 16 + fr) * 264 + (2 * wid + dt) * 16 + fq * 4) = (u32x2){pk_bf16(accS[dt][dvt][0], accS[dt][dvt][1]), pk_bf16(accS[dt][dvt][2], accS[dt][dvt][3])};
        {
            float ss = 0.f; const int n = nt * 16 + fr;
#pragma unroll
            for (int i = 0; i < 2; ++i) {
                const int dvt = 2 * (wid & 1) + i;
                ss += accO[i][0] * accO[i][0] + accO[i][1] * accO[i][1] + accO[i][2] * accO[i][2] + accO[i][3] * accO[i][3];
                if (n < Lc) *(u32x2*)(Z + (zr + n) * INC + 4096 + h * 512 + slice * 64 + dvt * 16 + fq * 4) =
                    (u32x2){pk_bf16(accO[i][0] * bf_lo(sgc[i][0]), accO[i][1] * bf_hi(sgc[i][0])), pk_bf16(accO[i][2] * bf_lo(sgc[i][1]), accO[i][3] * bf_hi(sgc[i][1]))};
            }
            ss += shx(ss, 16, lane); ss += shx(ss, 32, lane);
            if (fq == 0 && n < Lc) atomicAdd(sso + (size_t)(grow0 + c * 64 + n) * 4 + h, ss);
        }
        __syncthreads();
    }
#pragma unroll
    for (int dt = 0; dt < 2; ++dt)
#pragma unroll
        for (int dvt = 0; dvt < 4; ++dvt)
#pragma unroll
            for (int j = 0; j < 4; ++j) { const int d = (2 * wid + dt) * 16 + fq * 4 + j; s_out[(size_t)d * 512 + slice * 64 + dvt * 16 + fr] = accS[dt][dvt][j]; }
}

__device__ __forceinline__ void sgu_unit(const Ctx& cx, const Params& p, LAS unsigned char* lds, bf16_t* Z, int zrow0, int grow0, int rows, int g, float* vout, const float* ssv, bool load_w) {
    LAS bf16_t* WS = (LAS bf16_t*)lds; LAS bf16_t* VT = (LAS bf16_t*)(lds + 34816);
    const int tid = cx.tid, wid = __builtin_amdgcn_readfirstlane(tid >> 6), lane = tid & 63, fr = lane & 15, fq = lane >> 4;
    if (load_w)
#pragma unroll
    for (int it = 0; it < 4; ++it) {
        const int item = tid + 512 * it, n = item >> 4, m0 = (item & 15) * 8;
        const float* src = p.w_s + ((size_t)g * 128 + n) * 128 + m0;
        const f32x4 a = *(const f32x4*)src, b = *(const f32x4*)(src + 4); float v[8];
#pragma unroll
        for (int e = 0; e < 4; ++e) { v[e] = (m0 + e <= n) ? a[e] : 0.f; v[4 + e] = (m0 + 4 + e <= n) ? b[e] : 0.f; }
        *(LAS u32x4*)(WS + n * 136 + m0) = pack8(v);
    }
#pragma unroll
    for (int it = 0; it < 4; ++it) {
        const int item = tid + 512 * it, m = item >> 4, d0 = (item & 15) * 8; float v[8];
#pragma unroll
        for (int e = 0; e < 8; ++e) v[e] = 0.f;
        if (m < rows) {
            unpack8(*(const u32x4*)(Z + (size_t)(zrow0 + m) * INC + 1024 + g * 128 + d0), v);
            const float rs = rsq(ssv[grow0 + m] * (1.f / 1024.f) + EPS);
            const f32x4 g0 = *(const f32x4*)(p.g_sgu + g * 128 + d0), g1 = *(const f32x4*)(p.g_sgu + g * 128 + d0 + 4);
#pragma unroll
            for (int e = 0; e < 4; ++e) { v[e] *= rs * g0[e]; v[4 + e] *= rs * g1[e]; }
            if (vout) { *(f32x4*)(vout + (size_t)m * 1024 + g * 128 + d0) = (f32x4){v[0], v[1], v[2], v[3]}; *(f32x4*)(vout + (size_t)m * 1024 + g * 128 + d0 + 4) = (f32x4){v[4], v[5], v[6], v[7]}; }
        }
        *(LAS u32x4*)(VT + m * 136 + d0) = pack8(v);
    }
    u32x2 uu[8]; float bias = 0.f;
    if (wid * 16 < rows) {
        bias = p.b_s[g * 128 + wid * 16 + fr];
#pragma unroll
        for (int dt = 0; dt < 8; ++dt) uu[dt] = *(const u32x2*)(Z + (size_t)(zrow0 + wid * 16 + fr) * INC + g * 128 + dt * 16 + fq * 4);
    }
    __syncthreads();
    if (wid * 16 < rows) {
        const int nks = (wid >> 1) + 1;
        f32x4 acc[8];
#pragma unroll
        for (int dt = 0; dt < 8; ++dt) acc[dt] = (f32x4){0.f, 0.f, 0.f, 0.f};
        for (int ks = 0; ks < nks; ++ks) {
            const bf16x8 b = *(const LAS bf16x8*)(WS + (wid * 16 + fr) * 136 + ks * 32 + fq * 8);
#pragma unroll
            for (int dt = 0; dt < 8; ++dt) { const bf16x8 a = tr_frag(VT + ks * 32 * 136 + dt * 16, 136, lane); acc[dt] = MFMA16(a, b, acc[dt]); }
        }
        const int n = wid * 16 + fr;
#pragma unroll
        for (int dt = 0; dt < 8; ++dt) {
            bf16_t* up = Z + (size_t)(zrow0 + n) * INC + g * 128 + dt * 16 + fq * 4;
            *(u32x2*)up = (u32x2){pk_bf16(bf_lo(uu[dt][0]) * (acc[dt][0] + bias), bf_hi(uu[dt][0]) * (acc[dt][1] + bias)), pk_bf16(bf_lo(uu[dt][1]) * (acc[dt][2] + bias), bf_hi(uu[dt][1]) * (acc[dt][3] + bias))};
        }
    }
    __syncthreads();
}

__device__ __forceinline__ void phase2(const Ctx& cx, const Params& p, LAS unsigned char* lds, int hf) {
    unsigned char* ws = p.ws; bf16_t* Z = (bf16_t*)(ws + OFF_Z); float* sso = (float*)(ws + OFF_SSO); const float* ssv = (const float*)(ws + OFF_SSV);
    const int rowbase = hf ? NH0 : 0;
    for (int u = cx.bid; u < 256; u += cx.nb) {
        const int slice = u & 7, h = (u >> 3) & 3, bl = u >> 5, b = hf * 8 + bl;
        retention_unit(cx, lds, Z, bl * 2048, rowbase + bl * 2048, 32, 64, 0, h, slice, nullptr, p.out + O_SP + ((size_t)b * 4 + h) * 256 * 512, sso);
    }
    if (hf == 0) {
        for (int u = cx.bid; u < 512; u += cx.nb) {
            const int slice = u & 7, h = (u >> 3) & 3, b = u >> 5;
            retention_unit(cx, lds, Z, 16384 + b * 16, 16384 + b * 16, 1, 16, 1024, h, slice, p.state + ((size_t)b * 4 + h) * 256 * 512,
                           p.out + O_SS + ((size_t)b * 4 + h) * 256 * 512, sso);
        }
    }
    const int nprompt = 128 * 8, nsgu = nprompt + (hf == 0 ? 16 * 8 : 0);
    int last_g = -1;
    for (int u = cx.bid; u < nsgu; u += cx.nb) {
        if (u < nprompt) { const int g = u & 7, ci = u >> 3; sgu_unit(cx, p, lds, Z, ci * 128, rowbase + ci * 128, 128, g, nullptr, ssv, g != last_g); last_g = g; }
        else { const int v = u - nprompt, g = v & 7, b = v >> 3; sgu_unit(cx, p, lds, Z, 16384 + b * 16, 16384 + b * 16, 16, g, p.out + O_SV + (size_t)b * 16 * 1024, ssv, g != last_g); last_g = g; }
    }
}

#define CE_DESC(x, i, l) do { const float _a = fmaxf(x[i], x[l]), _b = fminf(x[i], x[l]); x[i] = _a; x[l] = _b; } while (0)
__device__ __forceinline__ void bitonic_sort16_desc(float (&x)[16]) {
#pragma unroll
    for (int k = 2; k <= 16; k <<= 1)
#pragma unroll
        for (int j = k >> 1; j > 0; j >>= 1)
#pragma unroll
            for (int i = 0; i < 16; ++i) {
                const int l = i ^ j;
                if (l > i) { if ((i & k) == 0 || k == 16) CE_DESC(x, i, l); else CE_DESC(x, l, i); }
            }
}
__device__ __forceinline__ void bitonic_merge16_desc(float (&x)[16]) {
#pragma unroll
    for (int j = 8; j > 0; j >>= 1)
#pragma unroll
        for (int i = 0; i < 16; ++i) { const int l = i ^ j; if (l > i) CE_DESC(x, i, l); }
}
#define TOPK_INS_FROM(L, x, S0) do { float _v = (x); _Pragma("unroll") for (int _i = (S0); _i < 16; ++_i) { const float _h = fmaxf(L[_i], _v); _v = fminf(L[_i], _v); L[_i] = _h; } } while (0)
__device__ __forceinline__ void phase7(const Ctx& cx, const Params& p, LAS unsigned char* lds) {
    unsigned char* ws = p.ws; const bf16_t* QP = (const bf16_t*)(ws + OFF_QP); int* ids = (int*)(ws + OFF_IDS); float* wts = (float*)(ws + OFF_WTS);
    LAS bf16_t* KEYS = (LAS bf16_t*)lds;
    LAS float* SC = (LAS float*)(lds + 69632);
    LAS float* TP = (LAS float*)(lds + 69632 + 67584);
    const int tid = cx.tid, wid = __builtin_amdgcn_readfirstlane(tid >> 6), lane = tid & 63, fr = lane & 15, fq = lane >> 4;
#pragma unroll
    for (int it = 0; it < 8; ++it) {
        const int idx = tid + 512 * it, tab = idx >> 11, row = (idx >> 4) & 127, c8 = (idx & 15) * 8;
        *(LAS u32x4*)(KEYS + tab * 17408 + row * 136 + c8) = *(const u32x4*)((const bf16_t*)(ws + (tab ? OFF_K2 : OFF_K1)) + row * 128 + c8);
    }
    bf16x8 a[2][4], an[2][4];
    auto load_a = [&](int tile, bf16x8 (&d)[2][4]) {
#pragma unroll
        for (int half = 0; half < 2; ++half)
#pragma unroll
            for (int ks = 0; ks < 4; ++ks) d[half][ks] = *(const bf16x8*)(QP + (size_t)(tile * 16 + fr) * 2048 + wid * 256 + half * 128 + ks * 32 + fq * 8);
    };
    if (cx.bid < NTOK / 16) load_a(cx.bid, an);
    __syncthreads();
    const size_t cv_end = CONV_ITEMS * (size_t)(cx.bid + 1) / (size_t)cx.nb; size_t cv_pos = CONV_ITEMS * (size_t)cx.bid / (size_t)cx.nb;
    for (int tile = cx.bid; tile < NTOK / 16; tile += cx.nb) {
        const int row0 = tile * 16;
#pragma unroll
        for (int half = 0; half < 2; ++half)
#pragma unroll
            for (int ks = 0; ks < 4; ++ks) a[half][ks] = an[half][ks];
        if (tile + cx.nb < NTOK / 16) load_a(tile + cx.nb, an);
#pragma unroll
        for (int half = 0; half < 2; ++half) {
#pragma unroll
            for (int nt = 0; nt < 8; ++nt) {
                f32x4 acc = (f32x4){0.f, 0.f, 0.f, 0.f};
#pragma unroll
                for (int ks = 0; ks < 4; ++ks) acc = MFMA16(a[half][ks], *(const LAS bf16x8*)(KEYS + half * 17408 + (nt * 16 + fr) * 136 + ks * 32 + fq * 8), acc);
#pragma unroll
                for (int j = 0; j < 4; ++j) {
                    const int t = fq * 4 + j, list = t * 8 + wid, n = nt * 16 + fr;
                    SC[list * 132 + ((n + 8 * fq) & 127)] = __uint_as_float((__float_as_uint(acc[j]) & ~127u) | (unsigned)n);
                }
            }
            __syncthreads();
            if (tid < 256) {
                const int list = tid >> 1, part = tid & 1; const LAS float* sp = SC + list * 132 + part * 64;
                float T[16];
#pragma unroll
                for (int i = 0; i < 4; ++i) { const f32x4 v = *(const LAS f32x4*)(sp + i * 4); T[4 * i] = v[0]; T[4 * i + 1] = v[1]; T[4 * i + 2] = v[2]; T[4 * i + 3] = v[3]; }
                bitonic_sort16_desc(T);
#pragma unroll 1
                for (int grp = 1; grp < 4; ++grp) {
                    float G[16];
#pragma unroll
                    for (int i = 0; i < 4; ++i) { const f32x4 v = *(const LAS f32x4*)(sp + grp * 16 + i * 4); G[4 * i] = v[0]; G[4 * i + 1] = v[1]; G[4 * i + 2] = v[2]; G[4 * i + 3] = v[3]; }
                    bitonic_sort16_desc(G);
#pragma unroll
                    for (int i = 0; i < 16; ++i) T[i] = fmaxf(T[i], G[15 - i]);
                    bitonic_merge16_desc(T);
                }
                float O[16];
#pragma unroll
                for (int i = 0; i < 16; ++i) O[i] = __int_as_float(__builtin_amdgcn_update_dpp(0, __float_as_int(T[i]), 0xB1, 0xF, 0xF, true));
#pragma unroll
                for (int i = 0; i < 16; ++i) T[i] = fmaxf(T[i], O[15 - i]);
                bitonic_merge16_desc(T);
                if (part == 0) {
#pragma unroll
                    for (int i = 0; i < 4; ++i) *(LAS f32x4*)(TP + (list * 2 + half) * 16 + i * 4) = (f32x4){T[4 * i], T[4 * i + 1], T[4 * i + 2], T[4 * i + 3]};
                }
            } else if (cv_pos + (size_t)(tid - 256) < cv_end) convert_item(p, ws, cv_pos + (size_t)(tid - 256));
            cv_pos += 256;
            __syncthreads();
        }
        if (tid < 128) {
            float v1[16], v2[16], L[16];
#pragma unroll
            for (int i = 0; i < 4; ++i) {
                const f32x4 va = *(const LAS f32x4*)(TP + (tid * 2) * 16 + i * 4), vb = *(const LAS f32x4*)(TP + (tid * 2 + 1) * 16 + i * 4);
#pragma unroll
                for (int e = 0; e < 4; ++e) { v1[4 * i + e] = va[e]; v2[4 * i + e] = vb[e]; }
            }
#pragma unroll
            for (int jj = 0; jj < 16; ++jj) { const float c = v1[0] + v2[jj]; L[jj] = __uint_as_float((__float_as_uint(c) & ~255u) | (unsigned)jj); }
#pragma unroll
            for (int i = 1; i < 16; ++i)
#pragma unroll
                for (int jj = 0; jj < 16; ++jj)
                    if ((i + 1) * (jj + 1) <= 16) { const float c = v1[i] + v2[jj]; TOPK_INS_FROM(L, __uint_as_float((__float_as_uint(c) & ~255u) | (unsigned)(i * 16 + jj)), (i + 1) * (jj + 1) - 1); }
            float ex[16], sum = 0.f;
#pragma unroll
            for (int k = 0; k < 16; ++k) { ex[k] = fexp2((L[k] - L[0]) * 1.44269504f); sum += ex[k]; }
            const float rinv = 1.f / sum;
#pragma unroll
            for (int k = 0; k < 16; ++k) {
                const unsigned code = __float_as_uint(L[k]) & 255u;
                const unsigned e1 = __float_as_uint(TP[(tid * 2) * 16 + (code >> 4)]) & 127u, e2 = __float_as_uint(TP[(tid * 2 + 1) * 16 + (code & 15u)]) & 127u;
                ((LAS int*)SC)[tid * 16 + k] = (int)(e1 * 128u + e2); SC[2048 + tid * 16 + k] = ex[k] * rinv;
            }
        }
        __syncthreads();
        *(u32x4*)(ids + (size_t)row0 * 128 + tid * 4) = *(const LAS u32x4*)((LAS int*)SC + tid * 4);
        *(f32x4*)(wts + (size_t)row0 * 128 + tid * 4) = *(const LAS f32x4*)(SC + 2048 + tid * 4);
        __syncthreads();
    }
    for (size_t it = cv_pos + tid; it < cv_end; it += 512) convert_item(p, ws, it);
}

__device__ __forceinline__ void phase8(const Ctx& cx, const Params& p, LAS unsigned char* lds) {
    unsigned char* ws = p.ws; const unsigned char* EU = ws + OFF_EU; const unsigned char* EV = ws + OFF_EV;
    const int* ids = (const int*)(ws + OFF_IDS); const float* wts = (const float*)(ws + OFF_WTS);
    const float* ss2 = (const float*)(ws + OFF_SS2);
    const int tid = cx.tid, wid = __builtin_amdgcn_readfirstlane(tid >> 6), lane = tid & 63, fr = lane & 15, fq = lane >> 4;
    const int nfull = (NTOK / (cx.nb * 8)) * (cx.nb * 8);
    const unsigned char* ET = ws + OFF_EU;
    int nid0 = 0, nid1 = 0; float nw0 = 0.f, nw1 = 0.f, nr2 = 0.f;
    auto fetch_ids = [&](int r, int& i0_, int& i1_, float& a0, float& a1, float& rr) {
        i0_ = ids[(size_t)r * 128 + lane] & 16383; i1_ = ids[(size_t)r * 128 + 64 + lane] & 16383;
        a0 = wts[(size_t)r * 128 + lane]; a1 = wts[(size_t)r * 128 + 64 + lane];
        rr = rsq(ss2[r] * (1.f / 1024.f) + EPS) * (1.f / EU_SCALE);
    };
    if (cx.bid * 8 + wid < nfull) fetch_ids(cx.bid * 8 + wid, nid0, nid1, nw0, nw1, nr2);
    for (int r = cx.bid * 8 + wid; r < nfull; r += cx.nb * 8) {
        const int id0 = nid0, id1 = nid1; const float w0 = nw0, w1 = nw1, r2 = nr2;
        float* yr = yrow(p, r);
        f32x2 tq[4][8];
#pragma unroll
        for (int j = 0; j < 4; ++j)
#pragma unroll
            for (int q = 0; q < 4; ++q) { const f32x4 v = *(const f32x4*)(yr + (fr + 16 * j) * 16 + q * 4); tq[j][2 * q] = (f32x2){v[0], v[1]}; tq[j][2 * q + 1] = (f32x2){v[2], v[3]}; }
        if (r + cx.nb * 8 < nfull) fetch_ids(r + cx.nb * 8, nid0, nid1, nw0, nw1, nr2);
        f32x2 acc[4][8];
#pragma unroll
        for (int j = 0; j < 4; ++j)
#pragma unroll
            for (int q = 0; q < 8; ++q) acc[j][q] = (f32x2){0.f, 0.f};
#pragma unroll 2
        for (int it = 0; it < 32; ++it) {
            const int src = ((it & 15) << 2) + fq;
            const int e = it < 16 ? shl_(id0, src) : shl_(id1, src);
            const float w = it < 16 ? shl_(w0, src) : shl_(w1, src);
            const unsigned char* rp = ET + (size_t)e * 2048 + fr * 16;
            u32x4 du[4], dv[4];
#pragma unroll
            for (int j = 0; j < 4; ++j) { du[j] = *(const u32x4*)(rp + j * 256); dv[j] = *(const u32x4*)(rp + 1024 + j * 256); }
            f32x2 s2 = (f32x2){0.f, 0.f};
#pragma unroll
            for (int j = 0; j < 4; ++j)
#pragma unroll
                for (int q = 0; q < 4; ++q) {
                    s2 = __builtin_amdgcn_cvt_pk_f32_fp8((int)du[j][q], false) * tq[j][2 * q] + s2;
                    s2 = __builtin_amdgcn_cvt_pk_f32_fp8((int)du[j][q], true) * tq[j][2 * q + 1] + s2;
                }
            const float sd = row16_sum(s2[0] + s2[1]);
            const float c = w * gelu_t(r2 * sd) * (1.f / EV_SCALE); const f32x2 cc = (f32x2){c, c};
#pragma unroll
            for (int j = 0; j < 4; ++j)
#pragma unroll
                for (int q = 0; q < 4; ++q) {
                    acc[j][2 * q] = __builtin_amdgcn_cvt_pk_f32_fp8((int)dv[j][q], false) * cc + acc[j][2 * q];
                    acc[j][2 * q + 1] = __builtin_amdgcn_cvt_pk_f32_fp8((int)dv[j][q], true) * cc + acc[j][2 * q + 1];
                }
        }
        float ss = 0.f;
#pragma unroll
        for (int j = 0; j < 4; ++j)
#pragma unroll
            for (int q = 0; q < 8; ++q)
#pragma unroll
                for (int h2 = 0; h2 < 2; ++h2) { float v = acc[j][q][h2]; v += shx(v, 16, lane); v += shx(v, 32, lane); acc[j][q][h2] = v; }
        if (fq == 0) {
#pragma unroll
            for (int j = 0; j < 4; ++j)
#pragma unroll
                for (int q = 0; q < 4; ++q) {
                    const f32x4 xv = *(const f32x4*)(yr + (fr + 16 * j) * 16 + q * 4);
                    acc[j][2 * q][0] += xv[0]; acc[j][2 * q][1] += xv[1]; acc[j][2 * q + 1][0] += xv[2]; acc[j][2 * q + 1][1] += xv[3];
                    ss += acc[j][2 * q][0] * acc[j][2 * q][0] + acc[j][2 * q][1] * acc[j][2 * q][1] + acc[j][2 * q + 1][0] * acc[j][2 * q + 1][0] + acc[j][2 * q + 1][1] * acc[j][2 * q + 1][1];
                }
        }
        ss = wave_sum(ss, lane);
        const float rs = rsq(ss * (1.f / 1024.f) + EPS);
        if (fq == 0) {
#pragma unroll
            for (int j = 0; j < 4; ++j)
#pragma unroll
                for (int q = 0; q < 4; ++q) {
                    const f32x4 g0 = *(const f32x4*)(p.g_final + (fr + 16 * j) * 16 + q * 4);
                    *(f32x4*)(yr + (fr + 16 * j) * 16 + q * 4) = (f32x4){acc[j][2 * q][0], acc[j][2 * q][1], acc[j][2 * q + 1][0], acc[j][2 * q + 1][1]} * rs * g0;
                }
        }
    }
    LAS float* cfb = (LAS float*)lds; LAS float* part = (LAS float*)(lds + 4096);
    __syncthreads();
    for (int r = nfull + cx.bid; r < NTOK; r += cx.nb) {
        const int id0 = ids[(size_t)r * 128 + lane] & 16383, id1 = ids[(size_t)r * 128 + 64 + lane] & 16383;
        const float w0 = wts[(size_t)r * 128 + lane], w1 = wts[(size_t)r * 128 + 64 + lane];
        const float r2 = rsq(ss2[r] * (1.f / 1024.f) + EPS) * (1.f / EU_SCALE);
        float* yr = yrow(p, r);
        f32x2 tq[4][8];
#pragma unroll
        for (int j = 0; j < 4; ++j)
#pragma unroll
            for (int q = 0; q < 4; ++q) { const f32x4 v = *(const f32x4*)(yr + (fr + 16 * j) * 16 + q * 4); tq[j][2 * q] = (f32x2){v[0], v[1]}; tq[j][2 * q + 1] = (f32x2){v[2], v[3]}; }
#pragma unroll
        for (int i4 = 0; i4 < 4; ++i4) {
            const int it = wid * 4 + i4, src = ((it & 15) << 2) + fq;
            const int e = it < 16 ? shl_(id0, src) : shl_(id1, src);
            const float w = it < 16 ? shl_(w0, src) : shl_(w1, src);
            const unsigned char* rp = ET + (size_t)e * 2048 + fr * 16;
            u32x4 d[4];
#pragma unroll
            for (int j = 0; j < 4; ++j) d[j] = *(const u32x4*)(rp + j * 256);
            f32x2 s2 = (f32x2){0.f, 0.f};
#pragma unroll
            for (int j = 0; j < 4; ++j)
#pragma unroll
                for (int q = 0; q < 4; ++q) {
                    s2 = __builtin_amdgcn_cvt_pk_f32_fp8((int)d[j][q], false) * tq[j][2 * q] + s2;
                    s2 = __builtin_amdgcn_cvt_pk_f32_fp8((int)d[j][q], true) * tq[j][2 * q + 1] + s2;
                }
            const float sd = row16_sum(s2[0] + s2[1]);
            if (fr == 0) cfb[it * 4 + fq] = w * gelu_t(r2 * sd) * (1.f / EV_SCALE);
        }
        __syncthreads();
        const float c0 = cfb[lane], c1 = cfb[64 + lane];
        const int idsel = wid < 4 ? id0 : id1; const float csel = wid < 4 ? c0 : c1;
        f32x2 acc[8];
#pragma unroll
        for (int i = 0; i < 8; ++i) acc[i] = (f32x2){0.f, 0.f};
#pragma unroll
        for (int k16 = 0; k16 < 16; ++k16) {
            const int kk = (wid & 3) * 16 + k16;
            const int e = __builtin_amdgcn_readlane(idsel, kk); const float c = __int_as_float(__builtin_amdgcn_readlane(__float_as_int(csel), kk));
            const u32x4 v = *(const u32x4*)(ET + (size_t)e * 2048 + 1024 + lane * 16); const f32x2 cc = (f32x2){c, c};
#pragma unroll
            for (int q = 0; q < 4; ++q) { acc[2 * q] = __builtin_amdgcn_cvt_pk_f32_fp8((int)v[q], false) * cc + acc[2 * q]; acc[2 * q + 1] = __builtin_amdgcn_cvt_pk_f32_fp8((int)v[q], true) * cc + acc[2 * q + 1]; }
        }
#pragma unroll
        for (int q = 0; q < 4; ++q) *(LAS f32x4*)(part + (wid * 64 + lane) * 16 + q * 4) = (f32x4){acc[2 * q][0], acc[2 * q][1], acc[2 * q + 1][0], acc[2 * q + 1][1]};
        __syncthreads();
        if (wid == 0) {
            float ss = 0.f; f32x4 x[4];
#pragma unroll
            for (int j = 0; j < 4; ++j) {
                x[j] = *(const f32x4*)(yr + lane * 16 + j * 4);
#pragma unroll
                for (int w8 = 0; w8 < 8; ++w8) x[j] += *(const LAS f32x4*)(part + (w8 * 64 + lane) * 16 + j * 4);
                ss += x[j][0] * x[j][0] + x[j][1] * x[j][1] + x[j][2] * x[j][2] + x[j][3] * x[j][3];
            }
            ss = wave_sum(ss, lane);
            const float rs = rsq(ss * (1.f / 1024.f) + EPS);
#pragma unroll
            for (int j = 0; j < 4; ++j) { const f32x4 g0 = *(const f32x4*)(p.g_final + lane * 16 + j * 4); *(f32x4*)(yr + lane * 16 + j * 4) = x[j] * rs * g0; }
        }
        __syncthreads();
    }
}

__device__ __forceinline__ void strip_mma(const bf16_t* A, int lda, const bf16_t* Bt, int ldb, int K, int c, int wid, int fr, int fq, f32x4 (&acc)[2]) {
#pragma unroll 2
    for (int ks = 0; ks < K / 32; ks += 4) {
        bf16x8 a[2][4], b[4];
#pragma unroll
        for (int u = 0; u < 4; ++u) {
            b[u] = *(const bf16x8*)(Bt + (size_t)(16 * c + fr) * ldb + (ks + u) * 32 + fq * 8);
#pragma unroll
            for (int i = 0; i < 2; ++i) a[i][u] = *(const bf16x8*)(A + (size_t)((2 * wid + i) * 16 + fr) * lda + (ks + u) * 32 + fq * 8);
        }
#pragma unroll
        for (int u = 0; u < 4; ++u)
#pragma unroll
            for (int i = 0; i < 2; ++i) acc[i] = MFMA16(a[i][u], b[u], acc[i]);
    }
}
__device__ __forceinline__ void sample_merge(const Ctx& cx, const Params& p) {
    unsigned char* ws = p.ws; const bf16_t* Zs = (const bf16_t*)(ws + OFF_Z) + (size_t)16384 * INC; bf16_t* M1 = (bf16_t*)(ws + OFF_M1) + (size_t)16384 * 1024;
    const int tid = cx.tid, wid = __builtin_amdgcn_readfirstlane(tid >> 6), lane = tid & 63, fr = lane & 15, fq = lane >> 4;
    for (int c = cx.bid; c < 64; c += cx.nb) {
        f32x4 aa[2] = {(f32x4){0.f, 0.f, 0.f, 0.f}, (f32x4){0.f, 0.f, 0.f, 0.f}}, ab[2] = {(f32x4){0.f, 0.f, 0.f, 0.f}, (f32x4){0.f, 0.f, 0.f, 0.f}};
        strip_mma(Zs, INC, (const bf16_t*)(ws + OFF_WA), 1024, 1024, c, wid, fr, fq, aa);
#pragma unroll 1
        for (int hh = 0; hh < 4; ++hh) {
            f32x4 ah[2] = {(f32x4){0.f, 0.f, 0.f, 0.f}, (f32x4){0.f, 0.f, 0.f, 0.f}};
            strip_mma(Zs + 4096 + hh * 512, INC, (const bf16_t*)(ws + OFF_WB) + hh * 512, 2048, 512, c, wid, fr, fq, ah);
#pragma unroll
            for (int i = 0; i < 2; ++i)
#pragma unroll
                for (int j = 0; j < 4; ++j) ab[i][j] += ah[i][j] * rsq(((const float*)(ws + OFF_SSO))[(size_t)(16384 + (2 * wid + i) * 16 + fq * 4 + j) * 4 + hh] * (1.f / 512.f) + EPS);
        }
#pragma unroll
        for (int i = 0; i < 2; ++i)
#pragma unroll
            for (int j = 0; j < 4; ++j) {
                const int row = (2 * wid + i) * 16 + fq * 4 + j, col = 16 * c + fr;
                const float ga = bf_lo((unsigned)Zs[(size_t)row * INC + 8192 + col]), gb = bf_lo((unsigned)Zs[(size_t)row * INC + 9216 + col]);
                M1[(size_t)row * 1024 + col] = f2bf(ga * aa[i][j] + gb * ab[i][j]);
            }
    }
}
__device__ __forceinline__ void sample_x2(const Ctx& cx, const Params& p) {
    unsigned char* ws = p.ws; bf16_t* X2b = (bf16_t*)(ws + OFF_X2B) + (size_t)16384 * 1024; float* ss2 = (float*)(ws + OFF_SS2) + 16384;
    const int tid = cx.tid, wid = __builtin_amdgcn_readfirstlane(tid >> 6), lane = tid & 63, fr = lane & 15, fq = lane >> 4;
    for (int c = cx.bid; c < 64; c += cx.nb) {
        f32x4 acc[2] = {(f32x4){0.f, 0.f, 0.f, 0.f}, (f32x4){0.f, 0.f, 0.f, 0.f}};
        strip_mma((const bf16_t*)(ws + OFF_M1) + (size_t)16384 * 1024, 1024, (const bf16_t*)(ws + OFF_WO), 1024, 1024, c, wid, fr, fq, acc);
#pragma unroll
        for (int i = 0; i < 2; ++i)
#pragma unroll
            for (int j = 0; j < 4; ++j) {
                const int row = (2 * wid + i) * 16 + fq * 4 + j, col = 16 * c + fr;
                const float v = p.xs[(size_t)row * 1024 + col] + acc[i][j];
                p.out[O_YS + (size_t)row * 1024 + col] = v; X2b[(size_t)row * 1024 + col] = f2bf(v);
                const float sq = row16_sum(v * v);
                if (fr == 0) atomicAdd(ss2 + row, sq);
            }
    }
}
__device__ __forceinline__ void sample_query(const Ctx& cx, const Params& p) {
    unsigned char* ws = p.ws; bf16_t* QP = (bf16_t*)(ws + OFF_QP) + (size_t)16384 * 2048; const float* ss2 = (const float*)(ws + OFF_SS2) + 16384;
    const int tid = cx.tid, wid = __builtin_amdgcn_readfirstlane(tid >> 6), lane = tid & 63, fr = lane & 15, fq = lane >> 4;
    for (int c = cx.bid; c < 128; c += cx.nb) {
        f32x4 acc[2] = {(f32x4){0.f, 0.f, 0.f, 0.f}, (f32x4){0.f, 0.f, 0.f, 0.f}};
        strip_mma((const bf16_t*)(ws + OFF_X2B) + (size_t)16384 * 1024, 1024, (const bf16_t*)(ws + OFF_WQ), 1024, 1024, c, wid, fr, fq, acc);
#pragma unroll
        for (int i = 0; i < 2; ++i)
#pragma unroll
            for (int j = 0; j < 4; ++j) {
                const int row = (2 * wid + i) * 16 + fq * 4 + j, col = 16 * c + fr;
                QP[(size_t)row * 2048 + col] = f2bf(acc[i][j] * rsq(ss2[row] * (1.f / 1024.f) + EPS));
            }
    }
}

__device__ __forceinline__ void run_phase(const Params& p, LAS unsigned char* lds, int ph, const Ctx& cx) {
    unsigned char* ws = p.ws; pg8::StaticOrder S; pg8::Gemm g;
    bf16_t* Z = (bf16_t*)(ws + OFF_Z); bf16_t* T1 = (bf16_t*)((unsigned char*)p.out + OUT_T1);
    if (ph == 0) { phase0(cx, p, lds); return; }
    if (ph >= 1 && ph <= 8) {
        const int hf = (ph - 1) >> 2, sub = (ph - 1) & 3, rowbase = hf ? NH0 : 0, nM = hf ? 64 : 65;
        if (sub == 0) {
            g.A = (const bf16_t*)((unsigned char*)p.out + OUT_XB) + (size_t)rowbase * 1024; g.Bt = (const bf16_t*)(ws + OFF_WIN); g.lda = 1024; g.ldb = 1024; g.K = 1024;
            S.init(nM, 40, cx.nb, cx.bid);
            EpiIn E{Z, (const float*)(ws + OFF_R1), (float*)(ws + OFF_SSV), p.b_gate, rowbase};
            pg8::gemm_phase(cx, lds, g, S, E);
        } else if (sub == 1) phase2(cx, p, lds, hf);
#ifdef DBG_SKIP_P3
        else if (sub == 2) { }
#else
        else if (sub == 2) { }
#endif
        else {
            S.init(64, 4, cx.nb, cx.bid);
            g.A = Z; g.Bt = (const bf16_t*)(ws + OFF_WA); g.lda = INC; g.ldb = 1024; g.K = 1024;
            EpiT1 E1{T1, Z}; pg8::gemm_phase(cx, lds, g, S, E1);
            g.A = Z + 4096; g.Bt = (const bf16_t*)(ws + OFF_WB); g.lda = INC; g.ldb = 2048; g.K = 2048;
            EpiM1 E2{T1, Z, (bf16_t*)(ws + OFF_M1), rowbase, (const float*)(ws + OFF_SSO)}; pg8::gemm_phase(cx, lds, g, S, E2);
            if (hf == 0) sample_merge(cx, p);
        }
        return;
    }
#ifdef DBG_YCONST
    if (ph >= 9 && ph <= 11) return;
#endif
    if (ph == 9) {
        g.A = (const bf16_t*)(ws + OFF_M1); g.Bt = (const bf16_t*)(ws + OFF_WO); g.lda = 1024; g.ldb = 1024; g.K = 1024;
        S.init(128, 4, cx.nb, cx.bid, 64);
        EpiX2 E{p.xp, p.xs, p.out, (bf16_t*)(ws + OFF_X2B), (float*)(ws + OFF_SS2)}; pg8::gemm_phase(cx, lds, g, S, E);
        sample_x2(cx, p); return;
    }
    if (ph == 10) {
        g.A = (const bf16_t*)(ws + OFF_X2B); g.Bt = (const bf16_t*)(ws + OFF_WQ); g.lda = 1024; g.ldb = 1024; g.K = 1024;
        S.init(128, 8, cx.nb, cx.bid, 64);
        EpiQP E{(bf16_t*)(ws + OFF_QP), (const float*)(ws + OFF_SS2)}; pg8::gemm_phase(cx, lds, g, S, E);
        sample_query(cx, p); return;
    }
    if (ph == 11) { phase7(cx, p, lds); return; }
    if (ph == 12) { phase8(cx, p, lds); return; }
}
constexpr int NPHASE = 13;

extern __shared__ __attribute__((aligned(16))) unsigned char dyn_smem[];

#if ONE_LAUNCH
__device__ __forceinline__ void grid_barrier(unsigned* ctr, unsigned target, int tid) {
    asm volatile("s_waitcnt vmcnt(0)" ::: "memory");
    __syncthreads();
    if (tid == 0) {
        __builtin_amdgcn_fence(__ATOMIC_RELEASE, "agent");
        asm volatile("s_waitcnt vmcnt(0)" ::: "memory");
        __hip_atomic_fetch_add(ctr, 1u, __ATOMIC_RELAXED, __HIP_MEMORY_SCOPE_AGENT);
        while (__hip_atomic_load(ctr, __ATOMIC_RELAXED, __HIP_MEMORY_SCOPE_AGENT) < target) __builtin_amdgcn_s_sleep(2);
        __builtin_amdgcn_fence(__ATOMIC_ACQUIRE, "agent");
        asm volatile("s_waitcnt vmcnt(0)" ::: "memory");
    }
    __syncthreads();
}
__global__ __launch_bounds__(512, 2) void mega_kernel(Params p) {
#if defined(__HIP_DEVICE_COMPILE__)
    LAS unsigned char* lds = (LAS unsigned char*)dyn_smem;
    cg::grid_group grid = cg::this_grid();
    const int wave0 = __builtin_amdgcn_readfirstlane((int)threadIdx.x >> 6);
    unsigned nbar = 0;
    { int never = 0; asm volatile("" : "+s"(never));
      if (never == 1000) grid.sync(); }
#pragma nounroll
    for (int ph = 0; ph < NPHASE; ++ph) {
        int phv = ph; asm volatile("" : "+s"(phv));
        int wv = wave0; asm volatile("" : "+s"(wv));
        int ln = (int)__builtin_amdgcn_mbcnt_hi(~0u, __builtin_amdgcn_mbcnt_lo(~0u, 0u)); asm volatile("" : "+v"(ln));
        Ctx cx; cx.tid = wv * 64 + ln; cx.bid = blockIdx.x; cx.nb = gridDim.x;
        asm volatile("" : "+s"(cx.bid)); asm volatile("" : "+s"(cx.nb));
        auto ka = __builtin_amdgcn_kernarg_segment_ptr(); asm volatile("" : "+s"(ka));
        const Params pl = *(const Params __attribute__((address_space(4)))*)(unsigned long long)ka;
        unsigned lo = 0; asm volatile("" : "+s"(lo));
        if (ph == 3 || ph == 7) continue;
        run_phase(pl, lds + lo, phv, cx);
        if (ph + 1 < NPHASE) { ++nbar; grid_barrier((unsigned*)(pl.ws + OFF_BAR), nbar * (unsigned)cx.nb, cx.tid); }
    }
#endif
}
#else
__global__ __launch_bounds__(512, 2) void stage_kernel(Params p, int ph) {
    LAS unsigned char* lds = (LAS unsigned char*)dyn_smem;
    Ctx cx; cx.tid = threadIdx.x; cx.bid = blockIdx.x; cx.nb = gridDim.x;
    run_phase(p, lds, ph, cx);
}
#endif

extern "C" void kernel_launch(void* const* d_in, const int* in_sizes, int n_in, void* d_out, int out_size, void* d_ws, size_t ws_size, hipStream_t stream) {
    Params p; memset(&p, 0, sizeof(p));
    p.xp = (const float*)d_in[0]; p.xs = (const float*)d_in[1]; p.state = (const float*)d_in[2]; p.w_in = (const float*)d_in[3]; p.w_s = (const float*)d_in[4];
    p.b_s = (const float*)d_in[5]; p.g_sgu = (const float*)d_in[6]; p.w_pa = (const float*)d_in[7]; p.w_pb = (const float*)d_in[8]; p.b_gate = (const float*)d_in[9];
    p.w_out = (const float*)d_in[10]; p.g_mix = (const float*)d_in[11]; p.g_ffn = (const float*)d_in[12]; p.w_q = (const float*)d_in[13]; p.k1 = (const float*)d_in[14];
    p.k2 = (const float*)d_in[15]; p.eu = (const float*)d_in[16]; p.ev = (const float*)d_in[17]; p.g_final = (const float*)d_in[18];
    p.out = (float*)d_out; p.ws = (unsigned char*)d_ws;
    if (ws_size < WS_NEED) { fprintf(stderr, "workspace too small: %zu < %zu\n", ws_size, (size_t)WS_NEED); return; }
#if ONE_LAUNCH
    static int grid_blocks = 0;
    if (!grid_blocks) {
        (void)hipFuncSetAttribute((const void*)mega_kernel, hipFuncAttributeMaxDynamicSharedMemorySize, LDS_BYTES);
        int dev = 0, cus = 0, per_cu = 0;
        hipGetDevice(&dev); hipDeviceGetAttribute(&cus, hipDeviceAttributeMultiprocessorCount, dev);
        hipOccupancyMaxActiveBlocksPerMultiprocessor(&per_cu, mega_kernel, 512, LDS_BYTES);
        if (per_cu < 1) per_cu = 1;
        grid_blocks = cus * 1;
    }
    (void)hipMemsetAsync((unsigned char*)d_ws + OFF_BAR, 0, 256, stream);
    void* args[] = {&p};
    hipError_t e = hipLaunchCooperativeKernel((const void*)mega_kernel, dim3(grid_blocks), dim3(512), args, LDS_BYTES, stream);
    if (e != hipSuccess) fprintf(stderr, "cooperative launch failed: %s (grid %d)\n", hipGetErrorString(e), grid_blocks);
#else
    static bool attr = false;
    if (!attr) { (void)hipFuncSetAttribute((const void*)stage_kernel, hipFuncAttributeMaxDynamicSharedMemorySize, LDS_BYTES); attr = true; }
    for (int ph = 0; ph < NPHASE; ++ph) hipLaunchKernelGGL(stage_kernel, dim3(256), dim3(512), LDS_BYTES, stream, p, ph);
#endif
}
```

```cpp
#include <hip/hip_runtime.h>
#include <hip/hip_cooperative_groups.h>
#include <cstdio>
#include <cstring>
namespace cg = cooperative_groups;

#ifndef ONE_LAUNCH
#define ONE_LAUNCH 1
#endif

#define LAS __attribute__((address_space(3)))
typedef unsigned short bf16_t;
typedef short bf16x8 __attribute__((ext_vector_type(8)));
typedef float f32x4 __attribute__((ext_vector_type(4)));
typedef unsigned u32x4 __attribute__((ext_vector_type(4)));
typedef unsigned u32x2 __attribute__((ext_vector_type(2)));
typedef __bf16 bf16x2_t __attribute__((ext_vector_type(2)));

constexpr int DM = 1024, NTOK = 33024, NH0 = 16640, INC = 10240;
constexpr float EPS = 1e-6f;
constexpr int LDS_BYTES = 153600;
constexpr float EU_SCALE = 64.f, EV_SCALE = 64.f;

constexpr size_t OFF_WIN = 0;
constexpr size_t OFF_WA  = OFF_WIN + (size_t)10240 * 1024 * 2;
constexpr size_t OFF_WB  = OFF_WA + (size_t)1024 * 1024 * 2;
constexpr size_t OFF_WO  = OFF_WB + (size_t)1024 * 2048 * 2;
constexpr size_t OFF_WQ  = OFF_WO + (size_t)1024 * 1024 * 2;
constexpr size_t OFF_EU  = OFF_WQ + (size_t)2048 * 1024 * 2;
constexpr size_t OFF_EV  = OFF_EU + (size_t)16384 * 1024 * 2;
constexpr size_t OFF_K1  = OFF_EV + (size_t)16384 * 1024 * 2;
constexpr size_t OFF_K2  = OFF_K1 + 32768;
constexpr size_t OFF_M1  = OFF_K2 + 32768;
constexpr size_t OFF_R1  = OFF_M1 + (size_t)NTOK * 1024 * 2;
constexpr size_t OFF_SSV = OFF_R1 + (size_t)NTOK * 4;
constexpr size_t OFF_SS2 = OFF_SSV + (size_t)NTOK * 4;
constexpr size_t OFF_SSO = OFF_SS2 + (size_t)NTOK * 4;
constexpr size_t OFF_Z   = OFF_SSO + (size_t)NTOK * 16;
constexpr size_t Z_BYTES = (size_t)NH0 * INC * 2;
constexpr size_t OFF_BAR = OFF_Z + Z_BYTES;
constexpr size_t WS_NEED = OFF_BAR + 256;
constexpr size_t OFF_X2B = OFF_Z;
constexpr size_t OFF_QP  = OFF_X2B + (size_t)NTOK * 1024 * 2;
constexpr size_t OFF_IDS = OFF_QP + (size_t)NTOK * 2048 * 2;
constexpr size_t OFF_WTS = OFF_IDS + (size_t)NTOK * 128 * 4;
constexpr size_t OUT_XB = 0;
constexpr size_t OUT_T1 = (size_t)NTOK * 1024 * 2;
constexpr size_t O_YP = 0, O_YS = (size_t)32768 * 1024, O_SP = O_YS + (size_t)256 * 1024, O_SS = O_SP + (size_t)16 * 4 * 256 * 512,
                 O_SV = O_SS + (size_t)16 * 4 * 256 * 512;

struct Params {
    const float *xp, *xs, *state, *w_in, *w_s, *b_s, *g_sgu, *w_pa, *w_pb, *b_gate, *w_out, *g_mix, *g_ffn, *w_q, *k1, *k2, *eu, *ev, *g_final;
    float* out;
    unsigned char* ws;
};

struct Ctx { int tid, bid, nb; };

__device__ __forceinline__ float bf_lo(unsigned u) { return __uint_as_float(u << 16); }
__device__ __forceinline__ float bf_hi(unsigned u) { return __uint_as_float(u & 0xffff0000u); }
typedef float f32x2 __attribute__((ext_vector_type(2)));
__device__ __forceinline__ unsigned pk_bf16(float lo, float hi) {
    f32x2 v = {lo, hi}; bf16x2_t b = __builtin_convertvector(v, bf16x2_t); return __builtin_bit_cast(unsigned, b);
}
__device__ __forceinline__ bf16_t f2bf(float f) { return (bf16_t)(pk_bf16(f, 0.f) & 0xffffu); }
__device__ __forceinline__ float fexp2(float x) { return __builtin_amdgcn_exp2f(x); }
__device__ __forceinline__ float frcp(float x) { return __builtin_amdgcn_rcpf(x); }
__device__ __forceinline__ float sigm(float x) { return frcp(1.f + fexp2(-1.44269504f * x)); }
__device__ __forceinline__ float gelu_t(float x) { const float u = 0.7978845608f * (x + 0.044715f * x * x * x); return x * frcp(1.f + fexp2(-2.88539008f * u)); }
__device__ __forceinline__ float rsq(float x) { return __builtin_amdgcn_rsqf(x); }
__device__ __forceinline__ f32x2 gelu_t2(f32x2 x) {
    const f32x2 w = (x * x) * (-0.10294324f) + (-2.3022082f), t = x * w;
    f32x2 e; e.x = fexp2(t.x); e.y = fexp2(t.y);
    const f32x2 d = e + 1.f;
    f32x2 r; r.x = frcp(d.x); r.y = frcp(d.y);
    return x * r;
}
__device__ __forceinline__ const float* xrow(const Params& p, int ir) {
    return ir < 16384 ? p.xp + (size_t)ir * 1024 : (ir < 16640 ? p.xs + (size_t)(ir - 16384) * 1024 : p.xp + (size_t)(ir - 256) * 1024);
}
__device__ __forceinline__ float* yrow(const Params& p, int ir) {
    return ir < 16384 ? p.out + O_YP + (size_t)ir * 1024 : (ir < 16640 ? p.out + O_YS + (size_t)(ir - 16384) * 1024 : p.out + O_YP + (size_t)(ir - 256) * 1024);
}
__device__ __forceinline__ float shx(float v, int m, int lane) { return __int_as_float(__builtin_amdgcn_ds_bpermute((lane ^ m) << 2, __float_as_int(v))); }
__device__ __forceinline__ float shl_(float v, int src) { return __int_as_float(__builtin_amdgcn_ds_bpermute(src << 2, __float_as_int(v))); }
__device__ __forceinline__ int shl_(int v, int src) { return __builtin_amdgcn_ds_bpermute(src << 2, v); }
__device__ __forceinline__ float wave_sum(float v, int lane) {
#pragma unroll
    for (int o = 32; o >= 1; o >>= 1) v += shx(v, o, lane);
    return v;
}
__device__ __forceinline__ float row16_sum(float s) {
    s += __int_as_float(__builtin_amdgcn_update_dpp(0, __float_as_int(s), 0xB1, 0xF, 0xF, true));
    s += __int_as_float(__builtin_amdgcn_update_dpp(0, __float_as_int(s), 0x4E, 0xF, 0xF, true));
    s += __int_as_float(__builtin_amdgcn_update_dpp(0, __float_as_int(s), 0x141, 0xF, 0xF, true));
    s += __int_as_float(__builtin_amdgcn_update_dpp(0, __float_as_int(s), 0x140, 0xF, 0xF, true));
    return s;
}
__device__ __forceinline__ float dot2bf(unsigned a, unsigned b, float c) {
    return __builtin_amdgcn_fdot2_f32_bf16(__builtin_bit_cast(bf16x2_t, a), __builtin_bit_cast(bf16x2_t, b), c, false);
}
typedef short s16x4 __attribute__((ext_vector_type(4)));
__device__ __forceinline__ bf16x8 tr_frag(const LAS bf16_t* tile, int stride, int lane) {
    const LAS bf16_t* a0 = tile + (8 * (lane >> 4) + ((lane >> 2) & 3)) * stride + 4 * (lane & 3);
    const s16x4 lo = __builtin_amdgcn_ds_read_tr16_b64_v4i16((LAS s16x4*)a0), hi = __builtin_amdgcn_ds_read_tr16_b64_v4i16((LAS s16x4*)(a0 + 4 * stride));
    return (bf16x8){lo[0], lo[1], lo[2], lo[3], hi[0], hi[1], hi[2], hi[3]};
}
#define MFMA16(a, b, c) __builtin_amdgcn_mfma_f32_16x16x32_bf16((a), (b), (c), 0, 0, 0)

namespace pg8 {
constexpr int BM = 256, BK = 64, HALF = 128, HTB = HALF * BK * 2, STAGE_BYTES = 8 * HTB, NXCD = 8, WGM = 8;
__device__ __forceinline__ int lds_byte(int r, int c) { const int st = (r >> 4) * 2 + (c >> 5), rr = r & 15, cc = c & 31, ob = rr * 64 + cc * 2; return st * 1024 + (ob ^ (((ob >> 9) & 1) << 5)); }
__device__ __forceinline__ void stage_rc(int b, int& R, int& C) { const int st = b / 1024, sb = b % 1024, swz = sb ^ (((sb >> 9) & 1) << 5); R = (st >> 1) * 16 + swz / 64; C = (st & 1) * 32 + (swz % 64) / 2; }
__device__ __forceinline__ int perm32(int rho) { const int n = rho >> 4, i = rho & 15; return 8 * (i >> 2) + 4 * n + (i & 3); }
struct Unit { int pm, pn; };
struct Gemm { const bf16_t* A; const bf16_t* Bt; int lda, ldb, K; };
struct StaticOrder {
    int nM, nN, nwg, G, c, skip;
    __device__ void init(int nM_, int nN_, int G_, int c_, int skip_ = 1 << 30) { nM = nM_; nN = nN_; nwg = nM * nN; G = G_; c = c_; skip = skip_; }
    __device__ bool next(int i, Unit& u) const {
        const long L = (long)i * G + c; if (L >= nwg) return false;
        int wgid = (int)L; { const int q = nwg / NXCD, r = nwg % NXCD, xcd = wgid % NXCD, off = wgid / NXCD; wgid = (xcd < r ? xcd * (q + 1) : r * (q + 1) + (xcd - r) * q) + off; }
        const int nig = WGM * nN, gid = wgid / nig, fm = gid * WGM, gsz = (nM - fm) < WGM ? (nM - fm) : WGM;
        u.pm = fm + ((wgid % nig) % gsz); u.pn = (wgid % nig) / gsz; if (u.pm >= skip) ++u.pm; return true;
    }
};

template <class Epi>
__device__ __forceinline__ void gemm_phase(const Ctx& cx, LAS unsigned char* lds, const Gemm g, const StaticOrder& S, const Epi& E) {
    const int tid = cx.tid, wid = __builtin_amdgcn_readfirstlane(tid >> 6), lane = tid & 63, wr = wid >> 2, wc = wid & 3, fr = lane & 15, fq = lane >> 4;
    const int K = g.K, nt = K / BK;
    unsigned voffA[2], voffB[2];
#pragma unroll
    for (int i = 0; i < 2; ++i) { int R, C; stage_rc(tid * 16 + i * 8192, R, C); const int Rb = (R & ~31) + perm32(R & 31);
        voffA[i] = (unsigned)(R * g.lda + C) * 2u; voffB[i] = (unsigned)(Rb * g.ldb + C) * 2u; }
    const size_t kstep = (size_t)(BK * 2);
    const size_t hstepA = (size_t)HALF * g.lda * 2, hstepB = (size_t)HALF * g.ldb * 2;
    const size_t tstepA = 2 * hstepA, tstepB = 2 * hstepB;
    const unsigned ldsw = (unsigned)wid * 1024u;
    const int aoff = lds_byte(wr * 64 + fr, fq * 8), boff = lds_byte(wc * 32 + fr, fq * 8);
#define PG8_SA(b, h) (((b) * 2 + (h)) * HTB)
#define PG8_SB(b, h) ((4 + (b) * 2 + (h)) * HTB)
#define PG8_STAGE(bufoff, gbase, voff) do { _Pragma("unroll") for (int _i = 0; _i < 2; ++_i) \
        __builtin_amdgcn_global_load_lds((const unsigned*)((const char*)(gbase) + (voff)[_i]), (LAS unsigned*)(lds + (bufoff) + ldsw + _i * 8192), 16, 0, 0); } while (0)
#define PG8_LDA(dst, b, h) do { _Pragma("unroll") for (int m = 0; m < 4; ++m) _Pragma("unroll") for (int k = 0; k < 2; ++k) dst[m][k] = *(const LAS bf16x8*)(lds + PG8_SA(b, h) + aoff + m * 2048 + k * 1024); } while (0)
#define PG8_LDB(dst, b, h) do { _Pragma("unroll") for (int n = 0; n < 2; ++n) _Pragma("unroll") for (int k = 0; k < 2; ++k) dst[n][k] = *(const LAS bf16x8*)(lds + PG8_SB(b, h) + boff + n * 2048 + k * 1024); } while (0)
#define PG8_MMA(ai, bj, At, Bt) do { __builtin_amdgcn_s_setprio(1); _Pragma("unroll") for (int m = 0; m < 4; ++m) _Pragma("unroll") for (int n = 0; n < 2; ++n) _Pragma("unroll") for (int k = 0; k < 2; ++k) \
        acc[ai][bj][m][n] = __builtin_amdgcn_mfma_f32_16x16x32_bf16(Bt[n][k], At[m][k], acc[ai][bj][m][n], 0, 0, 0); __builtin_amdgcn_s_setprio(0); } while (0)
#define PG8_WAIT_V(n) asm volatile("s_waitcnt vmcnt(" #n ")" ::: "memory")
#define PG8_WAIT_L(n) asm volatile("s_waitcnt lgkmcnt(" #n ")" ::: "memory")
#define PG8_BAR __builtin_amdgcn_s_barrier()
#define PG8_SCHED __builtin_amdgcn_sched_barrier(0)
    Unit cur, nxt; int ui = 0;
    if (!S.next(0, cur)) return;
    f32x4 acc[2][2][4][2];
#pragma unroll
    for (int a = 0; a < 2; ++a)
#pragma unroll
        for (int b = 0; b < 2; ++b)
#pragma unroll
            for (int m = 0; m < 4; ++m)
#pragma unroll
                for (int n = 0; n < 2; ++n) acc[a][b][m][n] = (f32x4){0.f, 0.f, 0.f, 0.f};
    bf16x8 At[4][2], B0[2][2], B1[2][2];
    const char* cA = (const char*)g.A + (size_t)cur.pm * tstepA; const char* cB = (const char*)g.Bt + (size_t)cur.pn * tstepB;
    if constexpr (Epi::RESCALE) E.prep((LAS float*)(lds + STAGE_BYTES), cur, tid);
    PG8_STAGE(PG8_SB(0, 0), cB, voffB); PG8_STAGE(PG8_SA(0, 0), cA, voffA); PG8_STAGE(PG8_SB(0, 1), cB + hstepB, voffB); PG8_STAGE(PG8_SA(0, 1), cA + hstepA, voffA);
    if (wr == 1) PG8_BAR;
    PG8_WAIT_V(4); PG8_BAR;
    PG8_STAGE(PG8_SB(1, 0), cB + kstep, voffB); PG8_STAGE(PG8_SA(1, 0), cA + kstep, voffA); PG8_STAGE(PG8_SB(1, 1), cB + hstepB + kstep, voffB);
    PG8_WAIT_V(6); PG8_BAR;
    for (;;) {
        const bool has_next = S.next(ui + 1, nxt);
        if constexpr (Epi::RESCALE) { if (has_next) E.prep((LAS float*)(lds + STAGE_BYTES) + ((ui + 1) & 1) * 1024, nxt, tid); }
        const char* nA = has_next ? (const char*)g.A + (size_t)nxt.pm * tstepA : cA; const char* nB = has_next ? (const char*)g.Bt + (size_t)nxt.pn * tstepB : cB;
        for (int t = 0; t < nt; t += 2) {
            const bool last = (t == nt - 2);
            const char* a1 = cA + (size_t)(t + 1) * kstep;
            const char* a2 = last ? nA : cA + (size_t)(t + 2) * kstep; const char* b2 = last ? nB : cB + (size_t)(t + 2) * kstep;
            const char* a3 = a2 + kstep; const char* b3 = b2 + kstep;
            PG8_LDB(B0, 0, 0); PG8_SCHED; PG8_LDA(At, 0, 0); PG8_STAGE(PG8_SA(1, 1), a1 + hstepA, voffA);
            PG8_WAIT_L(8); PG8_BAR; PG8_WAIT_L(0); PG8_MMA(0, 0, At, B0); PG8_BAR; PG8_SCHED;
            PG8_LDB(B1, 0, 1); PG8_STAGE(PG8_SB(0, 0), b2, voffB);
            PG8_BAR; PG8_WAIT_L(0); PG8_MMA(0, 1, At, B1); PG8_BAR;
            PG8_LDA(At, 0, 1); PG8_STAGE(PG8_SA(0, 0), a2, voffA);
            PG8_BAR; PG8_WAIT_L(0); PG8_MMA(1, 0, At, B0); PG8_BAR; PG8_SCHED;
            PG8_STAGE(PG8_SB(0, 1), b2 + hstepB, voffB);
            PG8_WAIT_V(6); PG8_BAR; PG8_MMA(1, 1, At, B1); PG8_BAR;
            PG8_LDB(B0, 1, 0); PG8_SCHED; PG8_LDA(At, 1, 0); PG8_STAGE(PG8_SA(0, 1), a2 + hstepA, voffA);
            PG8_WAIT_L(8); PG8_BAR; PG8_WAIT_L(0); PG8_MMA(0, 0, At, B0); PG8_BAR; PG8_SCHED;
            PG8_LDB(B1, 1, 1); PG8_STAGE(PG8_SB(1, 0), b3, voffB);
            PG8_BAR; PG8_WAIT_L(0); PG8_MMA(0, 1, At, B1); PG8_BAR;
            PG8_LDA(At, 1, 1); PG8_STAGE(PG8_SA(1, 0), a3, voffA);
            PG8_BAR; PG8_WAIT_L(0); PG8_MMA(1, 0, At, B0); PG8_BAR; PG8_SCHED;
            PG8_STAGE(PG8_SB(1, 1), b3 + hstepB, voffB);
            PG8_WAIT_V(6); PG8_BAR; PG8_MMA(1, 1, At, B1); PG8_BAR;
            if constexpr (Epi::RESCALE) { if (((t + 2) & 7) == 0 && t + 2 < nt) E.mid(acc, (const LAS float*)(lds + STAGE_BYTES) + (ui & 1) * 1024, ((t + 2) >> 3) - 1, wr, fr); }
        }
        if constexpr (Epi::RESCALE) E.fin(acc, (const LAS float*)(lds + STAGE_BYTES) + (ui & 1) * 1024, cur, wr, wc, fr, fq); else E(acc, cur, wr, wc, fr, fq);
        if (!has_next) break;
#pragma unroll
        for (int a = 0; a < 2; ++a)
#pragma unroll
            for (int b = 0; b < 2; ++b)
#pragma unroll
                for (int m = 0; m < 4; ++m)
#pragma unroll
                    for (int n = 0; n < 2; ++n) acc[a][b][m][n] = (f32x4){0.f, 0.f, 0.f, 0.f};
        cur = nxt; cA = nA; cB = nB; ++ui;
    }
    PG8_WAIT_V(0);
    if (wr == 0) PG8_BAR;
    PG8_BAR;
#undef PG8_SA
#undef PG8_SB
#undef PG8_STAGE
#undef PG8_LDA
#undef PG8_LDB
#undef PG8_MMA
#undef PG8_WAIT_V
#undef PG8_WAIT_L
#undef PG8_BAR
#undef PG8_SCHED
}
}
using pg8::Unit;

__device__ __forceinline__ u32x4 pack8(const float (&v)[8]) { return (u32x4){pk_bf16(v[0], v[1]), pk_bf16(v[2], v[3]), pk_bf16(v[4], v[5]), pk_bf16(v[6], v[7])}; }
__device__ __forceinline__ void unpack8(const u32x4 u, float (&v)[8]) {
#pragma unroll
    for (int q = 0; q < 4; ++q) { v[2 * q] = bf_lo(u[q]); v[2 * q + 1] = bf_hi(u[q]); }
}

struct EpiIn {
    static constexpr bool RESCALE = false;
    bf16_t* Z; const float* r1; float* ssv; const float* b_gate; int rowbase;
    __device__ __forceinline__ void operator()(const f32x4 (&acc)[2][2][4][2], const Unit& u, int wr, int wc, int fr, int fq) const {
        const int pn = u.pn, lane = fr + 16 * fq;
        const int kind = pn < 4 ? 0 : pn < 8 ? 1 : pn < 12 ? 2 : pn < 16 ? 3 : pn < 24 ? 4 : pn < 32 ? 5 : 6;
        const int row0 = u.pm * 256 + wr * 64 + fr, col0 = pn * 256 + wc * 32 + 8 * fq;
        if (kind == 2 || kind == 3) {
            const float ksc = kind == 3 ? 0.0625f : 1.f;
            float inv8[8];
#pragma unroll
            for (int e = 0; e < 8; ++e) inv8[e] = fexp2(-(float)(wc * 32 + 8 * fq + e) * (13.287712379549449f / 127.f)) * 0.15915494309189535f;
#pragma unroll
            for (int ai = 0; ai < 2; ++ai)
#pragma unroll
                for (int m = 0; m < 4; ++m) {
                    const int row = row0 + ai * 128 + m * 16, gr = rowbase + row;
                    const float pos = (float)(gr < 16384 ? (gr & 2047) : (gr < 16640 ? 1024 + ((gr - 16384) & 15) : ((gr - 16640) & 2047)));
                    float v0[8], v1[8], o0[8], o1[8];
#pragma unroll
                    for (int e = 0; e < 4; ++e) { v0[e] = acc[ai][0][m][0][e]; v0[4 + e] = acc[ai][0][m][1][e]; v1[e] = acc[ai][1][m][0][e]; v1[4 + e] = acc[ai][1][m][1][e]; }
#pragma unroll
                    for (int e = 0; e < 8; ++e) {
                        float t = pos * inv8[e]; t -= floorf(t);
                        const float sn = __builtin_amdgcn_sinf(t) * ksc, cs = __builtin_amdgcn_cosf(t) * ksc;
                        o0[e] = v0[e] * cs - v1[e] * sn; o1[e] = v0[e] * sn + v1[e] * cs;
                    }
                    *(u32x4*)(Z + (size_t)row * INC + col0) = pack8(o0); *(u32x4*)(Z + (size_t)row * INC + col0 + 128) = pack8(o1);
                }
            return;
        }
#pragma unroll
        for (int ai = 0; ai < 2; ++ai)
#pragma unroll
            for (int m = 0; m < 4; ++m) {
                const int row = row0 + ai * 128 + m * 16; float ss = 0.f;
#pragma unroll
                for (int bj = 0; bj < 2; ++bj) {
                    const int col = col0 + bj * 128; float v[8];
#pragma unroll
                    for (int e = 0; e < 4; ++e) { v[e] = acc[ai][bj][m][0][e]; v[4 + e] = acc[ai][bj][m][1][e]; }
                    if (kind == 0 || kind == 1) {
#pragma unroll
                        for (int e = 0; e < 4; ++e) { const f32x2 gq = gelu_t2((f32x2){v[2 * e], v[2 * e + 1]}); v[2 * e] = gq[0]; v[2 * e + 1] = gq[1]; }
                        if (kind == 1) {
#pragma unroll
                            for (int e = 0; e < 8; ++e) ss += v[e] * v[e];
                        }
                    } else if (kind == 3) {
#pragma unroll
                        for (int e = 0; e < 8; ++e) v[e] *= 0.0625f;
                    } else if (kind == 5) {
#pragma unroll
                        for (int e = 0; e < 8; ++e) v[e] = v[e] * sigm(v[e]);
                    } else if (kind == 6) {
                        const f32x4 b0 = *(const f32x4*)(b_gate + col - 8192), b1 = *(const f32x4*)(b_gate + col - 8192 + 4);
#pragma unroll
                        for (int e = 0; e < 4; ++e) { v[e] = sigm(v[e] + b0[e]); v[4 + e] = sigm(v[4 + e] + b1[e]); }
                    }
                    *(u32x4*)(Z + (size_t)row * INC + col) = pack8(v);
                }
                if (kind == 1) { ss += shx(ss, 16, lane); ss += shx(ss, 32, lane); if (fq == 0) atomicAdd(ssv + rowbase + row, ss); }
            }
    }
};
struct EpiT1 {
    static constexpr bool RESCALE = false;
    bf16_t* T1; const bf16_t* Z;
    __device__ __forceinline__ void operator()(const f32x4 (&acc)[2][2][4][2], const Unit& u, int wr, int wc, int fr, int fq) const {
        const int row0 = u.pm * 256 + wr * 64 + fr, col0 = u.pn * 256 + wc * 32 + 8 * fq;
#pragma unroll
        for (int ai = 0; ai < 2; ++ai)
#pragma unroll
            for (int m = 0; m < 4; ++m) {
                const int row = row0 + ai * 128 + m * 16;
#pragma unroll
                for (int bj = 0; bj < 2; ++bj) {
                    const int col = col0 + bj * 128; float v[8], gt[8];
                    unpack8(*(const u32x4*)(Z + (size_t)row * INC + 8192 + col), gt);
#pragma unroll
                    for (int e = 0; e < 4; ++e) { v[e] = acc[ai][bj][m][0][e] * gt[e]; v[4 + e] = acc[ai][bj][m][1][e] * gt[4 + e]; }
                    *(u32x4*)(T1 + (size_t)row * 1024 + col) = pack8(v);
                }
            }
    }
};
struct EpiM1 {
    static constexpr bool RESCALE = true;
    const bf16_t* T1; const bf16_t* Z; bf16_t* M1; int rowbase; const float* sso;
    __device__ __forceinline__ void prep(LAS float* tab, const Unit& u, int tid) const {
        if (tid < 256) {
            const f32x4 sv = *(const f32x4*)(sso + (size_t)(rowbase + u.pm * 256 + tid) * 4);
            const float c0 = sv[0] * (1.f / 512.f) + EPS, c1 = sv[1] * (1.f / 512.f) + EPS, c2 = sv[2] * (1.f / 512.f) + EPS, c3 = sv[3] * (1.f / 512.f) + EPS;
            *(LAS f32x4*)(tab + tid * 4) = (f32x4){__builtin_sqrtf(c1 * frcp(c0)), __builtin_sqrtf(c2 * frcp(c1)), __builtin_sqrtf(c3 * frcp(c2)), rsq(c3)};
        }
    }
    __device__ __forceinline__ void mid(f32x4 (&acc)[2][2][4][2], const LAS float* tab, int seg, int wr, int fr) const {
#pragma unroll
        for (int ai = 0; ai < 2; ++ai)
#pragma unroll
            for (int m = 0; m < 4; ++m) {
                const float f = tab[(ai * 128 + wr * 64 + m * 16 + fr) * 4 + seg];
#pragma unroll
                for (int bj = 0; bj < 2; ++bj)
#pragma unroll
                    for (int n = 0; n < 2; ++n) acc[ai][bj][m][n] = acc[ai][bj][m][n] * f;
            }
    }
    __device__ __forceinline__ void operator()(const f32x4 (&acc)[2][2][4][2], const Unit& u, int wr, int wc, int fr, int fq) const {}
    __device__ __forceinline__ void fin(const f32x4 (&acc)[2][2][4][2], const LAS float* tab, const Unit& u, int wr, int wc, int fr, int fq) const {
        const int row0 = u.pm * 256 + wr * 64 + fr, col0 = u.pn * 256 + wc * 32 + 8 * fq;
#pragma unroll
        for (int ai = 0; ai < 2; ++ai)
#pragma unroll
            for (int m = 0; m < 4; ++m) {
                const int row = row0 + ai * 128 + m * 16; const float rn3 = tab[(ai * 128 + wr * 64 + m * 16 + fr) * 4 + 3];
#pragma unroll
                for (int bj = 0; bj < 2; ++bj) {
                    const int col = col0 + bj * 128; float v[8], gt[8], t1[8];
                    unpack8(*(const u32x4*)(Z + (size_t)row * INC + 9216 + col), gt);
                    unpack8(*(const u32x4*)(T1 + (size_t)row * 1024 + col), t1);
#pragma unroll
                    for (int e = 0; e < 4; ++e) { v[e] = t1[e] + acc[ai][bj][m][0][e] * rn3 * gt[e]; v[4 + e] = t1[4 + e] + acc[ai][bj][m][1][e] * rn3 * gt[4 + e]; }
                    *(u32x4*)(M1 + (size_t)(rowbase + row) * 1024 + col) = pack8(v);
                }
            }
    }
};
struct EpiX2 {
    static constexpr bool RESCALE = false;
    const float* xp; const float* xs; float* out; bf16_t* X2b; float* ss2;
    __device__ __forceinline__ void operator()(const f32x4 (&acc)[2][2][4][2], const Unit& u, int wr, int wc, int fr, int fq) const {
        const int row0 = u.pm * 256 + wr * 64 + fr, col0 = u.pn * 256 + wc * 32 + 8 * fq, lane = fr + 16 * fq;
#pragma unroll
        for (int ai = 0; ai < 2; ++ai)
#pragma unroll
            for (int m = 0; m < 4; ++m) {
                const int row = row0 + ai * 128 + m * 16;
                const float* xr = row < 16384 ? xp + (size_t)row * 1024 : (row < 16640 ? xs + (size_t)(row - 16384) * 1024 : xp + (size_t)(row - 256) * 1024);
                float* yr = row < 16384 ? out + O_YP + (size_t)row * 1024 : (row < 16640 ? out + O_YS + (size_t)(row - 16384) * 1024 : out + O_YP + (size_t)(row - 256) * 1024);
                float ss = 0.f;
#pragma unroll
                for (int bj = 0; bj < 2; ++bj) {
                    const int col = col0 + bj * 128; float v[8];
                    const f32x4 x0 = *(const f32x4*)(xr + col), x1 = *(const f32x4*)(xr + col + 4);
#pragma unroll
                    for (int e = 0; e < 4; ++e) { v[e] = acc[ai][bj][m][0][e] + x0[e]; v[4 + e] = acc[ai][bj][m][1][e] + x1[e]; }
#pragma unroll
                    for (int e = 0; e < 8; ++e) ss += v[e] * v[e];
                    *(f32x4*)(yr + col) = (f32x4){v[0], v[1], v[2], v[3]}; *(f32x4*)(yr + col + 4) = (f32x4){v[4], v[5], v[6], v[7]};
                    *(u32x4*)(X2b + (size_t)row * 1024 + col) = pack8(v);
                }
                ss += shx(ss, 16, lane); ss += shx(ss, 32, lane); if (fq == 0) atomicAdd(ss2 + row, ss);
            }
    }
};
struct EpiQP {
    static constexpr bool RESCALE = false;
    bf16_t* QP; const float* ss2;
    __device__ __forceinline__ void operator()(const f32x4 (&acc)[2][2][4][2], const Unit& u, int wr, int wc, int fr, int fq) const {
        const int row0 = u.pm * 256 + wr * 64 + fr, col0 = u.pn * 256 + wc * 32 + 8 * fq;
#pragma unroll
        for (int ai = 0; ai < 2; ++ai)
#pragma unroll
            for (int m = 0; m < 4; ++m) {
                const int row = row0 + ai * 128 + m * 16; const float rs = rsq(ss2[row] * (1.f / 1024.f) + EPS);
#pragma unroll
                for (int bj = 0; bj < 2; ++bj) {
                    const int col = col0 + bj * 128; float v[8];
#pragma unroll
                    for (int e = 0; e < 4; ++e) { v[e] = acc[ai][bj][m][0][e] * rs; v[4 + e] = acc[ai][bj][m][1][e] * rs; }
                    *(u32x4*)(QP + (size_t)row * 2048 + col) = pack8(v);
                }
            }
    }
};

__device__ __forceinline__ void convert_item(const Params& p, unsigned char* ws, size_t i) {
        const int d = (int)((i * 16) & 1023);
        unsigned ou[4], ov[4];
#pragma unroll
        for (int q = 0; q < 4; ++q) {
            const f32x4 a = *(const f32x4*)(p.eu + i * 16 + q * 4), g0 = *(const f32x4*)(p.g_ffn + d + q * 4), c = *(const f32x4*)(p.ev + i * 16 + q * 4);
            int u = __builtin_amdgcn_cvt_pk_fp8_f32(a[0] * g0[0] * EU_SCALE, a[1] * g0[1] * EU_SCALE, 0, false);
            u = __builtin_amdgcn_cvt_pk_fp8_f32(a[2] * g0[2] * EU_SCALE, a[3] * g0[3] * EU_SCALE, u, true);
            int v = __builtin_amdgcn_cvt_pk_fp8_f32(c[0] * EV_SCALE, c[1] * EV_SCALE, 0, false);
            v = __builtin_amdgcn_cvt_pk_fp8_f32(c[2] * EV_SCALE, c[3] * EV_SCALE, v, true);
            ou[q] = (unsigned)u; ov[q] = (unsigned)v;
        }
        *(u32x4*)(ws + OFF_EU + (i >> 6) * 2048 + (i & 63) * 16) = (u32x4){ou[0], ou[1], ou[2], ou[3]};
        *(u32x4*)(ws + OFF_EU + (i >> 6) * 2048 + 1024 + (i & 63) * 16) = (u32x4){ov[0], ov[1], ov[2], ov[3]};
    }
constexpr size_t CONV_ITEMS = (size_t)16384 * 64;

__device__ __forceinline__ void transpose_tile(const Ctx& cx, const float* src, bf16_t* dst, const float* scale, int K, int N, int tile, LAS float* tl) {
    const int tn = N / 64, k0 = (tile / tn) * 64, n0 = (tile % tn) * 64, tid = cx.tid;
    const int n4 = (tid & 15) * 4, kr = tid >> 4;
#pragma unroll
    for (int i = 0; i < 2; ++i) {
        const int kk = kr + 32 * i; f32x4 v = *(const f32x4*)(src + (size_t)(k0 + kk) * N + n0 + n4);
        if (scale) v = v * scale[k0 + kk];
        tl[kk * 65 + n4] = v[0]; tl[kk * 65 + n4 + 1] = v[1]; tl[kk * 65 + n4 + 2] = v[2]; tl[kk * 65 + n4 + 3] = v[3];
    }
    __syncthreads();
    const int n = tid >> 3, kc = (tid & 7) * 8; float o[8];
#pragma unroll
    for (int e = 0; e < 8; ++e) o[e] = tl[(kc + e) * 65 + n];
    *(u32x4*)(dst + (size_t)(n0 + n) * K + k0 + kc) = pack8(o);
    __syncthreads();
}
__device__ __forceinline__ void phase0(const Ctx& cx, const Params& p, LAS unsigned char* lds) {
    unsigned char* ws = p.ws; LAS float* tl = (LAS float*)lds;
    for (int j = cx.bid; j < 4096; j += cx.nb) {
        if (j < 2560) transpose_tile(cx, p.w_in, (bf16_t*)(ws + OFF_WIN), p.g_mix, 1024, 10240, j, tl);
        else if (j < 2816) transpose_tile(cx, p.w_pa, (bf16_t*)(ws + OFF_WA), nullptr, 1024, 1024, j - 2560, tl);
        else if (j < 3328) transpose_tile(cx, p.w_pb, (bf16_t*)(ws + OFF_WB), nullptr, 2048, 1024, j - 2816, tl);
        else if (j < 3584) transpose_tile(cx, p.w_out, (bf16_t*)(ws + OFF_WO), nullptr, 1024, 1024, j - 3328, tl);
        else transpose_tile(cx, p.w_q, (bf16_t*)(ws + OFF_WQ), p.g_ffn, 1024, 2048, j - 3584, tl);
    }
    const size_t gtid = (size_t)cx.bid * 512 + cx.tid, nth = (size_t)cx.nb * 512;
    for (size_t i = gtid; i < 16384; i += nth) { ((bf16_t*)(ws + OFF_K1))[i] = f2bf(p.k1[i]); ((bf16_t*)(ws + OFF_K2))[i] = f2bf(p.k2[i]); }
    for (size_t i = gtid; i < (size_t)NTOK * 6; i += nth) ((float*)(ws + OFF_SSV))[i] = 0.f;
    const int wid = __builtin_amdgcn_readfirstlane(cx.tid >> 6), lane = cx.tid & 63;
    bf16_t* xb = (bf16_t*)((unsigned char*)p.out + OUT_XB);
    for (int r = cx.bid * 8 + wid; r < NTOK; r += cx.nb * 8) {
        const float* xr = xrow(p, r); f32x4 v[4]; float ss = 0.f;
#pragma unroll
        for (int j = 0; j < 4; ++j) { v[j] = *(const f32x4*)(xr + lane * 8 + (j >> 1) * 512 + (j & 1) * 4); ss += v[j][0] * v[j][0] + v[j][1] * v[j][1] + v[j][2] * v[j][2] + v[j][3] * v[j][3]; }
        ss = wave_sum(ss, lane);
        const float rs = rsq(ss * (1.f / 1024.f) + EPS);
#pragma unroll
        for (int j = 0; j < 2; ++j)
            *(u32x4*)(xb + (size_t)r * 1024 + lane * 8 + j * 512) = (u32x4){pk_bf16(v[2 * j][0] * rs, v[2 * j][1] * rs), pk_bf16(v[2 * j][2] * rs, v[2 * j][3] * rs),
                                                                          pk_bf16(v[2 * j + 1][0] * rs, v[2 * j + 1][1] * rs), pk_bf16(v[2 * j + 1][2] * rs, v[2 * j + 1][3] * rs)};
    }
}

__device__ __forceinline__ void retention_unit(const Ctx& cx, LAS unsigned char* lds, bf16_t* Z, int zrow0, int grow0, int nchunks, int Lc, int pos0, int h, int slice,
                               const float* s0, float* s_out, float* sso) {
    LAS bf16_t* Qs = (LAS bf16_t*)lds; LAS bf16_t* Ks = (LAS bf16_t*)(lds + 33792); LAS bf16_t* ST = (LAS bf16_t*)(lds + 67584);
    LAS bf16_t* VT = (LAS bf16_t*)(lds + 101376); LAS bf16_t* Ps = (LAS bf16_t*)(lds + 110592);
    const int tid = cx.tid, wid = __builtin_amdgcn_readfirstlane(tid >> 6), lane = tid & 63, fr = lane & 15, fq = lane >> 4;
    const float l2g = log2f(1.f - exp2f(-5.f - (float)h));
    f32x4 accS[2][4];
#pragma unroll
    for (int dt = 0; dt < 2; ++dt)
#pragma unroll
        for (int dvt = 0; dvt < 4; ++dvt) {
#pragma unroll
            for (int j = 0; j < 4; ++j) { const int d = (2 * wid + dt) * 16 + fq * 4 + j; accS[dt][dvt][j] = s0 ? s0[(size_t)d * 512 + slice * 64 + dvt * 16 + fr] : 0.f; }
            *(LAS u32x2*)(ST + (dvt * 16 + fr) * 264 + (2 * wid + dt) * 16 + fq * 4) = (u32x2){pk_bf16(accS[dt][dvt][0], accS[dt][dvt][1]), pk_bf16(accS[dt][dvt][2], accS[dt][dvt][3])};
        }
    const float sdec = fexp2(l2g * (float)Lc);
    __syncthreads();
    u32x4 rq1[2], rq2[2], rk1[2], rk2[2], rv; u32x2 rsg[2];
    const int vm = tid >> 3, vc0 = (tid & 7) * 8;
    auto fetch = [&](int c) {
        const size_t zr = (size_t)(zrow0 + c * 64);
#pragma unroll
        for (int it = 0; it < 2; ++it) {
            const int item = tid + 512 * it, n = item >> 4, dc = (item & 15) * 8;
            rq1[it] = (u32x4){0, 0, 0, 0}; rq2[it] = rq1[it]; rk1[it] = rq1[it]; rk2[it] = rq1[it];
            if (n < Lc) {
                const bf16_t* zp = Z + (zr + n) * INC + 2048 + h * 256 + dc;
                rq1[it] = *(const u32x4*)zp; rq2[it] = *(const u32x4*)(zp + 128); rk1[it] = *(const u32x4*)(zp + 1024); rk2[it] = *(const u32x4*)(zp + 1152);
            }
        }
        rv = (u32x4){0, 0, 0, 0};
        if (vm < Lc) rv = *(const u32x4*)(Z + (zr + vm) * INC + 4096 + h * 512 + slice * 64 + vc0);
#pragma unroll
        for (int i = 0; i < 2; ++i) {
            rsg[i] = (u32x2){0, 0};
            const int n = (wid >> 1) * 16 + fr;
            if (n < Lc) rsg[i] = *(const u32x2*)(Z + (zr + n) * INC + 6144 + h * 512 + slice * 64 + (2 * (wid & 1) + i) * 16 + fq * 4);
        }
    };
    fetch(0);
    for (int c = 0; c < nchunks; ++c) {
        const size_t zr = (size_t)(zrow0 + c * 64);
#pragma unroll
        for (int it = 0; it < 2; ++it) {
            const int item = tid + 512 * it, n = item >> 4, dc = (item & 15) * 8;
            *(LAS u32x4*)(Qs + n * 264 + dc) = rq1[it]; *(LAS u32x4*)(Qs + n * 264 + 128 + dc) = rq2[it];
            *(LAS u32x4*)(Ks + n * 264 + dc) = rk1[it]; *(LAS u32x4*)(Ks + n * 264 + 128 + dc) = rk2[it];
        }
        {
            float v[8]; unpack8(rv, v);
            const float kd = fexp2(l2g * (float)(Lc - 1 - vm));
#pragma unroll
            for (int e = 0; e < 8; ++e) v[e] *= kd;
            *(LAS u32x4*)(VT + vm * 72 + vc0) = pack8(v);
        }
        __syncthreads();
        u32x2 sgc[2] = {rsg[0], rsg[1]};
        if (c + 1 < nchunks) fetch(c + 1);
        const int nt = wid >> 1;
#pragma unroll
        for (int mi = 0; mi < 2; ++mi) {
            const int mt = 2 * (wid & 1) + mi; f32x4 acc = (f32x4){0.f, 0.f, 0.f, 0.f};
            if (mt <= nt) {
#pragma unroll
                for (int ks = 0; ks < 8; ++ks) {
                    const bf16x8 a = *(const LAS bf16x8*)(Qs + (nt * 16 + fr) * 264 + ks * 32 + fq * 8), b = *(const LAS bf16x8*)(Ks + (mt * 16 + fr) * 264 + ks * 32 + fq * 8);
                    acc = MFMA16(a, b, acc);
                }
            }
#pragma unroll
            for (int j = 0; j < 4; ++j) {
                const int n = nt * 16 + fq * 4 + j, m = mt * 16 + fr;
                const float val = (m <= n) ? acc[j] * fexp2(l2g * (float)(n - (Lc - 1))) : 0.f;
                Ps[n * 72 + m] = f2bf(val);
            }
        }
        f32x4 accO[2];
#pragma unroll
        for (int i = 0; i < 2; ++i) {
            const int dvt = 2 * (wid & 1) + i; accO[i] = (f32x4){0.f, 0.f, 0.f, 0.f};
#pragma unroll
            for (int ks = 0; ks < 8; ++ks) {
                const bf16x8 a = *(const LAS bf16x8*)(ST + (dvt * 16 + fr) * 264 + ks * 32 + fq * 8), b = *(const LAS bf16x8*)(Qs + (nt * 16 + fr) * 264 + ks * 32 + fq * 8);
                accO[i] = MFMA16(a, b, accO[i]);
            }
            const float qd = fexp2(l2g * (float)(nt * 16 + fr + 1));
            accO[i] = accO[i] * qd;
        }
        __syncthreads();
#pragma unroll
        for (int i = 0; i < 2; ++i) {
            const int dvt = 2 * (wid & 1) + i;
#pragma unroll
            for (int ks = 0; ks < 2; ++ks) {
                const bf16x8 a = tr_frag(VT + ks * 32 * 72 + dvt * 16, 72, lane), b = *(const LAS bf16x8*)(Ps + (nt * 16 + fr) * 72 + ks * 32 + fq * 8);
                accO[i] = MFMA16(a, b, accO[i]);
            }
        }
#pragma unroll
        for (int dt = 0; dt < 2; ++dt)
#pragma unroll
            for (int dvt = 0; dvt < 4; ++dvt) accS[dt][dvt] = accS[dt][dvt] * sdec;
#pragma unroll
        for (int ks = 0; ks < 2; ++ks) {
            bf16x8 bv[4];
#pragma unroll
            for (int dvt = 0; dvt < 4; ++dvt) bv[dvt] = tr_frag(VT + ks * 32 * 72 + dvt * 16, 72, lane);
#pragma unroll
            for (int dt = 0; dt < 2; ++dt) {
                const bf16x8 a = tr_frag(Ks + ks * 32 * 264 + (2 * wid + dt) * 16, 264, lane);
#pragma unroll
                for (int dvt = 0; dvt < 4; ++dvt) accS[dt][dvt] = MFMA16(a, bv[dvt], accS[dt][dvt]);
            }
        }
#pragma unroll
        for (int dt = 0; dt < 2; ++dt)
#pragma unroll
            for (int dvt = 0; dvt < 4; ++dvt)
                *(LAS u32x2*)(ST + (dvt * 16 + fr) * 264 + (2 * wid + dt) * 16 + fq * 4) = (u32x2){pk_bf16(accS[dt][dvt][0], accS[dt][dvt][1]), pk_bf16(accS[dt][dvt][2], accS[dt][dvt][3])};
        {
            float ss = 0.f; const int n = nt * 16 + fr;
#pragma unroll
            for (int i = 0; i < 2; ++i) {
                const int dvt = 2 * (wid & 1) + i;
                ss += accO[i][0] * accO[i][0] + accO[i][1] * accO[i][1] + accO[i][2] * accO[i][2] + accO[i][3] * accO[i][3];
                if (n < Lc) *(u32x2*)(Z + (zr + n) * INC + 4096 + h * 512 + slice * 64 + dvt * 16 + fq * 4) =
                    (u32x2){pk_bf16(accO[i][0] * bf_lo(sgc[i][0]), accO[i][1] * bf_hi(sgc[i][0])), pk_bf16(accO[i][2] * bf_lo(sgc[i][1]), accO[i][3] * bf_hi(sgc[i][1]))};
            }
            ss += shx(ss, 16, lane); ss += shx(ss, 32, lane);
            if (fq == 0 && n < Lc) atomicAdd(sso + (size_t)(grow0 + c * 64 + n) * 4 + h, ss);
        }
        __syncthreads();
    }
#pragma unroll
    for (int dt = 0; dt < 2; ++dt)
#pragma unroll
        for (int dvt = 0; dvt < 4; ++dvt)
#pragma unroll
            for (int j = 0; j < 4; ++j) { const int d = (2 * wid + dt) * 16 + fq * 4 + j; s_out[(size_t)d * 512 + slice * 64 + dvt * 16 + fr] = accS[dt][dvt][j]; }
}

__device__ __forceinline__ void sgu_unit(const Ctx& cx, const Params& p, LAS unsigned char* lds, bf16_t* Z, int zrow0, int grow0, int rows, int g, float* vout, const float* ssv, bool load_w) {
    LAS bf16_t* WS = (LAS bf16_t*)lds; LAS bf16_t* VT = (LAS bf16_t*)(lds + 34816);
    const int tid = cx.tid, wid = __builtin_amdgcn_readfirstlane(tid >> 6), lane = tid & 63, fr = lane & 15, fq = lane >> 4;
    if (load_w)
#pragma unroll
    for (int it = 0; it < 4; ++it) {
        const int item = tid + 512 * it, n = item >> 4, m0 = (item & 15) * 8;
        const float* src = p.w_s + ((size_t)g * 128 + n) * 128 + m0;
        const f32x4 a = *(const f32x4*)src, b = *(const f32x4*)(src + 4); float v[8];
#pragma unroll
        for (int e = 0; e < 4; ++e) { v[e] = (m0 + e <= n) ? a[e] : 0.f; v[4 + e] = (m0 + 4 + e <= n) ? b[e] : 0.f; }
        *(LAS u32x4*)(WS + n * 136 + m0) = pack8(v);
    }
#pragma unroll
    for (int it = 0; it < 4; ++it) {
        const int item = tid + 512 * it, m = item >> 4, d0 = (item & 15) * 8; float v[8];
#pragma unroll
        for (int e = 0; e < 8; ++e) v[e] = 0.f;
        if (m < rows) {
            unpack8(*(const u32x4*)(Z + (size_t)(zrow0 + m) * INC + 1024 + g * 128 + d0), v);
            const float rs = rsq(ssv[grow0 + m] * (1.f / 1024.f) + EPS);
            const f32x4 g0 = *(const f32x4*)(p.g_sgu + g * 128 + d0), g1 = *(const f32x4*)(p.g_sgu + g * 128 + d0 + 4);
#pragma unroll
            for (int e = 0; e < 4; ++e) { v[e] *= rs * g0[e]; v[4 + e] *= rs * g1[e]; }
            if (vout) { *(f32x4*)(vout + (size_t)m * 1024 + g * 128 + d0) = (f32x4){v[0], v[1], v[2], v[3]}; *(f32x4*)(vout + (size_t)m * 1024 + g * 128 + d0 + 4) = (f32x4){v[4], v[5], v[6], v[7]}; }
        }
        *(LAS u32x4*)(VT + m * 136 + d0) = pack8(v);
    }
    u32x2 uu[8]; float bias = 0.f;
    if (wid * 16 < rows) {
        bias = p.b_s[g * 128 + wid * 16 + fr];
#pragma unroll
        for (int dt = 0; dt < 8; ++dt) uu[dt] = *(const u32x2*)(Z + (size_t)(zrow0 + wid * 16 + fr) * INC + g * 128 + dt * 16 + fq * 4);
    }
    __syncthreads();
    if (wid * 16 < rows) {
        const int nks = (wid >> 1) + 1;
        f32x4 acc[8];
#pragma unroll
        for (int dt = 0; dt < 8; ++dt) acc[dt] = (f32x4){0.f, 0.f, 0.f, 0.f};
        for (int ks = 0; ks < nks; ++ks) {
            const bf16x8 b = *(const LAS bf16x8*)(WS + (wid * 16 + fr) * 136 + ks * 32 + fq * 8);
#pragma unroll
            for (int dt = 0; dt < 8; ++dt) { const bf16x8 a = tr_frag(VT + ks * 32 * 136 + dt * 16, 136, lane); acc[dt] = MFMA16(a, b, acc[dt]); }
        }
        const int n = wid * 16 + fr;
#pragma unroll
        for (int dt = 0; dt < 8; ++dt) {
            bf16_t* up = Z + (size_t)(zrow0 + n) * INC + g * 128 + dt * 16 + fq * 4;
            *(u32x2*)up = (u32x2){pk_bf16(bf_lo(uu[dt][0]) * (acc[dt][0] + bias), bf_hi(uu[dt][0]) * (acc[dt][1] + bias)), pk_bf16(bf_lo(uu[dt][1]) * (acc[dt][2] + bias), bf_hi(uu[dt][1]) * (acc[dt][3] + bias))};
        }
    }
    __syncthreads();
}

__device__ __forceinline__ void phase2(const Ctx& cx, const Params& p, LAS unsigned char* lds, int hf) {
    unsigned char* ws = p.ws; bf16_t* Z = (bf16_t*)(ws + OFF_Z); float* sso = (float*)(ws + OFF_SSO); const float* ssv = (const float*)(ws + OFF_SSV);
    const int rowbase = hf ? NH0 : 0;
    for (int u = cx.bid; u < 256; u += cx.nb) {
        const int slice = u & 7, h = (u >> 3) & 3, bl = u >> 5, b = hf * 8 + bl;
        retention_unit(cx, lds, Z, bl * 2048, rowbase + bl * 2048, 32, 64, 0, h, slice, nullptr, p.out + O_SP + ((size_t)b * 4 + h) * 256 * 512, sso);
    }
    if (hf == 0) {
        for (int u = cx.bid; u < 512; u += cx.nb) {
            const int slice = u & 7, h = (u >> 3) & 3, b = u >> 5;
            retention_unit(cx, lds, Z, 16384 + b * 16, 16384 + b * 16, 1, 16, 1024, h, slice, p.state + ((size_t)b * 4 + h) * 256 * 512,
                           p.out + O_SS + ((size_t)b * 4 + h) * 256 * 512, sso);
        }
    }
    const int nprompt = 128 * 8, nsgu = nprompt + (hf == 0 ? 16 * 8 : 0);
    int last_g = -1;
    for (int u = cx.bid; u < nsgu; u += cx.nb) {
        if (u < nprompt) { const int g = u & 7, ci = u >> 3; sgu_unit(cx, p, lds, Z, ci * 128, rowbase + ci * 128, 128, g, nullptr, ssv, g != last_g); last_g = g; }
        else { const int v = u - nprompt, g = v & 7, b = v >> 3; sgu_unit(cx, p, lds, Z, 16384 + b * 16, 16384 + b * 16, 16, g, p.out + O_SV + (size_t)b * 16 * 1024, ssv, g != last_g); last_g = g; }
    }
}

#define CE_DESC(x, i, l) do { const float _a = fmaxf(x[i], x[l]), _b = fminf(x[i], x[l]); x[i] = _a; x[l] = _b; } while (0)
__device__ __forceinline__ void bitonic_sort16_desc(float (&x)[16]) {
#pragma unroll
    for (int k = 2; k <= 16; k <<= 1)
#pragma unroll
        for (int j = k >> 1; j > 0; j >>= 1)
#pragma unroll
            for (int i = 0; i < 16; ++i) {
                const int l = i ^ j;
                if (l > i) { if ((i & k) == 0 || k == 16) CE_DESC(x, i, l); else CE_DESC(x, l, i); }
            }
}
__device__ __forceinline__ void bitonic_merge16_desc(float (&x)[16]) {
#pragma unroll
    for (int j = 8; j > 0; j >>= 1)
#pragma unroll
        for (int i = 0; i < 16; ++i) { const int l = i ^ j; if (l > i) CE_DESC(x, i, l); }
}
#define TOPK_INS_FROM(L, x, S0) do { float _v = (x); _Pragma("unroll") for (int _i = (S0); _i < 16; ++_i) { const float _h = fmaxf(L[_i], _v); _v = fminf(L[_i], _v); L[_i] = _h; } } while (0)
__device__ __forceinline__ void phase7(const Ctx& cx, const Params& p, LAS unsigned char* lds) {
    unsigned char* ws = p.ws; const bf16_t* QP = (const bf16_t*)(ws + OFF_QP); int* ids = (int*)(ws + OFF_IDS); float* wts = (float*)(ws + OFF_WTS);
    LAS bf16_t* KEYS = (LAS bf16_t*)lds;
    LAS float* SC = (LAS float*)(lds + 69632);
    LAS float* TP = (LAS float*)(lds + 69632 + 67584);
    const int tid = cx.tid, wid = __builtin_amdgcn_readfirstlane(tid >> 6), lane = tid & 63, fr = lane & 15, fq = lane >> 4;
#pragma unroll
    for (int it = 0; it < 8; ++it) {
        const int idx = tid + 512 * it, tab = idx >> 11, row = (idx >> 4) & 127, c8 = (idx & 15) * 8;
        *(LAS u32x4*)(KEYS + tab * 17408 + row * 136 + c8) = *(const u32x4*)((const bf16_t*)(ws + (tab ? OFF_K2 : OFF_K1)) + row * 128 + c8);
    }
    bf16x8 a[2][4], an[2][4];
    auto load_a = [&](int tile, bf16x8 (&d)[2][4]) {
#pragma unroll
        for (int half = 0; half < 2; ++half)
#pragma unroll
            for (int ks = 0; ks < 4; ++ks) d[half][ks] = *(const bf16x8*)(QP + (size_t)(tile * 16 + fr) * 2048 + wid * 256 + half * 128 + ks * 32 + fq * 8);
    };
    if (cx.bid < NTOK / 16) load_a(cx.bid, an);
    __syncthreads();
    const size_t cv_end = CONV_ITEMS * (size_t)(cx.bid + 1) / (size_t)cx.nb; size_t cv_pos = CONV_ITEMS * (size_t)cx.bid / (size_t)cx.nb;
    for (int tile = cx.bid; tile < NTOK / 16; tile += cx.nb) {
        const int row0 = tile * 16;
#pragma unroll
        for (int half = 0; half < 2; ++half)
#pragma unroll
            for (int ks = 0; ks < 4; ++ks) a[half][ks] = an[half][ks];
        if (tile + cx.nb < NTOK / 16) load_a(tile + cx.nb, an);
#pragma unroll
        for (int half = 0; half < 2; ++half) {
#pragma unroll
            for (int nt = 0; nt < 8; ++nt) {
                f32x4 acc = (f32x4){0.f, 0.f, 0.f, 0.f};
#pragma unroll
                for (int ks = 0; ks < 4; ++ks) acc = MFMA16(a[half][ks], *(const LAS bf16x8*)(KEYS + half * 17408 + (nt * 16 + fr) * 136 + ks * 32 + fq * 8), acc);
#pragma unroll
                for (int j = 0; j < 4; ++j) {
                    const int t = fq * 4 + j, list = t * 8 + wid, n = nt * 16 + fr;
                    SC[list * 132 + ((n + 8 * fq) & 127)] = __uint_as_float((__float_as_uint(acc[j]) & ~127u) | (unsigned)n);
                }
            }
            __syncthreads();
            if (tid < 256) {
                const int list = tid >> 1, part = tid & 1; const LAS float* sp = SC + list * 132 + part * 64;
                float T[16];
#pragma unroll
                for (int i = 0; i < 4; ++i) { const f32x4 v = *(const LAS f32x4*)(sp + i * 4); T[4 * i] = v[0]; T[4 * i + 1] = v[1]; T[4 * i + 2] = v[2]; T[4 * i + 3] = v[3]; }
                bitonic_sort16_desc(T);
#pragma unroll 1
                for (int grp = 1; grp < 4; ++grp) {
                    float G[16];
#pragma unroll
                    for (int i = 0; i < 4; ++i) { const f32x4 v = *(const LAS f32x4*)(sp + grp * 16 + i * 4); G[4 * i] = v[0]; G[4 * i + 1] = v[1]; G[4 * i + 2] = v[2]; G[4 * i + 3] = v[3]; }
                    bitonic_sort16_desc(G);
#pragma unroll
                    for (int i = 0; i < 16; ++i) T[i] = fmaxf(T[i], G[15 - i]);
                    bitonic_merge16_desc(T);
                }
                float O[16];
#pragma unroll
                for (int i = 0; i < 16; ++i) O[i] = __int_as_float(__builtin_amdgcn_update_dpp(0, __float_as_int(T[i]), 0xB1, 0xF, 0xF, true));
#pragma unroll
                for (int i = 0; i < 16; ++i) T[i] = fmaxf(T[i], O[15 - i]);
                bitonic_merge16_desc(T);
                if (part == 0) {
#pragma unroll
                    for (int i = 0; i < 4; ++i) *(LAS f32x4*)(TP + (list * 2 + half) * 16 + i * 4) = (f32x4){T[4 * i], T[4 * i + 1], T[4 * i + 2], T[4 * i + 3]};
                }
            } else if (cv_pos + (size_t)(tid - 256) < cv_end) convert_item(p, ws, cv_pos + (size_t)(tid - 256));
            cv_pos += 256;
            __syncthreads();
        }
        if (tid < 128) {
            float v1[16], v2[16], L[16];
#pragma unroll
            for (int i = 0; i < 4; ++i) {
                const f32x4 va = *(const LAS f32x4*)(TP + (tid * 2) * 16 + i * 4), vb = *(const LAS f32x4*)(TP + (tid * 2 + 1) * 16 + i * 4);
#pragma unroll
                for (int e = 0; e < 4; ++e) { v1[4 * i + e] = va[e]; v2[4 * i + e] = vb[e]; }
            }
#pragma unroll
            for (int jj = 0; jj < 16; ++jj) { const float c = v1[0] + v2[jj]; L[jj] = __uint_as_float((__float_as_uint(c) & ~255u) | (unsigned)jj); }
#pragma unroll
            for (int i = 1; i < 16; ++i)
#pragma unroll
                for (int jj = 0; jj < 16; ++jj)
                    if ((i + 1) * (jj + 1) <= 16) { const float c = v1[i] + v2[jj]; TOPK_INS_FROM(L, __uint_as_float((__float_as_uint(c) & ~255u) | (unsigned)(i * 16 + jj)), (i + 1) * (jj + 1) - 1); }
            float ex[16], sum = 0.f;
#pragma unroll
            for (int k = 0; k < 16; ++k) { ex[k] = fexp2((L[k] - L[0]) * 1.44269504f); sum += ex[k]; }
            const float rinv = 1.f / sum;
#pragma unroll
            for (int k = 0; k < 16; ++k) {
                const unsigned code = __float_as_uint(L[k]) & 255u;
                const unsigned e1 = __float_as_uint(TP[(tid * 2) * 16 + (code >> 4)]) & 127u, e2 = __float_as_uint(TP[(tid * 2 + 1) * 16 + (code & 15u)]) & 127u;
                ((LAS int*)SC)[tid * 16 + k] = (int)(e1 * 128u + e2); SC[2048 + tid * 16 + k] = ex[k] * rinv;
            }
        }
        __syncthreads();
        *(u32x4*)(ids + (size_t)row0 * 128 + tid * 4) = *(const LAS u32x4*)((LAS int*)SC + tid * 4);
        *(f32x4*)(wts + (size_t)row0 * 128 + tid * 4) = *(const LAS f32x4*)(SC + 2048 + tid * 4);
        __syncthreads();
    }
    for (size_t it = cv_pos + tid; it < cv_end; it += 512) convert_item(p, ws, it);
}

__device__ __forceinline__ void phase8(const Ctx& cx, const Params& p, LAS unsigned char* lds) {
    unsigned char* ws = p.ws; const unsigned char* EU = ws + OFF_EU; const unsigned char* EV = ws + OFF_EV;
    const int* ids = (const int*)(ws + OFF_IDS); const float* wts = (const float*)(ws + OFF_WTS);
    const float* ss2 = (const float*)(ws + OFF_SS2);
    const int tid = cx.tid, wid = __builtin_amdgcn_readfirstlane(tid >> 6), lane = tid & 63, fr = lane & 15, fq = lane >> 4;
    const int nfull = (NTOK / (cx.nb * 8)) * (cx.nb * 8);
    const unsigned char* ET = ws + OFF_EU;
    int nid0 = 0, nid1 = 0; float nw0 = 0.f, nw1 = 0.f, nr2 = 0.f;
    auto fetch_ids = [&](int r, int& i0_, int& i1_, float& a0, float& a1, float& rr) {
        i0_ = ids[(size_t)r * 128 + lane] & 16383; i1_ = ids[(size_t)r * 128 + 64 + lane] & 16383;
        a0 = wts[(size_t)r * 128 + lane]; a1 = wts[(size_t)r * 128 + 64 + lane];
        rr = rsq(ss2[r] * (1.f / 1024.f) + EPS) * (1.f / EU_SCALE);
    };
    if (cx.bid * 8 + wid < nfull) fetch_ids(cx.bid * 8 + wid, nid0, nid1, nw0, nw1, nr2);
    for (int r = cx.bid * 8 + wid; r < nfull; r += cx.nb * 8) {
        const int id0 = nid0, id1 = nid1; const float w0 = nw0, w1 = nw1, r2 = nr2;
        float* yr = yrow(p, r);
        f32x2 tq[4][8];
#pragma unroll
        for (int j = 0; j < 4; ++j)
#pragma unroll
            for (int q = 0; q < 4; ++q) { const f32x4 v = *(const f32x4*)(yr + (fr + 16 * j) * 16 + q * 4); tq[j][2 * q] = (f32x2){v[0], v[1]}; tq[j][2 * q + 1] = (f32x2){v[2], v[3]}; }
        if (r + cx.nb * 8 < nfull) fetch_ids(r + cx.nb * 8, nid0, nid1, nw0, nw1, nr2);
        f32x2 acc[4][8];
#pragma unroll
        for (int j = 0; j < 4; ++j)
#pragma unroll
            for (int q = 0; q < 8; ++q) acc[j][q] = (f32x2){0.f, 0.f};
#pragma unroll 2
        for (int it = 0; it < 32; ++it) {
            const int src = ((it & 15) << 2) + fq;
            const int e = it < 16 ? shl_(id0, src) : shl_(id1, src);
            const float w = it < 16 ? shl_(w0, src) : shl_(w1, src);
            const unsigned char* rp = ET + (size_t)e * 2048 + fr * 16;
            u32x4 du[4], dv[4];
#pragma unroll
            for (int j = 0; j < 4; ++j) { du[j] = *(const u32x4*)(rp + j * 256); dv[j] = *(const u32x4*)(rp + 1024 + j * 256); }
            f32x2 s2 = (f32x2){0.f, 0.f};
#pragma unroll
            for (int j = 0; j < 4; ++j)
#pragma unroll
                for (int q = 0; q < 4; ++q) {
                    s2 = __builtin_amdgcn_cvt_pk_f32_fp8((int)du[j][q], false) * tq[j][2 * q] + s2;
                    s2 = __builtin_amdgcn_cvt_pk_f32_fp8((int)du[j][q], true) * tq[j][2 * q + 1] + s2;
                }
            const float sd = row16_sum(s2[0] + s2[1]);
            const float c = w * gelu_t(r2 * sd) * (1.f / EV_SCALE); const f32x2 cc = (f32x2){c, c};
#pragma unroll
            for (int j = 0; j < 4; ++j)
#pragma unroll
                for (int q = 0; q < 4; ++q) {
                    acc[j][2 * q] = __builtin_amdgcn_cvt_pk_f32_fp8((int)dv[j][q], false) * cc + acc[j][2 * q];
                    acc[j][2 * q + 1] = __builtin_amdgcn_cvt_pk_f32_fp8((int)dv[j][q], true) * cc + acc[j][2 * q + 1];
                }
        }
        float ss = 0.f;
#pragma unroll
        for (int j = 0; j < 4; ++j)
#pragma unroll
            for (int q = 0; q < 8; ++q)
#pragma unroll
                for (int h2 = 0; h2 < 2; ++h2) { float v = acc[j][q][h2]; v += shx(v, 16, lane); v += shx(v, 32, lane); acc[j][q][h2] = v; }
        if (fq == 0) {
#pragma unroll
            for (int j = 0; j < 4; ++j)
#pragma unroll
                for (int q = 0; q < 4; ++q) {
                    const f32x4 xv = *(const f32x4*)(yr + (fr + 16 * j) * 16 + q * 4);
                    acc[j][2 * q][0] += xv[0]; acc[j][2 * q][1] += xv[1]; acc[j][2 * q + 1][0] += xv[2]; acc[j][2 * q + 1][1] += xv[3];
                    ss += acc[j][2 * q][0] * acc[j][2 * q][0] + acc[j][2 * q][1] * acc[j][2 * q][1] + acc[j][2 * q + 1][0] * acc[j][2 * q + 1][0] + acc[j][2 * q + 1][1] * acc[j][2 * q + 1][1];
                }
        }
        ss = wave_sum(ss, lane);
        const float rs = rsq(ss * (1.f / 1024.f) + EPS);
        if (fq == 0) {
#pragma unroll
            for (int j = 0; j < 4; ++j)
#pragma unroll
                for (int q = 0; q < 4; ++q) {
                    const f32x4 g0 = *(const f32x4*)(p.g_final + (fr + 16 * j) * 16 + q * 4);
                    *(f32x4*)(yr + (fr + 16 * j) * 16 + q * 4) = (f32x4){acc[j][2 * q][0], acc[j][2 * q][1], acc[j][2 * q + 1][0], acc[j][2 * q + 1][1]} * rs * g0;
                }
        }
    }
    LAS float* cfb = (LAS float*)lds; LAS float* part = (LAS float*)(lds + 4096);
    __syncthreads();
    for (int r = nfull + cx.bid; r < NTOK; r += cx.nb) {
        const int id0 = ids[(size_t)r * 128 + lane] & 16383, id1 = ids[(size_t)r * 128 + 64 + lane] & 16383;
        const float w0 = wts[(size_t)r * 128 + lane], w1 = wts[(size_t)r * 128 + 64 + lane];
        const float r2 = rsq(ss2[r] * (1.f / 1024.f) + EPS) * (1.f / EU_SCALE);
        float* yr = yrow(p, r);
        f32x2 tq[4][8];
#pragma unroll
        for (int j = 0; j < 4; ++j)
#pragma unroll
            for (int q = 0; q < 4; ++q) { const f32x4 v = *(const f32x4*)(yr + (fr + 16 * j) * 16 + q * 4); tq[j][2 * q] = (f32x2){v[0], v[1]}; tq[j][2 * q + 1] = (f32x2){v[2], v[3]}; }
#pragma unroll
        for (int i4 = 0; i4 < 4; ++i4) {
            const int it = wid * 4 + i4, src = ((it & 15) << 2) + fq;
            const int e = it < 16 ? shl_(id0, src) : shl_(id1, src);
            const float w = it < 16 ? shl_(w0, src) : shl_(w1, src);
            const unsigned char* rp = ET + (size_t)e * 2048 + fr * 16;
            u32x4 d[4];
#pragma unroll
            for (int j = 0; j < 4; ++j) d[j] = *(const u32x4*)(rp + j * 256);
            f32x2 s2 = (f32x2){0.f, 0.f};
#pragma unroll
            for (int j = 0; j < 4; ++j)
#pragma unroll
                for (int q = 0; q < 4; ++q) {
                    s2 = __builtin_amdgcn_cvt_pk_f32_fp8((int)d[j][q], false) * tq[j][2 * q] + s2;
                    s2 = __builtin_amdgcn_cvt_pk_f32_fp8((int)d[j][q], true) * tq[j][2 * q + 1] + s2;
                }
            const float sd = row16_sum(s2[0] + s2[1]);
            if (fr == 0) cfb[it * 4 + fq] = w * gelu_t(r2 * sd) * (1.f / EV_SCALE);
        }
        __syncthreads();
        const float c0 = cfb[lane], c1 = cfb[64 + lane];
        const int idsel = wid < 4 ? id0 : id1; const float csel = wid < 4 ? c0 : c1;
        f32x2 acc[8];
#pragma unroll
        for (int i = 0; i < 8; ++i) acc[i] = (f32x2){0.f, 0.f};
#pragma unroll
        for (int k16 = 0; k16 < 16; ++k16) {
            const int kk = (wid & 3) * 16 + k16;
            const int e = __builtin_amdgcn_readlane(idsel, kk); const float c = __int_as_float(__builtin_amdgcn_readlane(__float_as_int(csel), kk));
            const u32x4 v = *(const u32x4*)(ET + (size_t)e * 2048 + 1024 + lane * 16); const f32x2 cc = (f32x2){c, c};
#pragma unroll
            for (int q = 0; q < 4; ++q) { acc[2 * q] = __builtin_amdgcn_cvt_pk_f32_fp8((int)v[q], false) * cc + acc[2 * q]; acc[2 * q + 1] = __builtin_amdgcn_cvt_pk_f32_fp8((int)v[q], true) * cc + acc[2 * q + 1]; }
        }
#pragma unroll
        for (int q = 0; q < 4; ++q) *(LAS f32x4*)(part + (wid * 64 + lane) * 16 + q * 4) = (f32x4){acc[2 * q][0], acc[2 * q][1], acc[2 * q + 1][0], acc[2 * q + 1][1]};
        __syncthreads();
        if (wid == 0) {
            float ss = 0.f; f32x4 x[4];
#pragma unroll
            for (int j = 0; j < 4; ++j) {
                x[j] = *(const f32x4*)(yr + lane * 16 + j * 4);
#pragma unroll
                for (int w8 = 0; w8 < 8; ++w8) x[j] += *(const LAS f32x4*)(part + (w8 * 64 + lane) * 16 + j * 4);
                ss += x[j][0] * x[j][0] + x[j][1] * x[j][1] + x[j][2] * x[j][2] + x[j][3] * x[j][3];
            }
            ss = wave_sum(ss, lane);
            const float rs = rsq(ss * (1.f / 1024.f) + EPS);
#pragma unroll
            for (int j = 0; j < 4; ++j) { const f32x4 g0 = *(const f32x4*)(p.g_final + lane * 16 + j * 4); *(f32x4*)(yr + lane * 16 + j * 4) = x[j] * rs * g0; }
        }
        __syncthreads();
    }
}

__device__ __forceinline__ void strip_mma(const bf16_t* A, int lda, const bf16_t* Bt, int ldb, int K, int c, int wid, int fr, int fq, f32x4 (&acc)[2]) {
#pragma unroll 2
    for (int ks = 0; ks < K / 32; ks += 4) {
        bf16x8 a[2][4], b[4];
#pragma unroll
        for (int u = 0; u < 4; ++u) {
            b[u] = *(const bf16x8*)(Bt + (size_t)(16 * c + fr) * ldb + (ks + u) * 32 + fq * 8);
#pragma unroll
            for (int i = 0; i < 2; ++i) a[i][u] = *(const bf16x8*)(A + (size_t)((2 * wid + i) * 16 + fr) * lda + (ks + u) * 32 + fq * 8);
        }
#pragma unroll
        for (int u = 0; u < 4; ++u)
#pragma unroll
            for (int i = 0; i < 2; ++i) acc[i] = MFMA16(a[i][u], b[u], acc[i]);
    }
}
__device__ __forceinline__ void sample_merge(const Ctx& cx, const Params& p) {
    unsigned char* ws = p.ws; const bf16_t* Zs = (const bf16_t*)(ws + OFF_Z) + (size_t)16384 * INC; bf16_t* M1 = (bf16_t*)(ws + OFF_M1) + (size_t)16384 * 1024;
    const int tid = cx.tid, wid = __builtin_amdgcn_readfirstlane(tid >> 6), lane = tid & 63, fr = lane & 15, fq = lane >> 4;
    for (int c = cx.bid; c < 64; c += cx.nb) {
        f32x4 aa[2] = {(f32x4){0.f, 0.f, 0.f, 0.f}, (f32x4){0.f, 0.f, 0.f, 0.f}}, ab[2] = {(f32x4){0.f, 0.f, 0.f, 0.f}, (f32x4){0.f, 0.f, 0.f, 0.f}};
        strip_mma(Zs, INC, (const bf16_t*)(ws + OFF_WA), 1024, 1024, c, wid, fr, fq, aa);
#pragma unroll 1
        for (int hh = 0; hh < 4; ++hh) {
            f32x4 ah[2] = {(f32x4){0.f, 0.f, 0.f, 0.f}, (f32x4){0.f, 0.f, 0.f, 0.f}};
            strip_mma(Zs + 4096 + hh * 512, INC, (const bf16_t*)(ws + OFF_WB) + hh * 512, 2048, 512, c, wid, fr, fq, ah);
#pragma unroll
            for (int i = 0; i < 2; ++i)
#pragma unroll
                for (int j = 0; j < 4; ++j) ab[i][j] += ah[i][j] * rsq(((const float*)(ws + OFF_SSO))[(size_t)(16384 + (2 * wid + i) * 16 + fq * 4 + j) * 4 + hh] * (1.f / 512.f) + EPS);
        }
#pragma unroll
        for (int i = 0; i < 2; ++i)
#pragma unroll
            for (int j = 0; j < 4; ++j) {
                const int row = (2 * wid + i) * 16 + fq * 4 + j, col = 16 * c + fr;
                const float ga = bf_lo((unsigned)Zs[(size_t)row * INC + 8192 + col]), gb = bf_lo((unsigned)Zs[(size_t)row * INC + 9216 + col]);
                M1[(size_t)row * 1024 + col] = f2bf(ga * aa[i][j] + gb * ab[i][j]);
            }
    }
}
__device__ __forceinline__ void sample_x2(const Ctx& cx, const Params& p) {
    unsigned char* ws = p.ws; bf16_t* X2b = (bf16_t*)(ws + OFF_X2B) + (size_t)16384 * 1024; float* ss2 = (float*)(ws + OFF_SS2) + 16384;
    const int tid = cx.tid, wid = __builtin_amdgcn_readfirstlane(tid >> 6), lane = tid & 63, fr = lane & 15, fq = lane >> 4;
    for (int c = cx.bid; c < 64; c += cx.nb) {
        f32x4 acc[2] = {(f32x4){0.f, 0.f, 0.f, 0.f}, (f32x4){0.f, 0.f, 0.f, 0.f}};
        strip_mma((const bf16_t*)(ws + OFF_M1) + (size_t)16384 * 1024, 1024, (const bf16_t*)(ws + OFF_WO), 1024, 1024, c, wid, fr, fq, acc);
#pragma unroll
        for (int i = 0; i < 2; ++i)
#pragma unroll
            for (int j = 0; j < 4; ++j) {
                const int row = (2 * wid + i) * 16 + fq * 4 + j, col = 16 * c + fr;
                const float v = p.xs[(size_t)row * 1024 + col] + acc[i][j];
                p.out[O_YS + (size_t)row * 1024 + col] = v; X2b[(size_t)row * 1024 + col] = f2bf(v);
                const float sq = row16_sum(v * v);
                if (fr == 0) atomicAdd(ss2 + row, sq);
            }
    }
}
__device__ __forceinline__ void sample_query(const Ctx& cx, const Params& p) {
    unsigned char* ws = p.ws; bf16_t* QP = (bf16_t*)(ws + OFF_QP) + (size_t)16384 * 2048; const float* ss2 = (const float*)(ws + OFF_SS2) + 16384;
    const int tid = cx.tid, wid = __builtin_amdgcn_readfirstlane(tid >> 6), lane = tid & 63, fr = lane & 15, fq = lane >> 4;
    for (int c = cx.bid; c < 128; c += cx.nb) {
        f32x4 acc[2] = {(f32x4){0.f, 0.f, 0.f, 0.f}, (f32x4){0.f, 0.f, 0.f, 0.f}};
        strip_mma((const bf16_t*)(ws + OFF_X2B) + (size_t)16384 * 1024, 1024, (const bf16_t*)(ws + OFF_WQ), 1024, 1024, c, wid, fr, fq, acc);
#pragma unroll
        for (int i = 0; i < 2; ++i)
#pragma unroll
            for (int j = 0; j < 4; ++j) {
                const int row = (2 * wid + i) * 16 + fq * 4 + j, col = 16 * c + fr;
                QP[(size_t)row * 2048 + col] = f2bf(acc[i][j] * rsq(ss2[row] * (1.f / 1024.f) + EPS));
            }
    }
}

__device__ __forceinline__ void run_phase(const Params& p, LAS unsigned char* lds, int ph, const Ctx& cx) {
    unsigned char* ws = p.ws; pg8::StaticOrder S; pg8::Gemm g;
    bf16_t* Z = (bf16_t*)(ws + OFF_Z); bf16_t* T1 = (bf16_t*)((unsigned char*)p.out + OUT_T1);
    if (ph == 0) { phase0(cx, p, lds); return; }
    if (ph >= 1 && ph <= 8) {
        const int hf = (ph - 1) >> 2, sub = (ph - 1) & 3, rowbase = hf ? NH0 : 0, nM = hf ? 64 : 65;
        if (sub == 0) {
            g.A = (const bf16_t*)((unsigned char*)p.out + OUT_XB) + (size_t)rowbase * 1024; g.Bt = (const bf16_t*)(ws + OFF_WIN); g.lda = 1024; g.ldb = 1024; g.K = 1024;
            S.init(nM, 40, cx.nb, cx.bid);
            EpiIn E{Z, (const float*)(ws + OFF_R1), (float*)(ws + OFF_SSV), p.b_gate, rowbase};
            pg8::gemm_phase(cx, lds, g, S, E);
        } else if (sub == 1) phase2(cx, p, lds, hf);
#ifdef DBG_SKIP_P3
        else if (sub == 2) { }
#else
        else if (sub == 2) { }
#endif
        else {
            S.init(64, 4, cx.nb, cx.bid);
            g.A = Z; g.Bt = (const bf16_t*)(ws + OFF_WA); g.lda = INC; g.ldb = 1024; g.K = 1024;
            EpiT1 E1{T1, Z}; pg8::gemm_phase(cx, lds, g, S, E1);
            g.A = Z + 4096; g.Bt = (const bf16_t*)(ws + OFF_WB); g.lda = INC; g.ldb = 2048; g.K = 2048;
            EpiM1 E2{T1, Z, (bf16_t*)(ws + OFF_M1), rowbase, (const float*)(ws + OFF_SSO)}; pg8::gemm_phase(cx, lds, g, S, E2);
            if (hf == 0) sample_merge(cx, p);
        }
        return;
    }
#ifdef DBG_YCONST
    if (ph >= 9 && ph <= 11) return;
#endif
    if (ph == 9) {
        g.A = (const bf16_t*)(ws + OFF_M1); g.Bt = (const bf16_t*)(ws + OFF_WO); g.lda = 1024; g.ldb = 1024; g.K = 1024;
        S.init(128, 4, cx.nb, cx.bid, 64);
        EpiX2 E{p.xp, p.xs, p.out, (bf16_t*)(ws + OFF_X2B), (float*)(ws + OFF_SS2)}; pg8::gemm_phase(cx, lds, g, S, E);
        sample_x2(cx, p); return;
    }
    if (ph == 10) {
        g.A = (const bf16_t*)(ws + OFF_X2B); g.Bt = (const bf16_t*)(ws + OFF_WQ); g.lda = 1024; g.ldb = 1024; g.K = 1024;
        S.init(128, 8, cx.nb, cx.bid, 64);
        EpiQP E{(bf16_t*)(ws + OFF_QP), (const float*)(ws + OFF_SS2)}; pg8::gemm_phase(cx, lds, g, S, E);
        sample_query(cx, p); return;
    }
    if (ph == 11) { phase7(cx, p, lds); return; }
    if (ph == 12) { phase8(cx, p, lds); return; }
}
constexpr int NPHASE = 13;

extern __shared__ __attribute__((aligned(16))) unsigned char dyn_smem[];

#if ONE_LAUNCH
__device__ __forceinline__ void grid_barrier(unsigned* ctr, unsigned target, int tid) {
    asm volatile("s_waitcnt vmcnt(0)" ::: "memory");
    __syncthreads();
    if (tid == 0) {
        __builtin_amdgcn_fence(__ATOMIC_RELEASE, "agent");
        asm volatile("s_waitcnt vmcnt(0)" ::: "memory");
        __hip_atomic_fetch_add(ctr, 1u, __ATOMIC_RELAXED, __HIP_MEMORY_SCOPE_AGENT);
        while (__hip_atomic_load(ctr, __ATOMIC_RELAXED, __HIP_MEMORY_SCOPE_AGENT) < target) __builtin_amdgcn_s_sleep(2);
        __builtin_amdgcn_fence(__ATOMIC_ACQUIRE, "agent");
        asm volatile("s_waitcnt vmcnt(0)" ::: "memory");
    }
    __syncthreads();
}
__global__ __launch_bounds__(512, 2) void mega_kernel(Params p) {
#if defined(__HIP_DEVICE_COMPILE__)
    LAS unsigned char* lds = (LAS unsigned char*)dyn_smem;
    cg::grid_group grid = cg::this_grid();
    const int wave0 = __builtin_amdgcn_readfirstlane((int)threadIdx.x >> 6);
    unsigned nbar = 0;
    { int never = 0; asm volatile("" : "+s"(never));
      if (never == 1000) grid.sync(); }
#pragma nounroll
    for (int ph = 0; ph < NPHASE; ++ph) {
        int phv = ph; asm volatile("" : "+s"(phv));
        int wv = wave0; asm volatile("" : "+s"(wv));
        int ln = (int)__builtin_amdgcn_mbcnt_hi(~0u, __builtin_amdgcn_mbcnt_lo(~0u, 0u)); asm volatile("" : "+v"(ln));
        Ctx cx; cx.tid = wv * 64 + ln; cx.bid = blockIdx.x; cx.nb = gridDim.x;
        asm volatile("" : "+s"(cx.bid)); asm volatile("" : "+s"(cx.nb));
        auto ka = __builtin_amdgcn_kernarg_segment_ptr(); asm volatile("" : "+s"(ka));
        const Params pl = *(const Params __attribute__((address_space(4)))*)(unsigned long long)ka;
        unsigned lo = 0; asm volatile("" : "+s"(lo));
        if (ph == 3 || ph == 7) continue;
        run_phase(pl, lds + lo, phv, cx);
        if (ph + 1 < NPHASE) { ++nbar; grid_barrier((unsigned*)(pl.ws + OFF_BAR), nbar * (unsigned)cx.nb, cx.tid); }
    }
#endif
}
#else
__global__ __launch_bounds__(512, 2) void stage_kernel(Params p, int ph) {
    LAS unsigned char* lds = (LAS unsigned char*)dyn_smem;
    Ctx cx; cx.tid = threadIdx.x; cx.bid = blockIdx.x; cx.nb = gridDim.x;
    run_phase(p, lds, ph, cx);
}
#endif

extern "C" void kernel_launch(void* const* d_in, const int* in_sizes, int n_in, void* d_out, int out_size, void* d_ws, size_t ws_size, hipStream_t stream) {
    Params p; memset(&p, 0, sizeof(p));
    p.xp = (const float*)d_in[0]; p.xs = (const float*)d_in[1]; p.state = (const float*)d_in[2]; p.w_in = (const float*)d_in[3]; p.w_s = (const float*)d_in[4];
    p.b_s = (const float*)d_in[5]; p.g_sgu = (const float*)d_in[6]; p.w_pa = (const float*)d_in[7]; p.w_pb = (const float*)d_in[8]; p.b_gate = (const float*)d_in[9];
    p.w_out = (const float*)d_in[10]; p.g_mix = (const float*)d_in[11]; p.g_ffn = (const float*)d_in[12]; p.w_q = (const float*)d_in[13]; p.k1 = (const float*)d_in[14];
    p.k2 = (const float*)d_in[15]; p.eu = (const float*)d_in[16]; p.ev = (const float*)d_in[17]; p.g_final = (const float*)d_in[18];
    p.out = (float*)d_out; p.ws = (unsigned char*)d_ws;
    if (ws_size < WS_NEED) { fprintf(stderr, "workspace too small: %zu < %zu\n", ws_size, (size_t)WS_NEED); return; }
#if ONE_LAUNCH
    static int grid_blocks = 0;
    if (!grid_blocks) {
        (void)hipFuncSetAttribute((const void*)mega_kernel, hipFuncAttributeMaxDynamicSharedMemorySize, LDS_BYTES);
        int dev = 0, cus = 0, per_cu = 0;
        hipGetDevice(&dev); hipDeviceGetAttribute(&cus, hipDeviceAttributeMultiprocessorCount, dev);
        hipOccupancyMaxActiveBlocksPerMultiprocessor(&per_cu, mega_kernel, 512, LDS_BYTES);
        if (per_cu < 1) per_cu = 1;
        grid_blocks = cus * 1;
    }
    (void)hipMemsetAsync((unsigned char*)d_ws + OFF_BAR, 0, 256, stream);
    void* args[] = {&p};
    hipError_t e = hipLaunchCooperativeKernel((const void*)mega_kernel, dim3(grid_blocks), dim3(512), args, LDS_BYTES, stream);
    if (e != hipSuccess) fprintf(stderr, "cooperative launch failed: %s (grid %d)\n", hipGetErrorString(e), grid_blocks);
#else
    static bool attr = false;
    if (!attr) { (void)hipFuncSetAttribute((const void*)stage_kernel, hipFuncAttributeMaxDynamicSharedMemorySize, LDS_BYTES); attr = true; }
    for (int ph = 0; ph < NPHASE; ++ph) hipLaunchKernelGGL(stage_kernel, dim3(256), dim3(512), LDS_BYTES, stream, p, ph);
#endif
}
```

```cpp
#include <hip/hip_runtime.h>
#include <hip/hip_cooperative_groups.h>
#include <cstdio>
#include <cstring>
namespace cg = cooperative_groups;

#ifndef ONE_LAUNCH
#define ONE_LAUNCH 1
#endif

#define LAS __attribute__((address_space(3)))
typedef unsigned short bf16_t;
typedef short bf16x8 __attribute__((ext_vector_type(8)));
typedef float f32x4 __attribute__((ext_vector_type(4)));
typedef unsigned u32x4 __attribute__((ext_vector_type(4)));
typedef unsigned u32x2 __attribute__((ext_vector_type(2)));
typedef __bf16 bf16x2_t __attribute__((ext_vector_type(2)));

constexpr int DM = 1024, NTOK = 33024, NH0 = 16640, INC = 10240;
constexpr float EPS = 1e-6f;
constexpr int LDS_BYTES = 153600;
constexpr float EU_SCALE = 64.f, EV_SCALE = 64.f;

constexpr size_t OFF_WIN = 0;
constexpr size_t OFF_WA  = OFF_WIN + (size_t)10240 * 1024 * 2;
constexpr size_t OFF_WB  = OFF_WA + (size_t)1024 * 1024 * 2;
constexpr size_t OFF_WO  = OFF_WB + (size_t)1024 * 2048 * 2;
constexpr size_t OFF_WQ  = OFF_WO + (size_t)1024 * 1024 * 2;
constexpr size_t OFF_EU  = OFF_WQ + (size_t)2048 * 1024 * 2;
constexpr size_t OFF_EV  = OFF_EU + (size_t)16384 * 1024 * 2;
constexpr size_t OFF_K1  = OFF_EV + (size_t)16384 * 1024 * 2;
constexpr size_t OFF_K2  = OFF_K1 + 32768;
constexpr size_t OFF_M1  = OFF_K2 + 32768;
constexpr size_t OFF_R1  = OFF_M1 + (size_t)NTOK * 1024 * 2;
constexpr size_t OFF_SSV = OFF_R1 + (size_t)NTOK * 4;
constexpr size_t OFF_SS2 = OFF_SSV + (size_t)NTOK * 4;
constexpr size_t OFF_SSO = OFF_SS2 + (size_t)NTOK * 4;
constexpr size_t OFF_Z   = OFF_SSO + (size_t)NTOK * 16;
constexpr size_t Z_BYTES = (size_t)NH0 * INC * 2;
constexpr size_t OFF_BAR = OFF_Z + Z_BYTES;
constexpr size_t WS_NEED = OFF_BAR + 256;
constexpr size_t OFF_X2B = OFF_Z;
constexpr size_t OFF_QP  = OFF_X2B + (size_t)NTOK * 1024 * 2;
constexpr size_t OFF_IDS = OFF_QP + (size_t)NTOK * 2048 * 2;
constexpr size_t OFF_WTS = OFF_IDS + (size_t)NTOK * 128 * 4;
constexpr size_t OUT_XB = 0;
constexpr size_t OUT_T1 = (size_t)NTOK * 1024 * 2;
constexpr size_t O_YP = 0, O_YS = (size_t)32768 * 1024, O_SP = O_YS + (size_t)256 * 1024, O_SS = O_SP + (size_t)16 * 4 * 256 * 512,
                 O_SV = O_SS + (size_t)16 * 4 * 256 * 512;

struct Params {
    const float *xp, *xs, *state, *w_in, *w_s, *b_s, *g_sgu, *w_pa, *w_pb, *b_gate, *w_out, *g_mix, *g_ffn, *w_q, *k1, *k2, *eu, *ev, *g_final;
    float* out;
    unsigned char* ws;
};

struct Ctx { int tid, bid, nb; };

__device__ __forceinline__ float bf_lo(unsigned u) { return __uint_as_float(u << 16); }
__device__ __forceinline__ float bf_hi(unsigned u) { return __uint_as_float(u & 0xffff0000u); }
typedef float f32x2 __attribute__((ext_vector_type(2)));
__device__ __forceinline__ unsigned pk_bf16(float lo, float hi) {
    f32x2 v = {lo, hi}; bf16x2_t b = __builtin_convertvector(v, bf16x2_t); return __builtin_bit_cast(unsigned, b);
}
__device__ __forceinline__ bf16_t f2bf(float f) { return (bf16_t)(pk_bf16(f, 0.f) & 0xffffu); }
__device__ __forceinline__ float fexp2(float x) { return __builtin_amdgcn_exp2f(x); }
__device__ __forceinline__ float frcp(float x) { return __builtin_amdgcn_rcpf(x); }
__device__ __forceinline__ float sigm(float x) { return frcp(1.f + fexp2(-1.44269504f * x)); }
__device__ __forceinline__ float gelu_t(float x) { const float u = 0.7978845608f * (x + 0.044715f * x * x * x); return x * frcp(1.f + fexp2(-2.88539008f * u)); }
__device__ __forceinline__ float rsq(float x) { return __builtin_amdgcn_rsqf(x); }
__device__ __forceinline__ f32x2 sigm2(f32x2 x) {
    const f32x2 t = x * (-1.44269504f); f32x2 e; e.x = fexp2(t.x); e.y = fexp2(t.y);
    const f32x2 d = e + 1.f; f32x2 r; r.x = frcp(d.x); r.y = frcp(d.y); return r;
}
__device__ __forceinline__ f32x2 gelu_t2(f32x2 x) {
    const f32x2 w = (x * x) * (-0.10294324f) + (-2.3022082f), t = x * w;
    f32x2 e; e.x = fexp2(t.x); e.y = fexp2(t.y);
    const f32x2 d = e + 1.f;
    f32x2 r; r.x = frcp(d.x); r.y = frcp(d.y);
    return x * r;
}
__device__ __forceinline__ const float* xrow(const Params& p, int ir) {
    return ir < 16384 ? p.xp + (size_t)ir * 1024 : (ir < 16640 ? p.xs + (size_t)(ir - 16384) * 1024 : p.xp + (size_t)(ir - 256) * 1024);
}
__device__ __forceinline__ float* yrow(const Params& p, int ir) {
    return ir < 16384 ? p.out + O_YP + (size_t)ir * 1024 : (ir < 16640 ? p.out + O_YS + (size_t)(ir - 16384) * 1024 : p.out + O_YP + (size_t)(ir - 256) * 1024);
}
__device__ __forceinline__ float shx(float v, int m, int lane) { return __int_as_float(__builtin_amdgcn_ds_bpermute((lane ^ m) << 2, __float_as_int(v))); }
__device__ __forceinline__ float shl_(float v, int src) { return __int_as_float(__builtin_amdgcn_ds_bpermute(src << 2, __float_as_int(v))); }
__device__ __forceinline__ int shl_(int v, int src) { return __builtin_amdgcn_ds_bpermute(src << 2, v); }
__device__ __forceinline__ float wave_sum(float v, int lane) {
#pragma unroll
    for (int o = 32; o >= 1; o >>= 1) v += shx(v, o, lane);
    return v;
}
__device__ __forceinline__ float row16_sum(float s) {
    s += __int_as_float(__builtin_amdgcn_update_dpp(0, __float_as_int(s), 0xB1, 0xF, 0xF, true));
    s += __int_as_float(__builtin_amdgcn_update_dpp(0, __float_as_int(s), 0x4E, 0xF, 0xF, true));
    s += __int_as_float(__builtin_amdgcn_update_dpp(0, __float_as_int(s), 0x141, 0xF, 0xF, true));
    s += __int_as_float(__builtin_amdgcn_update_dpp(0, __float_as_int(s), 0x140, 0xF, 0xF, true));
    return s;
}
__device__ __forceinline__ float dot2bf(unsigned a, unsigned b, float c) {
    return __builtin_amdgcn_fdot2_f32_bf16(__builtin_bit_cast(bf16x2_t, a), __builtin_bit_cast(bf16x2_t, b), c, false);
}
typedef short s16x4 __attribute__((ext_vector_type(4)));
__device__ __forceinline__ bf16x8 tr_frag(const LAS bf16_t* tile, int stride, int lane) {
    const LAS bf16_t* a0 = tile + (8 * (lane >> 4) + ((lane >> 2) & 3)) * stride + 4 * (lane & 3);
    const s16x4 lo = __builtin_amdgcn_ds_read_tr16_b64_v4i16((LAS s16x4*)a0), hi = __builtin_amdgcn_ds_read_tr16_b64_v4i16((LAS s16x4*)(a0 + 4 * stride));
    return (bf16x8){lo[0], lo[1], lo[2], lo[3], hi[0], hi[1], hi[2], hi[3]};
}
#define MFMA16(a, b, c) __builtin_amdgcn_mfma_f32_16x16x32_bf16((a), (b), (c), 0, 0, 0)

namespace pg8 {
constexpr int BM = 256, BK = 64, HALF = 128, HTB = HALF * BK * 2, STAGE_BYTES = 8 * HTB, NXCD = 8, WGM = 8;
__device__ __forceinline__ int lds_byte(int r, int c) { const int st = (r >> 4) * 2 + (c >> 5), rr = r & 15, cc = c & 31, ob = rr * 64 + cc * 2; return st * 1024 + (ob ^ (((ob >> 9) & 1) << 5)); }
__device__ __forceinline__ void stage_rc(int b, int& R, int& C) { const int st = b / 1024, sb = b % 1024, swz = sb ^ (((sb >> 9) & 1) << 5); R = (st >> 1) * 16 + swz / 64; C = (st & 1) * 32 + (swz % 64) / 2; }
__device__ __forceinline__ int perm32(int rho) { const int n = rho >> 4, i = rho & 15; return 8 * (i >> 2) + 4 * n + (i & 3); }
struct Unit { int pm, pn; };
struct Gemm { const bf16_t* A; const bf16_t* Bt; int lda, ldb, K; };
struct StaticOrder {
    int nM, nN, nwg, G, c, skip;
    __device__ void init(int nM_, int nN_, int G_, int c_, int skip_ = 1 << 30) { nM = nM_; nN = nN_; nwg = nM * nN; G = G_; c = c_; skip = skip_; }
    __device__ bool next(int i, Unit& u) const {
        const long L = (long)i * G + c; if (L >= nwg) return false;
        int wgid = (int)L; { const int q = nwg / NXCD, r = nwg % NXCD, xcd = wgid % NXCD, off = wgid / NXCD; wgid = (xcd < r ? xcd * (q + 1) : r * (q + 1) + (xcd - r) * q) + off; }
        const int nig = WGM * nN, gid = wgid / nig, fm = gid * WGM, gsz = (nM - fm) < WGM ? (nM - fm) : WGM;
        u.pm = fm + ((wgid % nig) % gsz); u.pn = (wgid % nig) / gsz; if (u.pm >= skip) ++u.pm; return true;
    }
};

template <class Epi>
__device__ __forceinline__ void gemm_phase(const Ctx& cx, LAS unsigned char* lds, const Gemm g, const StaticOrder& S, const Epi& E) {
    const int tid = cx.tid, wid = __builtin_amdgcn_readfirstlane(tid >> 6), lane = tid & 63, wr = wid >> 2, wc = wid & 3, fr = lane & 15, fq = lane >> 4;
    const int K = g.K, nt = K / BK;
    unsigned voffA[2], voffB[2];
#pragma unroll
    for (int i = 0; i < 2; ++i) { int R, C; stage_rc(tid * 16 + i * 8192, R, C); const int Rb = (R & ~31) + perm32(R & 31);
        voffA[i] = (unsigned)(R * g.lda + C) * 2u; voffB[i] = (unsigned)(Rb * g.ldb + C) * 2u; }
    const size_t kstep = (size_t)(BK * 2);
    const size_t hstepA = (size_t)HALF * g.lda * 2, hstepB = (size_t)HALF * g.ldb * 2;
    const size_t tstepA = 2 * hstepA, tstepB = 2 * hstepB;
    const unsigned ldsw = (unsigned)wid * 1024u;
    const int aoff = lds_byte(wr * 64 + fr, fq * 8), boff = lds_byte(wc * 32 + fr, fq * 8);
#define PG8_SA(b, h) (((b) * 2 + (h)) * HTB)
#define PG8_SB(b, h) ((4 + (b) * 2 + (h)) * HTB)
#define PG8_STAGE(bufoff, gbase, voff) do { _Pragma("unroll") for (int _i = 0; _i < 2; ++_i) \
        __builtin_amdgcn_global_load_lds((const unsigned*)((const char*)(gbase) + (voff)[_i]), (LAS unsigned*)(lds + (bufoff) + ldsw + _i * 8192), 16, 0, 0); } while (0)
#define PG8_LDA(dst, b, h) do { _Pragma("unroll") for (int m = 0; m < 4; ++m) _Pragma("unroll") for (int k = 0; k < 2; ++k) dst[m][k] = *(const LAS bf16x8*)(lds + PG8_SA(b, h) + aoff + m * 2048 + k * 1024); } while (0)
#define PG8_LDB(dst, b, h) do { _Pragma("unroll") for (int n = 0; n < 2; ++n) _Pragma("unroll") for (int k = 0; k < 2; ++k) dst[n][k] = *(const LAS bf16x8*)(lds + PG8_SB(b, h) + boff + n * 2048 + k * 1024); } while (0)
#define PG8_MMA(ai, bj, At, Bt) do { __builtin_amdgcn_s_setprio(1); _Pragma("unroll") for (int m = 0; m < 4; ++m) _Pragma("unroll") for (int n = 0; n < 2; ++n) _Pragma("unroll") for (int k = 0; k < 2; ++k) \
        acc[ai][bj][m][n] = __builtin_amdgcn_mfma_f32_16x16x32_bf16(Bt[n][k], At[m][k], acc[ai][bj][m][n], 0, 0, 0); __builtin_amdgcn_s_setprio(0); } while (0)
#define PG8_WAIT_V(n) asm volatile("s_waitcnt vmcnt(" #n ")" ::: "memory")
#define PG8_WAIT_L(n) asm volatile("s_waitcnt lgkmcnt(" #n ")" ::: "memory")
#define PG8_BAR __builtin_amdgcn_s_barrier()
#define PG8_SCHED __builtin_amdgcn_sched_barrier(0)
    Unit cur, nxt; int ui = 0;
    if (!S.next(0, cur)) return;
    f32x4 acc[2][2][4][2];
#pragma unroll
    for (int a = 0; a < 2; ++a)
#pragma unroll
        for (int b = 0; b < 2; ++b)
#pragma unroll
            for (int m = 0; m < 4; ++m)
#pragma unroll
                for (int n = 0; n < 2; ++n) acc[a][b][m][n] = (f32x4){0.f, 0.f, 0.f, 0.f};
    bf16x8 At[4][2], B0[2][2], B1[2][2];
    const char* cA = (const char*)g.A + (size_t)cur.pm * tstepA; const char* cB = (const char*)g.Bt + (size_t)cur.pn * tstepB;
    if constexpr (Epi::RESCALE) E.prep((LAS float*)(lds + STAGE_BYTES), cur, tid);
    PG8_STAGE(PG8_SB(0, 0), cB, voffB); PG8_STAGE(PG8_SA(0, 0), cA, voffA); PG8_STAGE(PG8_SB(0, 1), cB + hstepB, voffB); PG8_STAGE(PG8_SA(0, 1), cA + hstepA, voffA);
    if (wr == 1) PG8_BAR;
    PG8_WAIT_V(4); PG8_BAR;
    PG8_STAGE(PG8_SB(1, 0), cB + kstep, voffB); PG8_STAGE(PG8_SA(1, 0), cA + kstep, voffA); PG8_STAGE(PG8_SB(1, 1), cB + hstepB + kstep, voffB);
    PG8_WAIT_V(6); PG8_BAR;
    for (;;) {
        const bool has_next = S.next(ui + 1, nxt);
        if constexpr (Epi::RESCALE) { if (has_next) E.prep((LAS float*)(lds + STAGE_BYTES) + ((ui + 1) & 1) * 1024, nxt, tid); }
        const char* nA = has_next ? (const char*)g.A + (size_t)nxt.pm * tstepA : cA; const char* nB = has_next ? (const char*)g.Bt + (size_t)nxt.pn * tstepB : cB;
        for (int t = 0; t < nt; t += 2) {
            const bool last = (t == nt - 2);
            const char* a1 = cA + (size_t)(t + 1) * kstep;
            const char* a2 = last ? nA : cA + (size_t)(t + 2) * kstep; const char* b2 = last ? nB : cB + (size_t)(t + 2) * kstep;
            const char* a3 = a2 + kstep; const char* b3 = b2 + kstep;
            PG8_LDB(B0, 0, 0); PG8_SCHED; PG8_LDA(At, 0, 0); PG8_STAGE(PG8_SA(1, 1), a1 + hstepA, voffA);
            PG8_WAIT_L(8); PG8_BAR; PG8_WAIT_L(0); PG8_MMA(0, 0, At, B0); PG8_BAR; PG8_SCHED;
            PG8_LDB(B1, 0, 1); PG8_STAGE(PG8_SB(0, 0), b2, voffB);
            PG8_BAR; PG8_WAIT_L(0); PG8_MMA(0, 1, At, B1); PG8_BAR;
            PG8_LDA(At, 0, 1); PG8_STAGE(PG8_SA(0, 0), a2, voffA);
            PG8_BAR; PG8_WAIT_L(0); PG8_MMA(1, 0, At, B0); PG8_BAR; PG8_SCHED;
            PG8_STAGE(PG8_SB(0, 1), b2 + hstepB, voffB);
            PG8_WAIT_V(6); PG8_BAR; PG8_MMA(1, 1, At, B1); PG8_BAR;
            PG8_LDB(B0, 1, 0); PG8_SCHED; PG8_LDA(At, 1, 0); PG8_STAGE(PG8_SA(0, 1), a2 + hstepA, voffA);
            PG8_WAIT_L(8); PG8_BAR; PG8_WAIT_L(0); PG8_MMA(0, 0, At, B0); PG8_BAR; PG8_SCHED;
            PG8_LDB(B1, 1, 1); PG8_STAGE(PG8_SB(1, 0), b3, voffB);
            PG8_BAR; PG8_WAIT_L(0); PG8_MMA(0, 1, At, B1); PG8_BAR;
            PG8_LDA(At, 1, 1); PG8_STAGE(PG8_SA(1, 0), a3, voffA);
            PG8_BAR; PG8_WAIT_L(0); PG8_MMA(1, 0, At, B0); PG8_BAR; PG8_SCHED;
            PG8_STAGE(PG8_SB(1, 1), b3 + hstepB, voffB);
            PG8_WAIT_V(6); PG8_BAR; PG8_MMA(1, 1, At, B1); PG8_BAR;
            if constexpr (Epi::RESCALE) { if (((t + 2) & 7) == 0 && t + 2 < nt) E.mid(acc, (const LAS float*)(lds + STAGE_BYTES) + (ui & 1) * 1024, ((t + 2) >> 3) - 1, wr, fr); }
        }
        if constexpr (Epi::RESCALE) E.fin(acc, (const LAS float*)(lds + STAGE_BYTES) + (ui & 1) * 1024, cur, wr, wc, fr, fq); else E(acc, cur, wr, wc, fr, fq);
        if (!has_next) break;
#pragma unroll
        for (int a = 0; a < 2; ++a)
#pragma unroll
            for (int b = 0; b < 2; ++b)
#pragma unroll
                for (int m = 0; m < 4; ++m)
#pragma unroll
                    for (int n = 0; n < 2; ++n) acc[a][b][m][n] = (f32x4){0.f, 0.f, 0.f, 0.f};
        cur = nxt; cA = nA; cB = nB; ++ui;
    }
    PG8_WAIT_V(0);
    if (wr == 0) PG8_BAR;
    PG8_BAR;
#undef PG8_SA
#undef PG8_SB
#undef PG8_STAGE
#undef PG8_LDA
#undef PG8_LDB
#undef PG8_MMA
#undef PG8_WAIT_V
#undef PG8_WAIT_L
#undef PG8_BAR
#undef PG8_SCHED
}
}
using pg8::Unit;

__device__ __forceinline__ u32x4 pack8(const float (&v)[8]) { return (u32x4){pk_bf16(v[0], v[1]), pk_bf16(v[2], v[3]), pk_bf16(v[4], v[5]), pk_bf16(v[6], v[7])}; }
__device__ __forceinline__ void unpack8(const u32x4 u, float (&v)[8]) {
#pragma unroll
    for (int q = 0; q < 4; ++q) { v[2 * q] = bf_lo(u[q]); v[2 * q + 1] = bf_hi(u[q]); }
}

struct EpiIn {
    static constexpr bool RESCALE = false;
    bf16_t* Z; const float* r1; float* ssv; const float* b_gate; int rowbase;
    __device__ __forceinline__ void operator()(const f32x4 (&acc)[2][2][4][2], const Unit& u, int wr, int wc, int fr, int fq) const {
        const int pn = u.pn, lane = fr + 16 * fq;
        const int kind = pn < 4 ? 0 : pn < 8 ? 1 : pn < 12 ? 2 : pn < 16 ? 3 : pn < 24 ? 4 : pn < 32 ? 5 : 6;
        const int row0 = u.pm * 256 + wr * 64 + fr, col0 = pn * 256 + wc * 32 + 8 * fq;
        if (kind == 2 || kind == 3) {
            const float ksc = kind == 3 ? 0.0625f : 1.f;
            float inv8[8];
#pragma unroll
            for (int e = 0; e < 8; ++e) inv8[e] = fexp2(-(float)(wc * 32 + 8 * fq + e) * (13.287712379549449f / 127.f)) * 0.15915494309189535f;
#pragma unroll
            for (int ai = 0; ai < 2; ++ai)
#pragma unroll
                for (int m = 0; m < 4; ++m) {
                    const int row = row0 + ai * 128 + m * 16, gr = rowbase + row;
                    const float pos = (float)(gr < 16384 ? (gr & 2047) : (gr < 16640 ? 1024 + ((gr - 16384) & 15) : ((gr - 16640) & 2047)));
                    float v0[8], v1[8], o0[8], o1[8];
#pragma unroll
                    for (int e = 0; e < 4; ++e) { v0[e] = acc[ai][0][m][0][e]; v0[4 + e] = acc[ai][0][m][1][e]; v1[e] = acc[ai][1][m][0][e]; v1[4 + e] = acc[ai][1][m][1][e]; }
#pragma unroll
                    for (int e = 0; e < 8; ++e) {
                        float t = pos * inv8[e]; t -= floorf(t);
                        const float sn = __builtin_amdgcn_sinf(t) * ksc, cs = __builtin_amdgcn_cosf(t) * ksc;
                        o0[e] = v0[e] * cs - v1[e] * sn; o1[e] = v0[e] * sn + v1[e] * cs;
                    }
                    *(u32x4*)(Z + (size_t)row * INC + col0) = pack8(o0); *(u32x4*)(Z + (size_t)row * INC + col0 + 128) = pack8(o1);
                }
            return;
        }
#pragma unroll
        for (int ai = 0; ai < 2; ++ai)
#pragma unroll
            for (int m = 0; m < 4; ++m) {
                const int row = row0 + ai * 128 + m * 16; float ss = 0.f;
#pragma unroll
                for (int bj = 0; bj < 2; ++bj) {
                    const int col = col0 + bj * 128; float v[8];
#pragma unroll
                    for (int e = 0; e < 4; ++e) { v[e] = acc[ai][bj][m][0][e]; v[4 + e] = acc[ai][bj][m][1][e]; }
                    if (kind == 0 || kind == 1) {
#pragma unroll
                        for (int e = 0; e < 4; ++e) { const f32x2 gq = gelu_t2((f32x2){v[2 * e], v[2 * e + 1]}); v[2 * e] = gq[0]; v[2 * e + 1] = gq[1]; }
                        if (kind == 1) {
#pragma unroll
                            for (int e = 0; e < 8; ++e) ss += v[e] * v[e];
                        }
                    } else if (kind == 3) {
#pragma unroll
                        for (int e = 0; e < 8; ++e) v[e] *= 0.0625f;
                    } else if (kind == 5) {
#pragma unroll
                        for (int e = 0; e < 4; ++e) { const f32x2 xx = (f32x2){v[2 * e], v[2 * e + 1]}, q2 = xx * sigm2(xx); v[2 * e] = q2[0]; v[2 * e + 1] = q2[1]; }
                    } else if (kind == 6) {
                        const f32x4 b0 = *(const f32x4*)(b_gate + col - 8192), b1 = *(const f32x4*)(b_gate + col - 8192 + 4);
                        const float bb[8] = {b0[0], b0[1], b0[2], b0[3], b1[0], b1[1], b1[2], b1[3]};
#pragma unroll
                        for (int e = 0; e < 4; ++e) { const f32x2 q2 = sigm2((f32x2){v[2 * e] + bb[2 * e], v[2 * e + 1] + bb[2 * e + 1]}); v[2 * e] = q2[0]; v[2 * e + 1] = q2[1]; }
                    }
                    *(u32x4*)(Z + (size_t)row * INC + col) = pack8(v);
                }
                if (kind == 1) { ss += shx(ss, 16, lane); ss += shx(ss, 32, lane); if (fq == 0) atomicAdd(ssv + rowbase + row, ss); }
            }
    }
};
struct EpiT1 {
    static constexpr bool RESCALE = false;
    bf16_t* T1; const bf16_t* Z;
    __device__ __forceinline__ void operator()(const f32x4 (&acc)[2][2][4][2], const Unit& u, int wr, int wc, int fr, int fq) const {
        const int row0 = u.pm * 256 + wr * 64 + fr, col0 = u.pn * 256 + wc * 32 + 8 * fq;
#pragma unroll
        for (int ai = 0; ai < 2; ++ai)
#pragma unroll
            for (int m = 0; m < 4; ++m) {
                const int row = row0 + ai * 128 + m * 16;
#pragma unroll
                for (int bj = 0; bj < 2; ++bj) {
                    const int col = col0 + bj * 128; float v[8], gt[8];
                    unpack8(*(const u32x4*)(Z + (size_t)row * INC + 8192 + col), gt);
#pragma unroll
                    for (int e = 0; e < 4; ++e) { v[e] = acc[ai][bj][m][0][e] * gt[e]; v[4 + e] = acc[ai][bj][m][1][e] * gt[4 + e]; }
                    *(u32x4*)(T1 + (size_t)row * 1024 + col) = pack8(v);
                }
            }
    }
};
struct EpiM1 {
    static constexpr bool RESCALE = true;
    const bf16_t* T1; const bf16_t* Z; bf16_t* M1; int rowbase; const float* sso;
    __device__ __forceinline__ void prep(LAS float* tab, const Unit& u, int tid) const {
        if (tid < 256) {
            const f32x4 sv = *(const f32x4*)(sso + (size_t)(rowbase + u.pm * 256 + tid) * 4);
            const float c0 = sv[0] * (1.f / 512.f) + EPS, c1 = sv[1] * (1.f / 512.f) + EPS, c2 = sv[2] * (1.f / 512.f) + EPS, c3 = sv[3] * (1.f / 512.f) + EPS;
            *(LAS f32x4*)(tab + tid * 4) = (f32x4){__builtin_sqrtf(c1 * frcp(c0)), __builtin_sqrtf(c2 * frcp(c1)), __builtin_sqrtf(c3 * frcp(c2)), rsq(c3)};
        }
    }
    __device__ __forceinline__ void mid(f32x4 (&acc)[2][2][4][2], const LAS float* tab, int seg, int wr, int fr) const {
#pragma unroll
        for (int ai = 0; ai < 2; ++ai)
#pragma unroll
            for (int m = 0; m < 4; ++m) {
                const float f = tab[(ai * 128 + wr * 64 + m * 16 + fr) * 4 + seg];
#pragma unroll
                for (int bj = 0; bj < 2; ++bj)
#pragma unroll
                    for (int n = 0; n < 2; ++n) acc[ai][bj][m][n] = acc[ai][bj][m][n] * f;
            }
    }
    __device__ __forceinline__ void operator()(const f32x4 (&acc)[2][2][4][2], const Unit& u, int wr, int wc, int fr, int fq) const {}
    __device__ __forceinline__ void fin(const f32x4 (&acc)[2][2][4][2], const LAS float* tab, const Unit& u, int wr, int wc, int fr, int fq) const {
        const int row0 = u.pm * 256 + wr * 64 + fr, col0 = u.pn * 256 + wc * 32 + 8 * fq;
#pragma unroll
        for (int ai = 0; ai < 2; ++ai)
#pragma unroll
            for (int m = 0; m < 4; ++m) {
                const int row = row0 + ai * 128 + m * 16; const float rn3 = tab[(ai * 128 + wr * 64 + m * 16 + fr) * 4 + 3];
#pragma unroll
                for (int bj = 0; bj < 2; ++bj) {
                    const int col = col0 + bj * 128; float v[8], gt[8], t1[8];
                    unpack8(*(const u32x4*)(Z + (size_t)row * INC + 9216 + col), gt);
                    unpack8(*(const u32x4*)(T1 + (size_t)row * 1024 + col), t1);
#pragma unroll
                    for (int e = 0; e < 4; ++e) { v[e] = t1[e] + acc[ai][bj][m][0][e] * rn3 * gt[e]; v[4 + e] = t1[4 + e] + acc[ai][bj][m][1][e] * rn3 * gt[4 + e]; }
                    *(u32x4*)(M1 + (size_t)(rowbase + row) * 1024 + col) = pack8(v);
                }
            }
    }
};
struct EpiX2 {
    static constexpr bool RESCALE = false;
    const float* xp; const float* xs; float* out; bf16_t* X2b; float* ss2;
    __device__ __forceinline__ void operator()(const f32x4 (&acc)[2][2][4][2], const Unit& u, int wr, int wc, int fr, int fq) const {
        const int row0 = u.pm * 256 + wr * 64 + fr, col0 = u.pn * 256 + wc * 32 + 8 * fq, lane = fr + 16 * fq;
#pragma unroll
        for (int ai = 0; ai < 2; ++ai)
#pragma unroll
            for (int m = 0; m < 4; ++m) {
                const int row = row0 + ai * 128 + m * 16;
                const float* xr = row < 16384 ? xp + (size_t)row * 1024 : (row < 16640 ? xs + (size_t)(row - 16384) * 1024 : xp + (size_t)(row - 256) * 1024);
                float* yr = row < 16384 ? out + O_YP + (size_t)row * 1024 : (row < 16640 ? out + O_YS + (size_t)(row - 16384) * 1024 : out + O_YP + (size_t)(row - 256) * 1024);
                float ss = 0.f;
#pragma unroll
                for (int bj = 0; bj < 2; ++bj) {
                    const int col = col0 + bj * 128; float v[8];
                    const f32x4 x0 = *(const f32x4*)(xr + col), x1 = *(const f32x4*)(xr + col + 4);
#pragma unroll
                    for (int e = 0; e < 4; ++e) { v[e] = acc[ai][bj][m][0][e] + x0[e]; v[4 + e] = acc[ai][bj][m][1][e] + x1[e]; }
#pragma unroll
                    for (int e = 0; e < 8; ++e) ss += v[e] * v[e];
                    *(f32x4*)(yr + col) = (f32x4){v[0], v[1], v[2], v[3]}; *(f32x4*)(yr + col + 4) = (f32x4){v[4], v[5], v[6], v[7]};
                    *(u32x4*)(X2b + (size_t)row * 1024 + col) = pack8(v);
                }
                ss += shx(ss, 16, lane); ss += shx(ss, 32, lane); if (fq == 0) atomicAdd(ss2 + row, ss);
            }
    }
};
struct EpiQP {
    static constexpr bool RESCALE = false;
    bf16_t* QP; const float* ss2;
    __device__ __forceinline__ void operator()(const f32x4 (&acc)[2][2][4][2], const Unit& u, int wr, int wc, int fr, int fq) const {
        const int row0 = u.pm * 256 + wr * 64 + fr, col0 = u.pn * 256 + wc * 32 + 8 * fq;
#pragma unroll
        for (int ai = 0; ai < 2; ++ai)
#pragma unroll
            for (int m = 0; m < 4; ++m) {
                const int row = row0 + ai * 128 + m * 16; const float rs = rsq(ss2[row] * (1.f / 1024.f) + EPS);
#pragma unroll
                for (int bj = 0; bj < 2; ++bj) {
                    const int col = col0 + bj * 128; float v[8];
#pragma unroll
                    for (int e = 0; e < 4; ++e) { v[e] = acc[ai][bj][m][0][e] * rs; v[4 + e] = acc[ai][bj][m][1][e] * rs; }
                    *(u32x4*)(QP + (size_t)row * 2048 + col) = pack8(v);
                }
            }
    }
};

__device__ __forceinline__ void convert_item(const Params& p, unsigned char* ws, size_t i) {
        const int d = (int)((i * 16) & 1023);
        unsigned ou[4], ov[4];
#pragma unroll
        for (int q = 0; q < 4; ++q) {
            const f32x4 a = *(const f32x4*)(p.eu + i * 16 + q * 4), g0 = *(const f32x4*)(p.g_ffn + d + q * 4), c = *(const f32x4*)(p.ev + i * 16 + q * 4);
            int u = __builtin_amdgcn_cvt_pk_fp8_f32(a[0] * g0[0] * EU_SCALE, a[1] * g0[1] * EU_SCALE, 0, false);
            u = __builtin_amdgcn_cvt_pk_fp8_f32(a[2] * g0[2] * EU_SCALE, a[3] * g0[3] * EU_SCALE, u, true);
            int v = __builtin_amdgcn_cvt_pk_fp8_f32(c[0] * EV_SCALE, c[1] * EV_SCALE, 0, false);
            v = __builtin_amdgcn_cvt_pk_fp8_f32(c[2] * EV_SCALE, c[3] * EV_SCALE, v, true);
            ou[q] = (unsigned)u; ov[q] = (unsigned)v;
        }
        *(u32x4*)(ws + OFF_EU + (i >> 6) * 2048 + (i & 63) * 16) = (u32x4){ou[0], ou[1], ou[2], ou[3]};
        *(u32x4*)(ws + OFF_EU + (i >> 6) * 2048 + 1024 + (i & 63) * 16) = (u32x4){ov[0], ov[1], ov[2], ov[3]};
    }
constexpr size_t CONV_ITEMS = (size_t)16384 * 64;

__device__ __forceinline__ void transpose_tile(const Ctx& cx, const float* src, bf16_t* dst, const float* scale, int K, int N, int tile, LAS float* tl) {
    const int tn = N / 64, k0 = (tile / tn) * 64, n0 = (tile % tn) * 64, tid = cx.tid;
    const int n4 = (tid & 15) * 4, kr = tid >> 4;
#pragma unroll
    for (int i = 0; i < 2; ++i) {
        const int kk = kr + 32 * i; f32x4 v = *(const f32x4*)(src + (size_t)(k0 + kk) * N + n0 + n4);
        if (scale) v = v * scale[k0 + kk];
        tl[kk * 65 + n4] = v[0]; tl[kk * 65 + n4 + 1] = v[1]; tl[kk * 65 + n4 + 2] = v[2]; tl[kk * 65 + n4 + 3] = v[3];
    }
    __syncthreads();
    const int n = tid >> 3, kc = (tid & 7) * 8; float o[8];
#pragma unroll
    for (int e = 0; e < 8; ++e) o[e] = tl[(kc + e) * 65 + n];
    *(u32x4*)(dst + (size_t)(n0 + n) * K + k0 + kc) = pack8(o);
    __syncthreads();
}
__device__ __forceinline__ void phase0(const Ctx& cx, const Params& p, LAS unsigned char* lds) {
    unsigned char* ws = p.ws; LAS float* tl = (LAS float*)lds;
    for (int j = cx.bid; j < 4096; j += cx.nb) {
        if (j < 2560) transpose_tile(cx, p.w_in, (bf16_t*)(ws + OFF_WIN), p.g_mix, 1024, 10240, j, tl);
        else if (j < 2816) transpose_tile(cx, p.w_pa, (bf16_t*)(ws + OFF_WA), nullptr, 1024, 1024, j - 2560, tl);
        else if (j < 3328) transpose_tile(cx, p.w_pb, (bf16_t*)(ws + OFF_WB), nullptr, 2048, 1024, j - 2816, tl);
        else if (j < 3584) transpose_tile(cx, p.w_out, (bf16_t*)(ws + OFF_WO), nullptr, 1024, 1024, j - 3328, tl);
        else transpose_tile(cx, p.w_q, (bf16_t*)(ws + OFF_WQ), p.g_ffn, 1024, 2048, j - 3584, tl);
    }
    const size_t gtid = (size_t)cx.bid * 512 + cx.tid, nth = (size_t)cx.nb * 512;
    for (size_t i = gtid; i < 16384; i += nth) { ((bf16_t*)(ws + OFF_K1))[i] = f2bf(p.k1[i]); ((bf16_t*)(ws + OFF_K2))[i] = f2bf(p.k2[i]); }
    for (size_t i = gtid; i < (size_t)NTOK * 6; i += nth) ((float*)(ws + OFF_SSV))[i] = 0.f;
    const int wid = __builtin_amdgcn_readfirstlane(cx.tid >> 6), lane = cx.tid & 63;
    bf16_t* xb = (bf16_t*)((unsigned char*)p.out + OUT_XB);
    for (int r = cx.bid * 8 + wid; r < NTOK; r += cx.nb * 8) {
        const float* xr = xrow(p, r); f32x4 v[4]; float ss = 0.f;
#pragma unroll
        for (int j = 0; j < 4; ++j) { v[j] = *(const f32x4*)(xr + lane * 8 + (j >> 1) * 512 + (j & 1) * 4); ss += v[j][0] * v[j][0] + v[j][1] * v[j][1] + v[j][2] * v[j][2] + v[j][3] * v[j][3]; }
        ss = wave_sum(ss, lane);
        const float rs = rsq(ss * (1.f / 1024.f) + EPS);
#pragma unroll
        for (int j = 0; j < 2; ++j)
            *(u32x4*)(xb + (size_t)r * 1024 + lane * 8 + j * 512) = (u32x4){pk_bf16(v[2 * j][0] * rs, v[2 * j][1] * rs), pk_bf16(v[2 * j][2] * rs, v[2 * j][3] * rs),
                                                                          pk_bf16(v[2 * j + 1][0] * rs, v[2 * j + 1][1] * rs), pk_bf16(v[2 * j + 1][2] * rs, v[2 * j + 1][3] * rs)};
    }
}

__device__ __forceinline__ void retention_unit(const Ctx& cx, LAS unsigned char* lds, bf16_t* Z, int zrow0, int grow0, int nchunks, int Lc, int pos0, int h, int slice,
                               const float* s0, float* s_out, float* sso) {
    LAS bf16_t* Qs = (LAS bf16_t*)lds; LAS bf16_t* Ks = (LAS bf16_t*)(lds + 33792); LAS bf16_t* ST = (LAS bf16_t*)(lds + 67584);
    LAS bf16_t* VT = (LAS bf16_t*)(lds + 101376); LAS bf16_t* Ps = (LAS bf16_t*)(lds + 110592);
    const int tid = cx.tid, wid = __builtin_amdgcn_readfirstlane(tid >> 6), lane = tid & 63, fr = lane & 15, fq = lane >> 4;
    const float l2g = log2f(1.f - exp2f(-5.f - (float)h));
    f32x4 accS[2][4];
#pragma unroll
    for (int dt = 0; dt < 2; ++dt)
#pragma unroll
        for (int dvt = 0; dvt < 4; ++dvt) {
#pragma unroll
            for (int j = 0; j < 4; ++j) { const int d = (2 * wid + dt) * 16 + fq * 4 + j; accS[dt][dvt][j] = s0 ? s0[(size_t)d * 512 + slice * 64 + dvt * 16 + fr] : 0.f; }
            *(LAS u32x2*)(ST + (dvt * 16 + fr) * 264 + (2 * wid + dt) * 16 + fq * 4) = (u32x2){pk_bf16(accS[dt][dvt][0], accS[dt][dvt][1]), pk_bf16(accS[dt][dvt][2], accS[dt][dvt][3])};
        }
    const float sdec = fexp2(l2g * (float)Lc);
    __syncthreads();
    u32x4 rq1[2], rq2[2], rk1[2], rk2[2], rv; u32x2 rsg[2];
    const int vm = tid >> 3, vc0 = (tid & 7) * 8;
    auto fetch = [&](int c) {
        const size_t zr = (size_t)(zrow0 + c * 64);
#pragma unroll
        for (int it = 0; it < 2; ++it) {
            const int item = tid + 512 * it, n = item >> 4, dc = (item & 15) * 8;
            rq1[it] = (u32x4){0, 0, 0, 0}; rq2[it] = rq1[it]; rk1[it] = rq1[it]; rk2[it] = rq1[it];
            if (n < Lc) {
                const bf16_t* zp = Z + (zr + n) * INC + 2048 + h * 256 + dc;
                rq1[it] = *(const u32x4*)zp; rq2[it] = *(const u32x4*)(zp + 128); rk1[it] = *(const u32x4*)(zp + 1024); rk2[it] = *(const u32x4*)(zp + 1152);
            }
        }
        rv = (u32x4){0, 0, 0, 0};
        if (vm < Lc) rv = *(const u32x4*)(Z + (zr + vm) * INC + 4096 + h * 512 + slice * 64 + vc0);
#pragma unroll
        for (int i = 0; i < 2; ++i) {
            rsg[i] = (u32x2){0, 0};
            const int n = (wid >> 1) * 16 + fr;
            if (n < Lc) rsg[i] = *(const u32x2*)(Z + (zr + n) * INC + 6144 + h * 512 + slice * 64 + (2 * (wid & 1) + i) * 16 + fq * 4);
        }
    };
    fetch(0);
    for (int c = 0; c < nchunks; ++c) {
        const size_t zr = (size_t)(zrow0 + c * 64);
#pragma unroll
        for (int it = 0; it < 2; ++it) {
            const int item = tid + 512 * it, n = item >> 4, dc = (item & 15) * 8;
            *(LAS u32x4*)(Qs + n * 264 + dc) = rq1[it]; *(LAS u32x4*)(Qs + n * 264 + 128 + dc) = rq2[it];
            *(LAS u32x4*)(Ks + n * 264 + dc) = rk1[it]; *(LAS u32x4*)(Ks + n * 264 + 128 + dc) = rk2[it];
        }
        {
            float v[8]; unpack8(rv, v);
            const float kd = fexp2(l2g * (float)(Lc - 1 - vm));
#pragma unroll
            for (int e = 0; e < 8; ++e) v[e] *= kd;
            *(LAS u32x4*)(VT + vm * 72 + vc0) = pack8(v);
        }
        __syncthreads();
        u32x2 sgc[2] = {rsg[0], rsg[1]};
        if (c + 1 < nchunks) fetch(c + 1);
        const int nt = wid >> 1;
#pragma unroll
        for (int mi = 0; mi < 2; ++mi) {
            const int mt = 2 * (wid & 1) + mi; f32x4 acc = (f32x4){0.f, 0.f, 0.f, 0.f};
            if (mt <= nt) {
#pragma unroll
                for (int ks = 0; ks < 8; ++ks) {
                    const bf16x8 a = *(const LAS bf16x8*)(Qs + (nt * 16 + fr) * 264 + ks * 32 + fq * 8), b = *(const LAS bf16x8*)(Ks + (mt * 16 + fr) * 264 + ks * 32 + fq * 8);
                    acc = MFMA16(a, b, acc);
                }
            }
#pragma unroll
            for (int j = 0; j < 4; ++j) {
                const int n = nt * 16 + fq * 4 + j, m = mt * 16 + fr;
                const float val = (m <= n) ? acc[j] * fexp2(l2g * (float)(n - (Lc - 1))) : 0.f;
                Ps[n * 72 + m] = f2bf(val);
            }
        }
        f32x4 accO[2];
#pragma unroll
        for (int i = 0; i < 2; ++i) {
            const int dvt = 2 * (wid & 1) + i; accO[i] = (f32x4){0.f, 0.f, 0.f, 0.f};
#pragma unroll
            for (int ks = 0; ks < 8; ++ks) {
                const bf16x8 a = *(const LAS bf16x8*)(ST + (dvt * 16 + fr) * 264 + ks * 32 + fq * 8), b = *(const LAS bf16x8*)(Qs + (nt * 16 + fr) * 264 + ks * 32 + fq * 8);
                accO[i] = MFMA16(a, b, accO[i]);
            }
            const float qd = fexp2(l2g * (float)(nt * 16 + fr + 1));
            accO[i] = accO[i] * qd;
        }
        __syncthreads();
#pragma unroll
        for (int i = 0; i < 2; ++i) {
            const int dvt = 2 * (wid & 1) + i;
#pragma unroll
            for (int ks = 0; ks < 2; ++ks) {
                const bf16x8 a = tr_frag(VT + ks * 32 * 72 + dvt * 16, 72, lane), b = *(const LAS bf16x8*)(Ps + (nt * 16 + fr) * 72 + ks * 32 + fq * 8);
                accO[i] = MFMA16(a, b, accO[i]);
            }
        }
#pragma unroll
        for (int dt = 0; dt < 2; ++dt)
#pragma unroll
            for (int dvt = 0; dvt < 4; ++dvt) accS[dt][dvt] = accS[dt][dvt] * sdec;
#pragma unroll
        for (int ks = 0; ks < 2; ++ks) {
            bf16x8 bv[4];
#pragma unroll
            for (int dvt = 0; dvt < 4; ++dvt) bv[dvt] = tr_frag(VT + ks * 32 * 72 + dvt * 16, 72, lane);
#pragma unroll
            for (int dt = 0; dt < 2; ++dt) {
                const bf16x8 a = tr_frag(Ks + ks * 32 * 264 + (2 * wid + dt) * 16, 264, lane);
#pragma unroll
                for (int dvt = 0; dvt < 4; ++dvt) accS[dt][dvt] = MFMA16(a, bv[dvt], accS[dt][dvt]);
            }
        }
#pragma unroll
        for (int dt = 0; dt < 2; ++dt)
#pragma unroll
            for (int dvt = 0; dvt < 4; ++dvt)
                *(LAS u32x2*)(ST + (dvt * 16 + fr) * 264 + (2 * wid + dt) * 16 + fq * 4) = (u32x2){pk_bf16(accS[dt][dvt][0], accS[dt][dvt][1]), pk_bf16(accS[dt][dvt][2], accS[dt][dvt][3])};
        {
            float ss = 0.f; const int n = nt * 16 + fr;
#pragma unroll
            for (int i = 0; i < 2; ++i) {
                const int dvt = 2 * (wid & 1) + i;
                ss += accO[i][0] * accO[i][0] + accO[i][1] * accO[i][1] + accO[i][2] * accO[i][2] + accO[i][3] * accO[i][3];
                if (n < Lc) *(u32x2*)(Z + (zr + n) * INC + 4096 + h * 512 + slice * 64 + dvt * 16 + fq * 4) =
                    (u32x2){pk_bf16(accO[i][0] * bf_lo(sgc[i][0]), accO[i][1] * bf_hi(sgc[i][0])), pk_bf16(accO[i][2] * bf_lo(sgc[i][1]), accO[i][3] * bf_hi(sgc[i][1]))};
            }
            ss += shx(ss, 16, lane); ss += shx(ss, 32, lane);
            if (fq == 0 && n < Lc) atomicAdd(sso + (size_t)(grow0 + c * 64 + n) * 4 + h, ss);
        }
        __syncthreads();
    }
#pragma unroll
    for (int dt = 0; dt < 2; ++dt)
#pragma unroll
        for (int dvt = 0; dvt < 4; ++dvt)
#pragma unroll
            for (int j = 0; j < 4; ++j) { const int d = (2 * wid + dt) * 16 + fq * 4 + j; s_out[(size_t)d * 512 + slice * 64 + dvt * 16 + fr] = accS[dt][dvt][j]; }
}

__device__ __forceinline__ void sgu_unit(const Ctx& cx, const Params& p, LAS unsigned char* lds, bf16_t* Z, int zrow0, int grow0, int rows, int g, float* vout, const float* ssv, bool load_w) {
    LAS bf16_t* WS = (LAS bf16_t*)lds; LAS bf16_t* VT = (LAS bf16_t*)(lds + 34816);
    const int tid = cx.tid, wid = __builtin_amdgcn_readfirstlane(tid >> 6), lane = tid & 63, fr = lane & 15, fq = lane >> 4;
    if (load_w)
#pragma unroll
    for (int it = 0; it < 4; ++it) {
        const int item = tid + 512 * it, n = item >> 4, m0 = (item & 15) * 8;
        const float* src = p.w_s + ((size_t)g * 128 + n) * 128 + m0;
        const f32x4 a = *(const f32x4*)src, b = *(const f32x4*)(src + 4); float v[8];
#pragma unroll
        for (int e = 0; e < 4; ++e) { v[e] = (m0 + e <= n) ? a[e] : 0.f; v[4 + e] = (m0 + 4 + e <= n) ? b[e] : 0.f; }
        *(LAS u32x4*)(WS + n * 136 + m0) = pack8(v);
    }
#pragma unroll
    for (int it = 0; it < 4; ++it) {
        const int item = tid + 512 * it, m = item >> 4, d0 = (item & 15) * 8; float v[8];
#pragma unroll
        for (int e = 0; e < 8; ++e) v[e] = 0.f;
        if (m < rows) {
            unpack8(*(const u32x4*)(Z + (size_t)(zrow0 + m) * INC + 1024 + g * 128 + d0), v);
            const float rs = rsq(ssv[grow0 + m] * (1.f / 1024.f) + EPS);
            const f32x4 g0 = *(const f32x4*)(p.g_sgu + g * 128 + d0), g1 = *(const f32x4*)(p.g_sgu + g * 128 + d0 + 4);
#pragma unroll
            for (int e = 0; e < 4; ++e) { v[e] *= rs * g0[e]; v[4 + e] *= rs * g1[e]; }
            if (vout) { *(f32x4*)(vout + (size_t)m * 1024 + g * 128 + d0) = (f32x4){v[0], v[1], v[2], v[3]}; *(f32x4*)(vout + (size_t)m * 1024 + g * 128 + d0 + 4) = (f32x4){v[4], v[5], v[6], v[7]}; }
        }
        *(LAS u32x4*)(VT + m * 136 + d0) = pack8(v);
    }
    u32x2 uu[8]; float bias = 0.f;
    if (wid * 16 < rows) {
        bias = p.b_s[g * 128 + wid * 16 + fr];
#pragma unroll
        for (int dt = 0; dt < 8; ++dt) uu[dt] = *(const u32x2*)(Z + (size_t)(zrow0 + wid * 16 + fr) * INC + g * 128 + dt * 16 + fq * 4);
    }
    __syncthreads();
    if (wid * 16 < rows) {
        const int nks = (wid >> 1) + 1;
        f32x4 acc[8];
#pragma unroll
        for (int dt = 0; dt < 8; ++dt) acc[dt] = (f32x4){0.f, 0.f, 0.f, 0.f};
        for (int ks = 0; ks < nks; ++ks) {
            const bf16x8 b = *(const LAS bf16x8*)(WS + (wid * 16 + fr) * 136 + ks * 32 + fq * 8);
#pragma unroll
            for (int dt = 0; dt < 8; ++dt) { const bf16x8 a = tr_frag(VT + ks * 32 * 136 + dt * 16, 136, lane); acc[dt] = MFMA16(a, b, acc[dt]); }
        }
        const int n = wid * 16 + fr;
#pragma unroll
        for (int dt = 0; dt < 8; ++dt) {
            bf16_t* up = Z + (size_t)(zrow0 + n) * INC + g * 128 + dt * 16 + fq * 4;
            *(u32x2*)up = (u32x2){pk_bf16(bf_lo(uu[dt][0]) * (acc[dt][0] + bias), bf_hi(uu[dt][0]) * (acc[dt][1] + bias)), pk_bf16(bf_lo(uu[dt][1]) * (acc[dt][2] + bias), bf_hi(uu[dt][1]) * (acc[dt][3] + bias))};
        }
    }
    __syncthreads();
}

__device__ __forceinline__ void phase2(const Ctx& cx, const Params& p, LAS unsigned char* lds, int hf) {
    unsigned char* ws = p.ws; bf16_t* Z = (bf16_t*)(ws + OFF_Z); float* sso = (float*)(ws + OFF_SSO); const float* ssv = (const float*)(ws + OFF_SSV);
    const int rowbase = hf ? NH0 : 0;
    for (int u = cx.bid; u < 256; u += cx.nb) {
        const int slice = u & 7, h = (u >> 3) & 3, bl = u >> 5, b = hf * 8 + bl;
        retention_unit(cx, lds, Z, bl * 2048, rowbase + bl * 2048, 32, 64, 0, h, slice, nullptr, p.out + O_SP + ((size_t)b * 4 + h) * 256 * 512, sso);
    }
    if (hf == 0) {
        for (int u = cx.bid; u < 512; u += cx.nb) {
            const int slice = u & 7, h = (u >> 3) & 3, b = u >> 5;
            retention_unit(cx, lds, Z, 16384 + b * 16, 16384 + b * 16, 1, 16, 1024, h, slice, p.state + ((size_t)b * 4 + h) * 256 * 512,
                           p.out + O_SS + ((size_t)b * 4 + h) * 256 * 512, sso);
        }
    }
    const int nprompt = 128 * 8, nsgu = nprompt + (hf == 0 ? 16 * 8 : 0);
    int last_g = -1;
    for (int u = cx.bid; u < nsgu; u += cx.nb) {
        if (u < nprompt) { const int g = u & 7, ci = u >> 3; sgu_unit(cx, p, lds, Z, ci * 128, rowbase + ci * 128, 128, g, nullptr, ssv, g != last_g); last_g = g; }
        else { const int v = u - nprompt, g = v & 7, b = v >> 3; sgu_unit(cx, p, lds, Z, 16384 + b * 16, 16384 + b * 16, 16, g, p.out + O_SV + (size_t)b * 16 * 1024, ssv, g != last_g); last_g = g; }
    }
}

#define CE_DESC(x, i, l) do { const float _a = fmaxf(x[i], x[l]), _b = fminf(x[i], x[l]); x[i] = _a; x[l] = _b; } while (0)
__device__ __forceinline__ void bitonic_sort16_desc(float (&x)[16]) {
#pragma unroll
    for (int k = 2; k <= 16; k <<= 1)
#pragma unroll
        for (int j = k >> 1; j > 0; j >>= 1)
#pragma unroll
            for (int i = 0; i < 16; ++i) {
                const int l = i ^ j;
                if (l > i) { if ((i & k) == 0 || k == 16) CE_DESC(x, i, l); else CE_DESC(x, l, i); }
            }
}
__device__ __forceinline__ void bitonic_merge16_desc(float (&x)[16]) {
#pragma unroll
    for (int j = 8; j > 0; j >>= 1)
#pragma unroll
        for (int i = 0; i < 16; ++i) { const int l = i ^ j; if (l > i) CE_DESC(x, i, l); }
}
#define TOPK_INS_FROM(L, x, S0) do { float _v = (x); _Pragma("unroll") for (int _i = (S0); _i < 16; ++_i) { const float _h = fmaxf(L[_i], _v); _v = fminf(L[_i], _v); L[_i] = _h; } } while (0)
__device__ __forceinline__ void phase7(const Ctx& cx, const Params& p, LAS unsigned char* lds) {
    unsigned char* ws = p.ws; const bf16_t* QP = (const bf16_t*)(ws + OFF_QP); int* ids = (int*)(ws + OFF_IDS); float* wts = (float*)(ws + OFF_WTS);
    LAS bf16_t* KEYS = (LAS bf16_t*)lds;
    LAS float* SC = (LAS float*)(lds + 69632);
    LAS float* TP = (LAS float*)(lds + 69632 + 67584);
    const int tid = cx.tid, wid = __builtin_amdgcn_readfirstlane(tid >> 6), lane = tid & 63, fr = lane & 15, fq = lane >> 4;
#pragma unroll
    for (int it = 0; it < 8; ++it) {
        const int idx = tid + 512 * it, tab = idx >> 11, row = (idx >> 4) & 127, c8 = (idx & 15) * 8;
        *(LAS u32x4*)(KEYS + tab * 17408 + row * 136 + c8) = *(const u32x4*)((const bf16_t*)(ws + (tab ? OFF_K2 : OFF_K1)) + row * 128 + c8);
    }
    bf16x8 a[2][4], an[2][4];
    auto load_a = [&](int tile, bf16x8 (&d)[2][4]) {
#pragma unroll
        for (int half = 0; half < 2; ++half)
#pragma unroll
            for (int ks = 0; ks < 4; ++ks) d[half][ks] = *(const bf16x8*)(QP + (size_t)(tile * 16 + fr) * 2048 + wid * 256 + half * 128 + ks * 32 + fq * 8);
    };
    if (cx.bid < NTOK / 16) load_a(cx.bid, an);
    __syncthreads();
    const size_t cv_end = CONV_ITEMS * (size_t)(cx.bid + 1) / (size_t)cx.nb; size_t cv_pos = CONV_ITEMS * (size_t)cx.bid / (size_t)cx.nb;
    for (int tile = cx.bid; tile < NTOK / 16; tile += cx.nb) {
        const int row0 = tile * 16;
#pragma unroll
        for (int half = 0; half < 2; ++half)
#pragma unroll
            for (int ks = 0; ks < 4; ++ks) a[half][ks] = an[half][ks];
        if (tile + cx.nb < NTOK / 16) load_a(tile + cx.nb, an);
#pragma unroll
        for (int half = 0; half < 2; ++half) {
#pragma unroll
            for (int nt = 0; nt < 8; ++nt) {
                f32x4 acc = (f32x4){0.f, 0.f, 0.f, 0.f};
#pragma unroll
                for (int ks = 0; ks < 4; ++ks) acc = MFMA16(a[half][ks], *(const LAS bf16x8*)(KEYS + half * 17408 + (nt * 16 + fr) * 136 + ks * 32 + fq * 8), acc);
#pragma unroll
                for (int j = 0; j < 4; ++j) {
                    const int t = fq * 4 + j, list = t * 8 + wid, n = nt * 16 + fr;
                    SC[list * 132 + ((n + 8 * fq) & 127)] = __uint_as_float((__float_as_uint(acc[j]) & ~127u) | (unsigned)n);
                }
            }
            __syncthreads();
            if (tid < 256) {
                const int list = tid >> 1, part = tid & 1; const LAS float* sp = SC + list * 132 + part * 64;
                float T[16];
#pragma unroll
                for (int i = 0; i < 4; ++i) { const f32x4 v = *(const LAS f32x4*)(sp + i * 4); T[4 * i] = v[0]; T[4 * i + 1] = v[1]; T[4 * i + 2] = v[2]; T[4 * i + 3] = v[3]; }
                bitonic_sort16_desc(T);
#pragma unroll 1
                for (int grp = 1; grp < 4; ++grp) {
                    float G[16];
#pragma unroll
                    for (int i = 0; i < 4; ++i) { const f32x4 v = *(const LAS f32x4*)(sp + grp * 16 + i * 4); G[4 * i] = v[0]; G[4 * i + 1] = v[1]; G[4 * i + 2] = v[2]; G[4 * i + 3] = v[3]; }
                    bitonic_sort16_desc(G);
#pragma unroll
                    for (int i = 0; i < 16; ++i) T[i] = fmaxf(T[i], G[15 - i]);
                    bitonic_merge16_desc(T);
                }
                float O[16];
#pragma unroll
                for (int i = 0; i < 16; ++i) O[i] = __int_as_float(__builtin_amdgcn_update_dpp(0, __float_as_int(T[i]), 0xB1, 0xF, 0xF, true));
#pragma unroll
                for (int i = 0; i < 16; ++i) T[i] = fmaxf(T[i], O[15 - i]);
                bitonic_merge16_desc(T);
                if (part == 0) {
#pragma unroll
                    for (int i = 0; i < 4; ++i) *(LAS f32x4*)(TP + (list * 2 + half) * 16 + i * 4) = (f32x4){T[4 * i], T[4 * i + 1], T[4 * i + 2], T[4 * i + 3]};
                }
            } else if (cv_pos + (size_t)(tid - 256) < cv_end) convert_item(p, ws, cv_pos + (size_t)(tid - 256));
            cv_pos += 256;
            __syncthreads();
        }
        if (tid < 128) {
            float v1[16], v2[16], L[16];
#pragma unroll
            for (int i = 0; i < 4; ++i) {
                const f32x4 va = *(const LAS f32x4*)(TP + (tid * 2) * 16 + i * 4), vb = *(const LAS f32x4*)(TP + (tid * 2 + 1) * 16 + i * 4);
#pragma unroll
                for (int e = 0; e < 4; ++e) { v1[4 * i + e] = va[e]; v2[4 * i + e] = vb[e]; }
            }
#pragma unroll
            for (int jj = 0; jj < 16; ++jj) { const float c = v1[0] + v2[jj]; L[jj] = __uint_as_float((__float_as_uint(c) & ~255u) | (unsigned)jj); }
#pragma unroll
            for (int i = 1; i < 16; ++i)
#pragma unroll
                for (int jj = 0; jj < 16; ++jj)
                    if ((i + 1) * (jj + 1) <= 16) { const float c = v1[i] + v2[jj]; TOPK_INS_FROM(L, __uint_as_float((__float_as_uint(c) & ~255u) | (unsigned)(i * 16 + jj)), (i + 1) * (jj + 1) - 1); }
            float ex[16], sum = 0.f;
#pragma unroll
            for (int k = 0; k < 16; ++k) { ex[k] = fexp2((L[k] - L[0]) * 1.44269504f); sum += ex[k]; }
            const float rinv = 1.f / sum;
#pragma unroll
            for (int k = 0; k < 16; ++k) {
                const unsigned code = __float_as_uint(L[k]) & 255u;
                const unsigned e1 = __float_as_uint(TP[(tid * 2) * 16 + (code >> 4)]) & 127u, e2 = __float_as_uint(TP[(tid * 2 + 1) * 16 + (code & 15u)]) & 127u;
                ((LAS int*)SC)[tid * 16 + k] = (int)(e1 * 128u + e2); SC[2048 + tid * 16 + k] = ex[k] * rinv;
            }
        }
        __syncthreads();
        *(u32x4*)(ids + (size_t)row0 * 128 + tid * 4) = *(const LAS u32x4*)((LAS int*)SC + tid * 4);
        *(f32x4*)(wts + (size_t)row0 * 128 + tid * 4) = *(const LAS f32x4*)(SC + 2048 + tid * 4);
        __syncthreads();
    }
    for (size_t it = cv_pos + tid; it < cv_end; it += 512) convert_item(p, ws, it);
}

__device__ __forceinline__ void phase8(const Ctx& cx, const Params& p, LAS unsigned char* lds) {
    unsigned char* ws = p.ws; const unsigned char* EU = ws + OFF_EU; const unsigned char* EV = ws + OFF_EV;
    const int* ids = (const int*)(ws + OFF_IDS); const float* wts = (const float*)(ws + OFF_WTS);
    const float* ss2 = (const float*)(ws + OFF_SS2);
    const int tid = cx.tid, wid = __builtin_amdgcn_readfirstlane(tid >> 6), lane = tid & 63, fr = lane & 15, fq = lane >> 4;
    const int nfull = (NTOK / (cx.nb * 8)) * (cx.nb * 8);
    const unsigned char* ET = ws + OFF_EU;
    int nid0 = 0, nid1 = 0; float nw0 = 0.f, nw1 = 0.f, nr2 = 0.f;
    auto fetch_ids = [&](int r, int& i0_, int& i1_, float& a0, float& a1, float& rr) {
        i0_ = ids[(size_t)r * 128 + lane] & 16383; i1_ = ids[(size_t)r * 128 + 64 + lane] & 16383;
        a0 = wts[(size_t)r * 128 + lane]; a1 = wts[(size_t)r * 128 + 64 + lane];
        rr = rsq(ss2[r] * (1.f / 1024.f) + EPS) * (1.f / EU_SCALE);
    };
    if (cx.bid * 8 + wid < nfull) fetch_ids(cx.bid * 8 + wid, nid0, nid1, nw0, nw1, nr2);
    for (int r = cx.bid * 8 + wid; r < nfull; r += cx.nb * 8) {
        const int id0 = nid0, id1 = nid1; const float w0 = nw0, w1 = nw1, r2 = nr2;
        float* yr = yrow(p, r);
        f32x2 tq[4][8];
#pragma unroll
        for (int j = 0; j < 4; ++j)
#pragma unroll
            for (int q = 0; q < 4; ++q) { const f32x4 v = *(const f32x4*)(yr + (fr + 16 * j) * 16 + q * 4); tq[j][2 * q] = (f32x2){v[0], v[1]}; tq[j][2 * q + 1] = (f32x2){v[2], v[3]}; }
        if (r + cx.nb * 8 < nfull) fetch_ids(r + cx.nb * 8, nid0, nid1, nw0, nw1, nr2);
        f32x2 acc[4][8];
#pragma unroll
        for (int j = 0; j < 4; ++j)
#pragma unroll
            for (int q = 0; q < 8; ++q) acc[j][q] = (f32x2){0.f, 0.f};
#pragma unroll 2
        for (int it = 0; it < 32; ++it) {
            const int src = ((it & 15) << 2) + fq;
            const int e = it < 16 ? shl_(id0, src) : shl_(id1, src);
            const float w = it < 16 ? shl_(w0, src) : shl_(w1, src);
            const unsigned char* rp = ET + (size_t)e * 2048 + fr * 16;
            u32x4 du[4], dv[4];
#pragma unroll
            for (int j = 0; j < 4; ++j) { du[j] = *(const u32x4*)(rp + j * 256); dv[j] = *(const u32x4*)(rp + 1024 + j * 256); }
            f32x2 s2 = (f32x2){0.f, 0.f};
#pragma unroll
            for (int j = 0; j < 4; ++j)
#pragma unroll
                for (int q = 0; q < 4; ++q) {
                    s2 = __builtin_amdgcn_cvt_pk_f32_fp8((int)du[j][q], false) * tq[j][2 * q] + s2;
                    s2 = __builtin_amdgcn_cvt_pk_f32_fp8((int)du[j][q], true) * tq[j][2 * q + 1] + s2;
                }
            const float sd = row16_sum(s2[0] + s2[1]);
            const float c = w * gelu_t(r2 * sd) * (1.f / EV_SCALE); const f32x2 cc = (f32x2){c, c};
#pragma unroll
            for (int j = 0; j < 4; ++j)
#pragma unroll
                for (int q = 0; q < 4; ++q) {
                    acc[j][2 * q] = __builtin_amdgcn_cvt_pk_f32_fp8((int)dv[j][q], false) * cc + acc[j][2 * q];
                    acc[j][2 * q + 1] = __builtin_amdgcn_cvt_pk_f32_fp8((int)dv[j][q], true) * cc + acc[j][2 * q + 1];
                }
        }
        float ss = 0.f;
#pragma unroll
        for (int j = 0; j < 4; ++j)
#pragma unroll
            for (int q = 0; q < 8; ++q)
#pragma unroll
                for (int h2 = 0; h2 < 2; ++h2) { float v = acc[j][q][h2]; v += shx(v, 16, lane); v += shx(v, 32, lane); acc[j][q][h2] = v; }
        if (fq == 0) {
#pragma unroll
            for (int j = 0; j < 4; ++j)
#pragma unroll
                for (int q = 0; q < 4; ++q) {
                    const f32x4 xv = *(const f32x4*)(yr + (fr + 16 * j) * 16 + q * 4);
                    acc[j][2 * q][0] += xv[0]; acc[j][2 * q][1] += xv[1]; acc[j][2 * q + 1][0] += xv[2]; acc[j][2 * q + 1][1] += xv[3];
                    ss += acc[j][2 * q][0] * acc[j][2 * q][0] + acc[j][2 * q][1] * acc[j][2 * q][1] + acc[j][2 * q + 1][0] * acc[j][2 * q + 1][0] + acc[j][2 * q + 1][1] * acc[j][2 * q + 1][1];
                }
        }
        ss = wave_sum(ss, lane);
        const float rs = rsq(ss * (1.f / 1024.f) + EPS);
        if (fq == 0) {
#pragma unroll
            for (int j = 0; j < 4; ++j)
#pragma unroll
                for (int q = 0; q < 4; ++q) {
                    const f32x4 g0 = *(const f32x4*)(p.g_final + (fr + 16 * j) * 16 + q * 4);
                    *(f32x4*)(yr + (fr + 16 * j) * 16 + q * 4) = (f32x4){acc[j][2 * q][0], acc[j][2 * q][1], acc[j][2 * q + 1][0], acc[j][2 * q + 1][1]} * rs * g0;
                }
        }
    }
    LAS float* cfb = (LAS float*)lds; LAS float* part = (LAS float*)(lds + 4096);
    __syncthreads();
    for (int r = nfull + cx.bid; r < NTOK; r += cx.nb) {
        const int id0 = ids[(size_t)r * 128 + lane] & 16383, id1 = ids[(size_t)r * 128 + 64 + lane] & 16383;
        const float w0 = wts[(size_t)r * 128 + lane], w1 = wts[(size_t)r * 128 + 64 + lane];
        const float r2 = rsq(ss2[r] * (1.f / 1024.f) + EPS) * (1.f / EU_SCALE);
        float* yr = yrow(p, r);
        f32x2 tq[4][8];
#pragma unroll
        for (int j = 0; j < 4; ++j)
#pragma unroll
            for (int q = 0; q < 4; ++q) { const f32x4 v = *(const f32x4*)(yr + (fr + 16 * j) * 16 + q * 4); tq[j][2 * q] = (f32x2){v[0], v[1]}; tq[j][2 * q + 1] = (f32x2){v[2], v[3]}; }
#pragma unroll
        for (int i4 = 0; i4 < 4; ++i4) {
            const int it = wid * 4 + i4, src = ((it & 15) << 2) + fq;
            const int e = it < 16 ? shl_(id0, src) : shl_(id1, src);
            const float w = it < 16 ? shl_(w0, src) : shl_(w1, src);
            const unsigned char* rp = ET + (size_t)e * 2048 + fr * 16;
            u32x4 d[4];
#pragma unroll
            for (int j = 0; j < 4; ++j) d[j] = *(const u32x4*)(rp + j * 256);
            f32x2 s2 = (f32x2){0.f, 0.f};
#pragma unroll
            for (int j = 0; j < 4; ++j)
#pragma unroll
                for (int q = 0; q < 4; ++q) {
                    s2 = __builtin_amdgcn_cvt_pk_f32_fp8((int)d[j][q], false) * tq[j][2 * q] + s2;
                    s2 = __builtin_amdgcn_cvt_pk_f32_fp8((int)d[j][q], true) * tq[j][2 * q + 1] + s2;
                }
            const float sd = row16_sum(s2[0] + s2[1]);
            if (fr == 0) cfb[it * 4 + fq] = w * gelu_t(r2 * sd) * (1.f / EV_SCALE);
        }
        __syncthreads();
        const float c0 = cfb[lane], c1 = cfb[64 + lane];
        const int idsel = wid < 4 ? id0 : id1; const float csel = wid < 4 ? c0 : c1;
        f32x2 acc[8];
#pragma unroll
        for (int i = 0; i < 8; ++i) acc[i] = (f32x2){0.f, 0.f};
#pragma unroll
        for (int k16 = 0; k16 < 16; ++k16) {
            const int kk = (wid & 3) * 16 + k16;
            const int e = __builtin_amdgcn_readlane(idsel, kk); const float c = __int_as_float(__builtin_amdgcn_readlane(__float_as_int(csel), kk));
            const u32x4 v = *(const u32x4*)(ET + (size_t)e * 2048 + 1024 + lane * 16); const f32x2 cc = (f32x2){c, c};
#pragma unroll
            for (int q = 0; q < 4; ++q) { acc[2 * q] = __builtin_amdgcn_cvt_pk_f32_fp8((int)v[q], false) * cc + acc[2 * q]; acc[2 * q + 1] = __builtin_amdgcn_cvt_pk_f32_fp8((int)v[q], true) * cc + acc[2 * q + 1]; }
        }
#pragma unroll
        for (int q = 0; q < 4; ++q) *(LAS f32x4*)(part + (wid * 64 + lane) * 16 + q * 4) = (f32x4){acc[2 * q][0], acc[2 * q][1], acc[2 * q + 1][0], acc[2 * q + 1][1]};
        __syncthreads();
        if (wid == 0) {
            float ss = 0.f; f32x4 x[4];
#pragma unroll
            for (int j = 0; j < 4; ++j) {
                x[j] = *(const f32x4*)(yr + lane * 16 + j * 4);
#pragma unroll
                for (int w8 = 0; w8 < 8; ++w8) x[j] += *(const LAS f32x4*)(part + (w8 * 64 + lane) * 16 + j * 4);
                ss += x[j][0] * x[j][0] + x[j][1] * x[j][1] + x[j][2] * x[j][2] + x[j][3] * x[j][3];
            }
            ss = wave_sum(ss, lane);
            const float rs = rsq(ss * (1.f / 1024.f) + EPS);
#pragma unroll
            for (int j = 0; j < 4; ++j) { const f32x4 g0 = *(const f32x4*)(p.g_final + lane * 16 + j * 4); *(f32x4*)(yr + lane * 16 + j * 4) = x[j] * rs * g0; }
        }
        __syncthreads();
    }
}

__device__ __forceinline__ void strip_mma(const bf16_t* A, int lda, const bf16_t* Bt, int ldb, int K, int c, int wid, int fr, int fq, f32x4 (&acc)[2]) {
#pragma unroll 2
    for (int ks = 0; ks < K / 32; ks += 4) {
        bf16x8 a[2][4], b[4];
#pragma unroll
        for (int u = 0; u < 4; ++u) {
            b[u] = *(const bf16x8*)(Bt + (size_t)(16 * c + fr) * ldb + (ks + u) * 32 + fq * 8);
#pragma unroll
            for (int i = 0; i < 2; ++i) a[i][u] = *(const bf16x8*)(A + (size_t)((2 * wid + i) * 16 + fr) * lda + (ks + u) * 32 + fq * 8);
        }
#pragma unroll
        for (int u = 0; u < 4; ++u)
#pragma unroll
            for (int i = 0; i < 2; ++i) acc[i] = MFMA16(a[i][u], b[u], acc[i]);
    }
}
__device__ __forceinline__ void sample_merge(const Ctx& cx, const Params& p) {
    unsigned char* ws = p.ws; const bf16_t* Zs = (const bf16_t*)(ws + OFF_Z) + (size_t)16384 * INC; bf16_t* M1 = (bf16_t*)(ws + OFF_M1) + (size_t)16384 * 1024;
    const int tid = cx.tid, wid = __builtin_amdgcn_readfirstlane(tid >> 6), lane = tid & 63, fr = lane & 15, fq = lane >> 4;
    for (int c = cx.bid; c < 64; c += cx.nb) {
        f32x4 aa[2] = {(f32x4){0.f, 0.f, 0.f, 0.f}, (f32x4){0.f, 0.f, 0.f, 0.f}}, ab[2] = {(f32x4){0.f, 0.f, 0.f, 0.f}, (f32x4){0.f, 0.f, 0.f, 0.f}};
        strip_mma(Zs, INC, (const bf16_t*)(ws + OFF_WA), 1024, 1024, c, wid, fr, fq, aa);
#pragma unroll 1
        for (int hh = 0; hh < 4; ++hh) {
            f32x4 ah[2] = {(f32x4){0.f, 0.f, 0.f, 0.f}, (f32x4){0.f, 0.f, 0.f, 0.f}};
            strip_mma(Zs + 4096 + hh * 512, INC, (const bf16_t*)(ws + OFF_WB) + hh * 512, 2048, 512, c, wid, fr, fq, ah);
#pragma unroll
            for (int i = 0; i < 2; ++i)
#pragma unroll
                for (int j = 0; j < 4; ++j) ab[i][j] += ah[i][j] * rsq(((const float*)(ws + OFF_SSO))[(size_t)(16384 + (2 * wid + i) * 16 + fq * 4 + j) * 4 + hh] * (1.f / 512.f) + EPS);
        }
#pragma unroll
        for (int i = 0; i < 2; ++i)
#pragma unroll
            for (int j = 0; j < 4; ++j) {
                const int row = (2 * wid + i) * 16 + fq * 4 + j, col = 16 * c + fr;
                const float ga = bf_lo((unsigned)Zs[(size_t)row * INC + 8192 + col]), gb = bf_lo((unsigned)Zs[(size_t)row * INC + 9216 + col]);
                M1[(size_t)row * 1024 + col] = f2bf(ga * aa[i][j] + gb * ab[i][j]);
            }
    }
}
__device__ __forceinline__ void sample_x2(const Ctx& cx, const Params& p) {
    unsigned char* ws = p.ws; bf16_t* X2b = (bf16_t*)(ws + OFF_X2B) + (size_t)16384 * 1024; float* ss2 = (float*)(ws + OFF_SS2) + 16384;
    const int tid = cx.tid, wid = __builtin_amdgcn_readfirstlane(tid >> 6), lane = tid & 63, fr = lane & 15, fq = lane >> 4;
    for (int c = cx.bid; c < 64; c += cx.nb) {
        f32x4 acc[2] = {(f32x4){0.f, 0.f, 0.f, 0.f}, (f32x4){0.f, 0.f, 0.f, 0.f}};
        strip_mma((const bf16_t*)(ws + OFF_M1) + (size_t)16384 * 1024, 1024, (const bf16_t*)(ws + OFF_WO), 1024, 1024, c, wid, fr, fq, acc);
#pragma unroll
        for (int i = 0; i < 2; ++i)
#pragma unroll
            for (int j = 0; j < 4; ++j) {
                const int row = (2 * wid + i) * 16 + fq * 4 + j, col = 16 * c + fr;
                const float v = p.xs[(size_t)row * 1024 + col] + acc[i][j];
                p.out[O_YS + (size_t)row * 1024 + col] = v; X2b[(size_t)row * 1024 + col] = f2bf(v);
                const float sq = row16_sum(v * v);
                if (fr == 0) atomicAdd(ss2 + row, sq);
            }
    }
}
__device__ __forceinline__ void sample_query(const Ctx& cx, const Params& p) {
    unsigned char* ws = p.ws; bf16_t* QP = (bf16_t*)(ws + OFF_QP) + (size_t)16384 * 2048; const float* ss2 = (const float*)(ws + OFF_SS2) + 16384;
    const int tid = cx.tid, wid = __builtin_amdgcn_readfirstlane(tid >> 6), lane = tid & 63, fr = lane & 15, fq = lane >> 4;
    for (int c = cx.bid; c < 128; c += cx.nb) {
        f32x4 acc[2] = {(f32x4){0.f, 0.f, 0.f, 0.f}, (f32x4){0.f, 0.f, 0.f, 0.f}};
        strip_mma((const bf16_t*)(ws + OFF_X2B) + (size_t)16384 * 1024, 1024, (const bf16_t*)(ws + OFF_WQ), 1024, 1024, c, wid, fr, fq, acc);
#pragma unroll
        for (int i = 0; i < 2; ++i)
#pragma unroll
            for (int j = 0; j < 4; ++j) {
                const int row = (2 * wid + i) * 16 + fq * 4 + j, col = 16 * c + fr;
                QP[(size_t)row * 2048 + col] = f2bf(acc[i][j] * rsq(ss2[row] * (1.f / 1024.f) + EPS));
            }
    }
}

__device__ __forceinline__ void run_phase(const Params& p, LAS unsigned char* lds, int ph, const Ctx& cx) {
    unsigned char* ws = p.ws; pg8::StaticOrder S; pg8::Gemm g;
    bf16_t* Z = (bf16_t*)(ws + OFF_Z); bf16_t* T1 = (bf16_t*)((unsigned char*)p.out + OUT_T1);
    if (ph == 0) { phase0(cx, p, lds); return; }
    if (ph >= 1 && ph <= 8) {
        const int hf = (ph - 1) >> 2, sub = (ph - 1) & 3, rowbase = hf ? NH0 : 0, nM = hf ? 64 : 65;
        if (sub == 0) {
            g.A = (const bf16_t*)((unsigned char*)p.out + OUT_XB) + (size_t)rowbase * 1024; g.Bt = (const bf16_t*)(ws + OFF_WIN); g.lda = 1024; g.ldb = 1024; g.K = 1024;
            S.init(nM, 40, cx.nb, cx.bid);
            EpiIn E{Z, (const float*)(ws + OFF_R1), (float*)(ws + OFF_SSV), p.b_gate, rowbase};
            pg8::gemm_phase(cx, lds, g, S, E);
        } else if (sub == 1) phase2(cx, p, lds, hf);
#ifdef DBG_SKIP_P3
        else if (sub == 2) { }
#else
        else if (sub == 2) { }
#endif
        else {
            S.init(64, 4, cx.nb, cx.bid);
            g.A = Z; g.Bt = (const bf16_t*)(ws + OFF_WA); g.lda = INC; g.ldb = 1024; g.K = 1024;
            EpiT1 E1{T1, Z}; pg8::gemm_phase(cx, lds, g, S, E1);
            g.A = Z + 4096; g.Bt = (const bf16_t*)(ws + OFF_WB); g.lda = INC; g.ldb = 2048; g.K = 2048;
            EpiM1 E2{T1, Z, (bf16_t*)(ws + OFF_M1), rowbase, (const float*)(ws + OFF_SSO)}; pg8::gemm_phase(cx, lds, g, S, E2);
            if (hf == 0) sample_merge(cx, p);
        }
        return;
    }
#ifdef DBG_YCONST
    if (ph >= 9 && ph <= 11) return;
#endif
    if (ph == 9) {
        g.A = (const bf16_t*)(ws + OFF_M1); g.Bt = (const bf16_t*)(ws + OFF_WO); g.lda = 1024; g.ldb = 1024; g.K = 1024;
        S.init(128, 4, cx.nb, cx.bid, 64);
        EpiX2 E{p.xp, p.xs, p.out, (bf16_t*)(ws + OFF_X2B), (float*)(ws + OFF_SS2)}; pg8::gemm_phase(cx, lds, g, S, E);
        sample_x2(cx, p); return;
    }
    if (ph == 10) {
        g.A = (const bf16_t*)(ws + OFF_X2B); g.Bt = (const bf16_t*)(ws + OFF_WQ); g.lda = 1024; g.ldb = 1024; g.K = 1024;
        S.init(128, 8, cx.nb, cx.bid, 64);
        EpiQP E{(bf16_t*)(ws + OFF_QP), (const float*)(ws + OFF_SS2)}; pg8::gemm_phase(cx, lds, g, S, E);
        sample_query(cx, p); return;
    }
    if (ph == 11) { phase7(cx, p, lds); return; }
    if (ph == 12) { phase8(cx, p, lds); return; }
}
constexpr int NPHASE = 13;

extern __shared__ __attribute__((aligned(16))) unsigned char dyn_smem[];

#if ONE_LAUNCH
__device__ __forceinline__ void grid_barrier(unsigned* ctr, unsigned target, int tid) {
    asm volatile("s_waitcnt vmcnt(0)" ::: "memory");
    __syncthreads();
    if (tid == 0) {
        __builtin_amdgcn_fence(__ATOMIC_RELEASE, "agent");
        asm volatile("s_waitcnt vmcnt(0)" ::: "memory");
        __hip_atomic_fetch_add(ctr, 1u, __ATOMIC_RELAXED, __HIP_MEMORY_SCOPE_AGENT);
        while (__hip_atomic_load(ctr, __ATOMIC_RELAXED, __HIP_MEMORY_SCOPE_AGENT) < target) __builtin_amdgcn_s_sleep(2);
        __builtin_amdgcn_fence(__ATOMIC_ACQUIRE, "agent");
        asm volatile("s_waitcnt vmcnt(0)" ::: "memory");
    }
    __syncthreads();
}
__global__ __launch_bounds__(512, 2) void mega_kernel(Params p) {
#if defined(__HIP_DEVICE_COMPILE__)
    LAS unsigned char* lds = (LAS unsigned char*)dyn_smem;
    cg::grid_group grid = cg::this_grid();
    const int wave0 = __builtin_amdgcn_readfirstlane((int)threadIdx.x >> 6);
    unsigned nbar = 0;
    { int never = 0; asm volatile("" : "+s"(never));
      if (never == 1000) grid.sync(); }
#pragma nounroll
    for (int ph = 0; ph < NPHASE; ++ph) {
        int phv = ph; asm volatile("" : "+s"(phv));
        int wv = wave0; asm volatile("" : "+s"(wv));
        int ln = (int)__builtin_amdgcn_mbcnt_hi(~0u, __builtin_amdgcn_mbcnt_lo(~0u, 0u)); asm volatile("" : "+v"(ln));
        Ctx cx; cx.tid = wv * 64 + ln; cx.bid = blockIdx.x; cx.nb = gridDim.x;
        asm volatile("" : "+s"(cx.bid)); asm volatile("" : "+s"(cx.nb));
        auto ka = __builtin_amdgcn_kernarg_segment_ptr(); asm volatile("" : "+s"(ka));
        const Params pl = *(const Params __attribute__((address_space(4)))*)(unsigned long long)ka;
        unsigned lo = 0; asm volatile("" : "+s"(lo));
        if (ph == 3 || ph == 7) continue;
        run_phase(pl, lds + lo, phv, cx);
        if (ph + 1 < NPHASE) { ++nbar; grid_barrier((unsigned*)(pl.ws + OFF_BAR), nbar * (unsigned)cx.nb, cx.tid); }
    }
#endif
}
#else
__global__ __launch_bounds__(512, 2) void stage_kernel(Params p, int ph) {
    LAS unsigned char* lds = (LAS unsigned char*)dyn_smem;
    Ctx cx; cx.tid = threadIdx.x; cx.bid = blockIdx.x; cx.nb = gridDim.x;
    run_phase(p, lds, ph, cx);
}
#endif

extern "C" void kernel_launch(void* const* d_in, const int* in_sizes, int n_in, void* d_out, int out_size, void* d_ws, size_t ws_size, hipStream_t stream) {
    Params p; memset(&p, 0, sizeof(p));
    p.xp = (const float*)d_in[0]; p.xs = (const float*)d_in[1]; p.state = (const float*)d_in[2]; p.w_in = (const float*)d_in[3]; p.w_s = (const float*)d_in[4];
    p.b_s = (const float*)d_in[5]; p.g_sgu = (const float*)d_in[6]; p.w_pa = (const float*)d_in[7]; p.w_pb = (const float*)d_in[8]; p.b_gate = (const float*)d_in[9];
    p.w_out = (const float*)d_in[10]; p.g_mix = (const float*)d_in[11]; p.g_ffn = (const float*)d_in[12]; p.w_q = (const float*)d_in[13]; p.k1 = (const float*)d_in[14];
    p.k2 = (const float*)d_in[15]; p.eu = (const float*)d_in[16]; p.ev = (const float*)d_in[17]; p.g_final = (const float*)d_in[18];
    p.out = (float*)d_out; p.ws = (unsigned char*)d_ws;
    if (ws_size < WS_NEED) { fprintf(stderr, "workspace too small: %zu < %zu\n", ws_size, (size_t)WS_NEED); return; }
#if ONE_LAUNCH
    static int grid_blocks = 0;
    if (!grid_blocks) {
        (void)hipFuncSetAttribute((const void*)mega_kernel, hipFuncAttributeMaxDynamicSharedMemorySize, LDS_BYTES);
        int dev = 0, cus = 0, per_cu = 0;
        hipGetDevice(&dev); hipDeviceGetAttribute(&cus, hipDeviceAttributeMultiprocessorCount, dev);
        hipOccupancyMaxActiveBlocksPerMultiprocessor(&per_cu, mega_kernel, 512, LDS_BYTES);
        if (per_cu < 1) per_cu = 1;
        grid_blocks = cus * 1;
    }
    (void)hipMemsetAsync((unsigned char*)d_ws + OFF_BAR, 0, 256, stream);
    void* args[] = {&p};
    hipError_t e = hipLaunchCooperativeKernel((const void*)mega_kernel, dim3(grid_blocks), dim3(512), args, LDS_BYTES, stream);
    if (e != hipSuccess) fprintf(stderr, "cooperative launch failed: %s (grid %d)\n", hipGetErrorString(e), grid_blocks);
#else
    static bool attr = false;
    if (!attr) { (void)hipFuncSetAttribute((const void*)stage_kernel, hipFuncAttributeMaxDynamicSharedMemorySize, LDS_BYTES); attr = true; }
    for (int ph = 0; ph < NPHASE; ++ph) hipLaunchKernelGGL(stage_kernel, dim3(256), dim3(512), LDS_BYTES, stream, p, ph);
#endif
}
```

```cpp
#include <hip/hip_runtime.h>
#include <hip/hip_cooperative_groups.h>
#include <cstdio>
#include <cstring>
namespace cg = cooperative_groups;

#ifndef ONE_LAUNCH
#define ONE_LAUNCH 1
#endif

#define LAS __attribute__((address_space(3)))
typedef unsigned short bf16_t;
typedef short bf16x8 __attribute__((ext_vector_type(8)));
typedef float f32x4 __attribute__((ext_vector_type(4)));
typedef unsigned u32x4 __attribute__((ext_vector_type(4)));
typedef unsigned u32x2 __attribute__((ext_vector_type(2)));
typedef __bf16 bf16x2_t __attribute__((ext_vector_type(2)));

constexpr int DM = 1024, NTOK = 33024, NH0 = 16640, INC = 10240;
constexpr float EPS = 1e-6f;
constexpr int LDS_BYTES = 153600;
constexpr float EU_SCALE = 64.f, EV_SCALE = 64.f;

constexpr size_t OFF_WIN = 0;
constexpr size_t OFF_WA  = OFF_WIN + (size_t)10240 * 1024 * 2;
constexpr size_t OFF_WB  = OFF_WA + (size_t)1024 * 1024 * 2;
constexpr size_t OFF_WO  = OFF_WB + (size_t)1024 * 2048 * 2;
constexpr size_t OFF_WQ  = OFF_WO + (size_t)1024 * 1024 * 2;
constexpr size_t OFF_EU  = OFF_WQ + (size_t)2048 * 1024 * 2;
constexpr size_t OFF_EV  = OFF_EU + (size_t)16384 * 1024 * 2;
constexpr size_t OFF_K1  = OFF_EV + (size_t)16384 * 1024 * 2;
constexpr size_t OFF_K2  = OFF_K1 + 32768;
constexpr size_t OFF_M1  = OFF_K2 + 32768;
constexpr size_t OFF_R1  = OFF_M1 + (size_t)NTOK * 1024 * 2;
constexpr size_t OFF_SSV = OFF_R1 + (size_t)NTOK * 4;
constexpr size_t OFF_SS2 = OFF_SSV + (size_t)NTOK * 4;
constexpr size_t OFF_SSO = OFF_SS2 + (size_t)NTOK * 4;
constexpr size_t OFF_Z   = OFF_SSO + (size_t)NTOK * 16;
constexpr size_t Z_BYTES = (size_t)NH0 * INC * 2;
constexpr size_t OFF_BAR = OFF_Z + Z_BYTES;
constexpr size_t WS_NEED = OFF_BAR + 256;
constexpr size_t OFF_X2B = OFF_Z;
constexpr size_t OFF_QP  = OFF_X2B + (size_t)NTOK * 1024 * 2;
constexpr size_t OFF_IDS = OFF_QP + (size_t)NTOK * 2048 * 2;
constexpr size_t OFF_WTS = OFF_IDS + (size_t)NTOK * 128 * 4;
constexpr size_t OUT_XB = 0;
constexpr size_t OUT_T1 = (size_t)NTOK * 1024 * 2;
constexpr size_t O_YP = 0, O_YS = (size_t)32768 * 1024, O_SP = O_YS + (size_t)256 * 1024, O_SS = O_SP + (size_t)16 * 4 * 256 * 512,
                 O_SV = O_SS + (size_t)16 * 4 * 256 * 512;

struct Params {
    const float *xp, *xs, *state, *w_in, *w_s, *b_s, *g_sgu, *w_pa, *w_pb, *b_gate, *w_out, *g_mix, *g_ffn, *w_q, *k1, *k2, *eu, *ev, *g_final;
    float* out;
    unsigned char* ws;
};

struct Ctx { int tid, bid, nb; };

__device__ __forceinline__ float bf_lo(unsigned u) { return __uint_as_float(u << 16); }
__device__ __forceinline__ float bf_hi(unsigned u) { return __uint_as_float(u & 0xffff0000u); }
typedef float f32x2 __attribute__((ext_vector_type(2)));
__device__ __forceinline__ unsigned pk_bf16(float lo, float hi) {
    f32x2 v = {lo, hi}; bf16x2_t b = __builtin_convertvector(v, bf16x2_t); return __builtin_bit_cast(unsigned, b);
}
__device__ __forceinline__ bf16_t f2bf(float f) { return (bf16_t)(pk_bf16(f, 0.f) & 0xffffu); }
__device__ __forceinline__ float fexp2(float x) { return __builtin_amdgcn_exp2f(x); }
__device__ __forceinline__ float frcp(float x) { return __builtin_amdgcn_rcpf(x); }
__device__ __forceinline__ float sigm(float x) { return frcp(1.f + fexp2(-1.44269504f * x)); }
__device__ __forceinline__ float gelu_t(float x) { const float u = 0.7978845608f * (x + 0.044715f * x * x * x); return x * frcp(1.f + fexp2(-2.88539008f * u)); }
__device__ __forceinline__ float rsq(float x) { return __builtin_amdgcn_rsqf(x); }
__device__ __forceinline__ f32x2 sigm2(f32x2 x) {
    const f32x2 t = x * (-1.44269504f); f32x2 e; e.x = fexp2(t.x); e.y = fexp2(t.y);
    const f32x2 d = e + 1.f; f32x2 r; r.x = frcp(d.x); r.y = frcp(d.y); return r;
}
__device__ __forceinline__ f32x2 gelu_t2(f32x2 x) {
    const f32x2 w = (x * x) * (-0.10294324f) + (-2.3022082f), t = x * w;
    f32x2 e; e.x = fexp2(t.x); e.y = fexp2(t.y);
    const f32x2 d = e + 1.f;
    f32x2 r; r.x = frcp(d.x); r.y = frcp(d.y);
    return x * r;
}
__device__ __forceinline__ const float* xrow(const Params& p, int ir) {
    return ir < 16384 ? p.xp + (size_t)ir * 1024 : (ir < 16640 ? p.xs + (size_t)(ir - 16384) * 1024 : p.xp + (size_t)(ir - 256) * 1024);
}
__device__ __forceinline__ float* yrow(const Params& p, int ir) {
    return ir < 16384 ? p.out + O_YP + (size_t)ir * 1024 : (ir < 16640 ? p.out + O_YS + (size_t)(ir - 16384) * 1024 : p.out + O_YP + (size_t)(ir - 256) * 1024);
}
__device__ __forceinline__ float shx(float v, int m, int lane) { return __int_as_float(__builtin_amdgcn_ds_bpermute((lane ^ m) << 2, __float_as_int(v))); }
__device__ __forceinline__ float shl_(float v, int src) { return __int_as_float(__builtin_amdgcn_ds_bpermute(src << 2, __float_as_int(v))); }
__device__ __forceinline__ int shl_(int v, int src) { return __builtin_amdgcn_ds_bpermute(src << 2, v); }
__device__ __forceinline__ float wave_sum(float v, int lane) {
#pragma unroll
    for (int o = 32; o >= 1; o >>= 1) v += shx(v, o, lane);
    return v;
}
__device__ __forceinline__ float row16_sum(float s) {
    s += __int_as_float(__builtin_amdgcn_update_dpp(0, __float_as_int(s), 0xB1, 0xF, 0xF, true));
    s += __int_as_float(__builtin_amdgcn_update_dpp(0, __float_as_int(s), 0x4E, 0xF, 0xF, true));
    s += __int_as_float(__builtin_amdgcn_update_dpp(0, __float_as_int(s), 0x141, 0xF, 0xF, true));
    s += __int_as_float(__builtin_amdgcn_update_dpp(0, __float_as_int(s), 0x140, 0xF, 0xF, true));
    return s;
}
__device__ __forceinline__ float dot2bf(unsigned a, unsigned b, float c) {
    return __builtin_amdgcn_fdot2_f32_bf16(__builtin_bit_cast(bf16x2_t, a), __builtin_bit_cast(bf16x2_t, b), c, false);
}
typedef short s16x4 __attribute__((ext_vector_type(4)));
__device__ __forceinline__ bf16x8 tr_frag(const LAS bf16_t* tile, int stride, int lane) {
    const LAS bf16_t* a0 = tile + (8 * (lane >> 4) + ((lane >> 2) & 3)) * stride + 4 * (lane & 3);
    const s16x4 lo = __builtin_amdgcn_ds_read_tr16_b64_v4i16((LAS s16x4*)a0), hi = __builtin_amdgcn_ds_read_tr16_b64_v4i16((LAS s16x4*)(a0 + 4 * stride));
    return (bf16x8){lo[0], lo[1], lo[2], lo[3], hi[0], hi[1], hi[2], hi[3]};
}
#define MFMA16(a, b, c) __builtin_amdgcn_mfma_f32_16x16x32_bf16((a), (b), (c), 0, 0, 0)

namespace pg8 {
constexpr int BM = 256, BK = 64, HALF = 128, HTB = HALF * BK * 2, STAGE_BYTES = 8 * HTB, NXCD = 8, WGM = 8;
__device__ __forceinline__ int lds_byte(int r, int c) { const int st = (r >> 4) * 2 + (c >> 5), rr = r & 15, cc = c & 31, ob = rr * 64 + cc * 2; return st * 1024 + (ob ^ (((ob >> 9) & 1) << 5)); }
__device__ __forceinline__ void stage_rc(int b, int& R, int& C) { const int st = b / 1024, sb = b % 1024, swz = sb ^ (((sb >> 9) & 1) << 5); R = (st >> 1) * 16 + swz / 64; C = (st & 1) * 32 + (swz % 64) / 2; }
__device__ __forceinline__ int perm32(int rho) { const int n = rho >> 4, i = rho & 15; return 8 * (i >> 2) + 4 * n + (i & 3); }
struct Unit { int pm, pn; };
struct Gemm { const bf16_t* A; const bf16_t* Bt; int lda, ldb, K; };
struct StaticOrder {
    int nM, nN, nwg, G, c, skip;
    __device__ void init(int nM_, int nN_, int G_, int c_, int skip_ = 1 << 30) { nM = nM_; nN = nN_; nwg = nM * nN; G = G_; c = c_; skip = skip_; }
    __device__ bool next(int i, Unit& u) const {
        const long L = (long)i * G + c; if (L >= nwg) return false;
        int wgid = (int)L; { const int q = nwg / NXCD, r = nwg % NXCD, xcd = wgid % NXCD, off = wgid / NXCD; wgid = (xcd < r ? xcd * (q + 1) : r * (q + 1) + (xcd - r) * q) + off; }
        const int nig = WGM * nN, gid = wgid / nig, fm = gid * WGM, gsz = (nM - fm) < WGM ? (nM - fm) : WGM;
        u.pm = fm + ((wgid % nig) % gsz); u.pn = (wgid % nig) / gsz; if (u.pm >= skip) ++u.pm; return true;
    }
};

template <class Epi>
__device__ __forceinline__ void gemm_phase(const Ctx& cx, LAS unsigned char* lds, const Gemm g, const StaticOrder& S, const Epi& E) {
    const int tid = cx.tid, wid = __builtin_amdgcn_readfirstlane(tid >> 6), lane = tid & 63, wr = wid >> 2, wc = wid & 3, fr = lane & 15, fq = lane >> 4;
    const int K = g.K, nt = K / BK;
    unsigned voffA[2], voffB[2];
#pragma unroll
    for (int i = 0; i < 2; ++i) { int R, C; stage_rc(tid * 16 + i * 8192, R, C); const int Rb = (R & ~31) + perm32(R & 31);
        voffA[i] = (unsigned)(R * g.lda + C) * 2u; voffB[i] = (unsigned)(Rb * g.ldb + C) * 2u; }
    const size_t kstep = (size_t)(BK * 2);
    const size_t hstepA = (size_t)HALF * g.lda * 2, hstepB = (size_t)HALF * g.ldb * 2;
    const size_t tstepA = 2 * hstepA, tstepB = 2 * hstepB;
    const unsigned ldsw = (unsigned)wid * 1024u;
    const int aoff = lds_byte(wr * 64 + fr, fq * 8), boff = lds_byte(wc * 32 + fr, fq * 8);
#define PG8_SA(b, h) (((b) * 2 + (h)) * HTB)
#define PG8_SB(b, h) ((4 + (b) * 2 + (h)) * HTB)
#define PG8_STAGE(bufoff, gbase, voff) do { _Pragma("unroll") for (int _i = 0; _i < 2; ++_i) \
        __builtin_amdgcn_global_load_lds((const unsigned*)((const char*)(gbase) + (voff)[_i]), (LAS unsigned*)(lds + (bufoff) + ldsw + _i * 8192), 16, 0, 0); } while (0)
#define PG8_LDA(dst, b, h) do { _Pragma("unroll") for (int m = 0; m < 4; ++m) _Pragma("unroll") for (int k = 0; k < 2; ++k) dst[m][k] = *(const LAS bf16x8*)(lds + PG8_SA(b, h) + aoff + m * 2048 + k * 1024); } while (0)
#define PG8_LDB(dst, b, h) do { _Pragma("unroll") for (int n = 0; n < 2; ++n) _Pragma("unroll") for (int k = 0; k < 2; ++k) dst[n][k] = *(const LAS bf16x8*)(lds + PG8_SB(b, h) + boff + n * 2048 + k * 1024); } while (0)
#define PG8_MMA(ai, bj, At, Bt) do { __builtin_amdgcn_s_setprio(1); _Pragma("unroll") for (int m = 0; m < 4; ++m) _Pragma("unroll") for (int n = 0; n < 2; ++n) _Pragma("unroll") for (int k = 0; k < 2; ++k) \
        acc[ai][bj][m][n] = __builtin_amdgcn_mfma_f32_16x16x32_bf16(Bt[n][k], At[m][k], acc[ai][bj][m][n], 0, 0, 0); __builtin_amdgcn_s_setprio(0); } while (0)
#define PG8_WAIT_V(n) asm volatile("s_waitcnt vmcnt(" #n ")" ::: "memory")
#define PG8_WAIT_L(n) asm volatile("s_waitcnt lgkmcnt(" #n ")" ::: "memory")
#define PG8_BAR __builtin_amdgcn_s_barrier()
#define PG8_SCHED __builtin_amdgcn_sched_barrier(0)
    Unit cur, nxt; int ui = 0;
    if (!S.next(0, cur)) return;
    f32x4 acc[2][2][4][2];
#pragma unroll
    for (int a = 0; a < 2; ++a)
#pragma unroll
        for (int b = 0; b < 2; ++b)
#pragma unroll
            for (int m = 0; m < 4; ++m)
#pragma unroll
                for (int n = 0; n < 2; ++n) acc[a][b][m][n] = (f32x4){0.f, 0.f, 0.f, 0.f};
    bf16x8 At[4][2], B0[2][2], B1[2][2];
    const char* cA = (const char*)g.A + (size_t)cur.pm * tstepA; const char* cB = (const char*)g.Bt + (size_t)cur.pn * tstepB;
    if constexpr (Epi::RESCALE) E.prep((LAS float*)(lds + STAGE_BYTES), cur, tid);
    PG8_STAGE(PG8_SB(0, 0), cB, voffB); PG8_STAGE(PG8_SA(0, 0), cA, voffA); PG8_STAGE(PG8_SB(0, 1), cB + hstepB, voffB); PG8_STAGE(PG8_SA(0, 1), cA + hstepA, voffA);
    if (wr == 1) PG8_BAR;
    PG8_WAIT_V(4); PG8_BAR;
    PG8_STAGE(PG8_SB(1, 0), cB + kstep, voffB); PG8_STAGE(PG8_SA(1, 0), cA + kstep, voffA); PG8_STAGE(PG8_SB(1, 1), cB + hstepB + kstep, voffB);
    PG8_WAIT_V(6); PG8_BAR;
    for (;;) {
        const bool has_next = S.next(ui + 1, nxt);
        if constexpr (Epi::RESCALE) { if (has_next) E.prep((LAS float*)(lds + STAGE_BYTES) + ((ui + 1) & 1) * 1024, nxt, tid); }
        const char* nA = has_next ? (const char*)g.A + (size_t)nxt.pm * tstepA : cA; const char* nB = has_next ? (const char*)g.Bt + (size_t)nxt.pn * tstepB : cB;
        for (int t = 0; t < nt; t += 2) {
            const bool last = (t == nt - 2);
            const char* a1 = cA + (size_t)(t + 1) * kstep;
            const char* a2 = last ? nA : cA + (size_t)(t + 2) * kstep; const char* b2 = last ? nB : cB + (size_t)(t + 2) * kstep;
            const char* a3 = a2 + kstep; const char* b3 = b2 + kstep;
            PG8_LDB(B0, 0, 0); PG8_SCHED; PG8_LDA(At, 0, 0); PG8_STAGE(PG8_SA(1, 1), a1 + hstepA, voffA);
            PG8_WAIT_L(8); PG8_BAR; PG8_WAIT_L(0); PG8_MMA(0, 0, At, B0); PG8_BAR; PG8_SCHED;
            PG8_LDB(B1, 0, 1); PG8_STAGE(PG8_SB(0, 0), b2, voffB);
            PG8_BAR; PG8_WAIT_L(0); PG8_MMA(0, 1, At, B1); PG8_BAR;
            PG8_LDA(At, 0, 1); PG8_STAGE(PG8_SA(0, 0), a2, voffA);
            PG8_BAR; PG8_WAIT_L(0); PG8_MMA(1, 0, At, B0); PG8_BAR; PG8_SCHED;
            PG8_STAGE(PG8_SB(0, 1), b2 + hstepB, voffB);
            PG8_WAIT_V(6); PG8_BAR; PG8_MMA(1, 1, At, B1); PG8_BAR;
            PG8_LDB(B0, 1, 0); PG8_SCHED; PG8_LDA(At, 1, 0); PG8_STAGE(PG8_SA(0, 1), a2 + hstepA, voffA);
            PG8_WAIT_L(8); PG8_BAR; PG8_WAIT_L(0); PG8_MMA(0, 0, At, B0); PG8_BAR; PG8_SCHED;
            PG8_LDB(B1, 1, 1); PG8_STAGE(PG8_SB(1, 0), b3, voffB);
            PG8_BAR; PG8_WAIT_L(0); PG8_MMA(0, 1, At, B1); PG8_BAR;
            PG8_LDA(At, 1, 1); PG8_STAGE(PG8_SA(1, 0), a3, voffA);
            PG8_BAR; PG8_WAIT_L(0); PG8_MMA(1, 0, At, B0); PG8_BAR; PG8_SCHED;
            PG8_STAGE(PG8_SB(1, 1), b3 + hstepB, voffB);
            PG8_WAIT_V(6); PG8_BAR; PG8_MMA(1, 1, At, B1); PG8_BAR;
            if constexpr (Epi::RESCALE) { if (((t + 2) & 7) == 0 && t + 2 < nt) E.mid(acc, (const LAS float*)(lds + STAGE_BYTES) + (ui & 1) * 1024, ((t + 2) >> 3) - 1, wr, fr); }
        }
        if constexpr (Epi::RESCALE) E.fin(acc, (const LAS float*)(lds + STAGE_BYTES) + (ui & 1) * 1024, cur, wr, wc, fr, fq); else E(acc, cur, wr, wc, fr, fq);
        if (!has_next) break;
#pragma unroll
        for (int a = 0; a < 2; ++a)
#pragma unroll
            for (int b = 0; b < 2; ++b)
#pragma unroll
                for (int m = 0; m < 4; ++m)
#pragma unroll
                    for (int n = 0; n < 2; ++n) acc[a][b][m][n] = (f32x4){0.f, 0.f, 0.f, 0.f};
        cur = nxt; cA = nA; cB = nB; ++ui;
    }
    PG8_WAIT_V(0);
    if (wr == 0) PG8_BAR;
    PG8_BAR;
#undef PG8_SA
#undef PG8_SB
#undef PG8_STAGE
#undef PG8_LDA
#undef PG8_LDB
#undef PG8_MMA
#undef PG8_WAIT_V
#undef PG8_WAIT_L
#undef PG8_BAR
#undef PG8_SCHED
}
}
using pg8::Unit;

__device__ __forceinline__ u32x4 pack8(const float (&v)[8]) { return (u32x4){pk_bf16(v[0], v[1]), pk_bf16(v[2], v[3]), pk_bf16(v[4], v[5]), pk_bf16(v[6], v[7])}; }
__device__ __forceinline__ void unpack8(const u32x4 u, float (&v)[8]) {
#pragma unroll
    for (int q = 0; q < 4; ++q) { v[2 * q] = bf_lo(u[q]); v[2 * q + 1] = bf_hi(u[q]); }
}

struct EpiIn {
    static constexpr bool RESCALE = false;
    bf16_t* Z; const float* r1; float* ssv; const float* b_gate; int rowbase;
    __device__ __forceinline__ void operator()(const f32x4 (&acc)[2][2][4][2], const Unit& u, int wr, int wc, int fr, int fq) const {
        const int pn = u.pn, lane = fr + 16 * fq;
        const int kind = pn < 4 ? 0 : pn < 8 ? 1 : pn < 12 ? 2 : pn < 16 ? 3 : pn < 24 ? 4 : pn < 32 ? 5 : 6;
        const int row0 = u.pm * 256 + wr * 64 + fr, col0 = pn * 256 + wc * 32 + 8 * fq;
        if (kind == 2 || kind == 3) {
            const float ksc = kind == 3 ? 0.0625f : 1.f;
            float inv8[8];
#pragma unroll
            for (int e = 0; e < 8; ++e) inv8[e] = fexp2(-(float)(wc * 32 + 8 * fq + e) * (13.287712379549449f / 127.f)) * 0.15915494309189535f;
#pragma unroll
            for (int ai = 0; ai < 2; ++ai)
#pragma unroll
                for (int m = 0; m < 4; ++m) {
                    const int row = row0 + ai * 128 + m * 16, gr = rowbase + row;
                    const float pos = (float)(gr < 16384 ? (gr & 2047) : (gr < 16640 ? 1024 + ((gr - 16384) & 15) : ((gr - 16640) & 2047)));
                    float v0[8], v1[8], o0[8], o1[8];
#pragma unroll
                    for (int e = 0; e < 4; ++e) { v0[e] = acc[ai][0][m][0][e]; v0[4 + e] = acc[ai][0][m][1][e]; v1[e] = acc[ai][1][m][0][e]; v1[4 + e] = acc[ai][1][m][1][e]; }
#pragma unroll
                    for (int e = 0; e < 8; e += 2) {
                        const float t0 = __builtin_amdgcn_fractf(pos * inv8[e]), t1 = __builtin_amdgcn_fractf(pos * inv8[e + 1]);
                        const f32x2 sn = (f32x2){__builtin_amdgcn_sinf(t0), __builtin_amdgcn_sinf(t1)}, cs = (f32x2){__builtin_amdgcn_cosf(t0), __builtin_amdgcn_cosf(t1)};
                        const f32x2 a = (f32x2){v0[e], v0[e + 1]} * ksc, b = (f32x2){v1[e], v1[e + 1]} * ksc;
                        const f32x2 r0 = a * cs - b * sn, r1 = a * sn + b * cs;
                        o0[e] = r0[0]; o0[e + 1] = r0[1]; o1[e] = r1[0]; o1[e + 1] = r1[1];
                    }
                    *(u32x4*)(Z + (size_t)row * INC + col0) = pack8(o0); *(u32x4*)(Z + (size_t)row * INC + col0 + 128) = pack8(o1);
                }
            return;
        }
#pragma unroll
        for (int ai = 0; ai < 2; ++ai)
#pragma unroll
            for (int m = 0; m < 4; ++m) {
                const int row = row0 + ai * 128 + m * 16; float ss = 0.f;
#pragma unroll
                for (int bj = 0; bj < 2; ++bj) {
                    const int col = col0 + bj * 128; float v[8];
#pragma unroll
                    for (int e = 0; e < 4; ++e) { v[e] = acc[ai][bj][m][0][e]; v[4 + e] = acc[ai][bj][m][1][e]; }
                    if (kind == 0 || kind == 1) {
#pragma unroll
                        for (int e = 0; e < 4; ++e) { const f32x2 gq = gelu_t2((f32x2){v[2 * e], v[2 * e + 1]}); v[2 * e] = gq[0]; v[2 * e + 1] = gq[1]; }
                        if (kind == 1) {
#pragma unroll
                            for (int e = 0; e < 8; ++e) ss += v[e] * v[e];
                        }
                    } else if (kind == 3) {
#pragma unroll
                        for (int e = 0; e < 8; ++e) v[e] *= 0.0625f;
                    } else if (kind == 5) {
#pragma unroll
                        for (int e = 0; e < 4; ++e) { const f32x2 xx = (f32x2){v[2 * e], v[2 * e + 1]}, q2 = xx * sigm2(xx); v[2 * e] = q2[0]; v[2 * e + 1] = q2[1]; }
                    } else if (kind == 6) {
                        const f32x4 b0 = *(const f32x4*)(b_gate + col - 8192), b1 = *(const f32x4*)(b_gate + col - 8192 + 4);
                        const float bb[8] = {b0[0], b0[1], b0[2], b0[3], b1[0], b1[1], b1[2], b1[3]};
#pragma unroll
                        for (int e = 0; e < 4; ++e) { const f32x2 q2 = sigm2((f32x2){v[2 * e] + bb[2 * e], v[2 * e + 1] + bb[2 * e + 1]}); v[2 * e] = q2[0]; v[2 * e + 1] = q2[1]; }
                    }
                    *(u32x4*)(Z + (size_t)row * INC + col) = pack8(v);
                }
                if (kind == 1) { ss += shx(ss, 16, lane); ss += shx(ss, 32, lane); if (fq == 0) atomicAdd(ssv + rowbase + row, ss); }
            }
    }
};
struct EpiT1 {
    static constexpr bool RESCALE = false;
    bf16_t* T1; const bf16_t* Z;
    __device__ __forceinline__ void operator()(const f32x4 (&acc)[2][2][4][2], const Unit& u, int wr, int wc, int fr, int fq) const {
        const int row0 = u.pm * 256 + wr * 64 + fr, col0 = u.pn * 256 + wc * 32 + 8 * fq;
#pragma unroll
        for (int ai = 0; ai < 2; ++ai)
#pragma unroll
            for (int m = 0; m < 4; ++m) {
                const int row = row0 + ai * 128 + m * 16;
#pragma unroll
                for (int bj = 0; bj < 2; ++bj) {
                    const int col = col0 + bj * 128; float v[8], gt[8];
                    unpack8(*(const u32x4*)(Z + (size_t)row * INC + 8192 + col), gt);
#pragma unroll
                    for (int e = 0; e < 4; ++e) { v[e] = acc[ai][bj][m][0][e] * gt[e]; v[4 + e] = acc[ai][bj][m][1][e] * gt[4 + e]; }
                    *(u32x4*)(T1 + (size_t)row * 1024 + col) = pack8(v);
                }
            }
    }
};
struct EpiM1 {
    static constexpr bool RESCALE = true;
    const bf16_t* T1; const bf16_t* Z; bf16_t* M1; int rowbase; const float* sso;
    __device__ __forceinline__ void prep(LAS float* tab, const Unit& u, int tid) const {
        if (tid < 256) {
            const f32x4 sv = *(const f32x4*)(sso + (size_t)(rowbase + u.pm * 256 + tid) * 4);
            const float c0 = sv[0] * (1.f / 512.f) + EPS, c1 = sv[1] * (1.f / 512.f) + EPS, c2 = sv[2] * (1.f / 512.f) + EPS, c3 = sv[3] * (1.f / 512.f) + EPS;
            *(LAS f32x4*)(tab + tid * 4) = (f32x4){__builtin_sqrtf(c1 * frcp(c0)), __builtin_sqrtf(c2 * frcp(c1)), __builtin_sqrtf(c3 * frcp(c2)), rsq(c3)};
        }
    }
    __device__ __forceinline__ void mid(f32x4 (&acc)[2][2][4][2], const LAS float* tab, int seg, int wr, int fr) const {
#pragma unroll
        for (int ai = 0; ai < 2; ++ai)
#pragma unroll
            for (int m = 0; m < 4; ++m) {
                const float f = tab[(ai * 128 + wr * 64 + m * 16 + fr) * 4 + seg];
#pragma unroll
                for (int bj = 0; bj < 2; ++bj)
#pragma unroll
                    for (int n = 0; n < 2; ++n) acc[ai][bj][m][n] = acc[ai][bj][m][n] * f;
            }
    }
    __device__ __forceinline__ void operator()(const f32x4 (&acc)[2][2][4][2], const Unit& u, int wr, int wc, int fr, int fq) const {}
    __device__ __forceinline__ void fin(const f32x4 (&acc)[2][2][4][2], const LAS float* tab, const Unit& u, int wr, int wc, int fr, int fq) const {
        const int row0 = u.pm * 256 + wr * 64 + fr, col0 = u.pn * 256 + wc * 32 + 8 * fq;
#pragma unroll
        for (int ai = 0; ai < 2; ++ai)
#pragma unroll
            for (int m = 0; m < 4; ++m) {
                const int row = row0 + ai * 128 + m * 16; const float rn3 = tab[(ai * 128 + wr * 64 + m * 16 + fr) * 4 + 3];
#pragma unroll
                for (int bj = 0; bj < 2; ++bj) {
                    const int col = col0 + bj * 128; float v[8], gt[8], t1[8];
                    unpack8(*(const u32x4*)(Z + (size_t)row * INC + 9216 + col), gt);
                    unpack8(*(const u32x4*)(T1 + (size_t)row * 1024 + col), t1);
#pragma unroll
                    for (int e = 0; e < 4; ++e) { v[e] = t1[e] + acc[ai][bj][m][0][e] * rn3 * gt[e]; v[4 + e] = t1[4 + e] + acc[ai][bj][m][1][e] * rn3 * gt[4 + e]; }
                    *(u32x4*)(M1 + (size_t)(rowbase + row) * 1024 + col) = pack8(v);
                }
            }
    }
};
struct EpiX2 {
    static constexpr bool RESCALE = false;
    const float* xp; const float* xs; float* out; bf16_t* X2b; float* ss2;
    __device__ __forceinline__ void operator()(const f32x4 (&acc)[2][2][4][2], const Unit& u, int wr, int wc, int fr, int fq) const {
        const int row0 = u.pm * 256 + wr * 64 + fr, col0 = u.pn * 256 + wc * 32 + 8 * fq, lane = fr + 16 * fq;
#pragma unroll
        for (int ai = 0; ai < 2; ++ai)
#pragma unroll
            for (int m = 0; m < 4; ++m) {
                const int row = row0 + ai * 128 + m * 16;
                const float* xr = row < 16384 ? xp + (size_t)row * 1024 : (row < 16640 ? xs + (size_t)(row - 16384) * 1024 : xp + (size_t)(row - 256) * 1024);
                float* yr = row < 16384 ? out + O_YP + (size_t)row * 1024 : (row < 16640 ? out + O_YS + (size_t)(row - 16384) * 1024 : out + O_YP + (size_t)(row - 256) * 1024);
                float ss = 0.f;
#pragma unroll
                for (int bj = 0; bj < 2; ++bj) {
                    const int col = col0 + bj * 128; float v[8];
                    const f32x4 x0 = *(const f32x4*)(xr + col), x1 = *(const f32x4*)(xr + col + 4);
#pragma unroll
                    for (int e = 0; e < 4; ++e) { v[e] = acc[ai][bj][m][0][e] + x0[e]; v[4 + e] = acc[ai][bj][m][1][e] + x1[e]; }
#pragma unroll
                    for (int e = 0; e < 8; ++e) ss += v[e] * v[e];
                    *(f32x4*)(yr + col) = (f32x4){v[0], v[1], v[2], v[3]}; *(f32x4*)(yr + col + 4) = (f32x4){v[4], v[5], v[6], v[7]};
                    *(u32x4*)(X2b + (size_t)row * 1024 + col) = pack8(v);
                }
                ss += shx(ss, 16, lane); ss += shx(ss, 32, lane); if (fq == 0) atomicAdd(ss2 + row, ss);
            }
    }
};
struct EpiQP {
    static constexpr bool RESCALE = false;
    bf16_t* QP; const float* ss2;
    __device__ __forceinline__ void operator()(const f32x4 (&acc)[2][2][4][2], const Unit& u, int wr, int wc, int fr, int fq) const {
        const int row0 = u.pm * 256 + wr * 64 + fr, col0 = u.pn * 256 + wc * 32 + 8 * fq;
#pragma unroll
        for (int ai = 0; ai < 2; ++ai)
#pragma unroll
            for (int m = 0; m < 4; ++m) {
                const int row = row0 + ai * 128 + m * 16; const float rs = rsq(ss2[row] * (1.f / 1024.f) + EPS);
#pragma unroll
                for (int bj = 0; bj < 2; ++bj) {
                    const int col = col0 + bj * 128; float v[8];
#pragma unroll
                    for (int e = 0; e < 4; ++e) { v[e] = acc[ai][bj][m][0][e] * rs; v[4 + e] = acc[ai][bj][m][1][e] * rs; }
                    *(u32x4*)(QP + (size_t)row * 2048 + col) = pack8(v);
                }
            }
    }
};

__device__ __forceinline__ void convert_item(const Params& p, unsigned char* ws, size_t i) {
        const int d = (int)((i * 16) & 1023);
        unsigned ou[4], ov[4];
#pragma unroll
        for (int q = 0; q < 4; ++q) {
            const f32x4 a = *(const f32x4*)(p.eu + i * 16 + q * 4), g0 = *(const f32x4*)(p.g_ffn + d + q * 4), c = *(const f32x4*)(p.ev + i * 16 + q * 4);
            int u = __builtin_amdgcn_cvt_pk_fp8_f32(a[0] * g0[0] * EU_SCALE, a[1] * g0[1] * EU_SCALE, 0, false);
            u = __builtin_amdgcn_cvt_pk_fp8_f32(a[2] * g0[2] * EU_SCALE, a[3] * g0[3] * EU_SCALE, u, true);
            int v = __builtin_amdgcn_cvt_pk_fp8_f32(c[0] * EV_SCALE, c[1] * EV_SCALE, 0, false);
            v = __builtin_amdgcn_cvt_pk_fp8_f32(c[2] * EV_SCALE, c[3] * EV_SCALE, v, true);
            ou[q] = (unsigned)u; ov[q] = (unsigned)v;
        }
        *(u32x4*)(ws + OFF_EU + (i >> 6) * 2048 + (i & 63) * 16) = (u32x4){ou[0], ou[1], ou[2], ou[3]};
        *(u32x4*)(ws + OFF_EU + (i >> 6) * 2048 + 1024 + (i & 63) * 16) = (u32x4){ov[0], ov[1], ov[2], ov[3]};
    }
constexpr size_t CONV_ITEMS = (size_t)16384 * 64;

__device__ __forceinline__ void transpose_tile(const Ctx& cx, const float* src, bf16_t* dst, const float* scale, int K, int N, int tile, LAS float* tl) {
    const int tn = N / 64, k0 = (tile / tn) * 64, n0 = (tile % tn) * 64, tid = cx.tid;
    const int n4 = (tid & 15) * 4, kr = tid >> 4;
#pragma unroll
    for (int i = 0; i < 2; ++i) {
        const int kk = kr + 32 * i; f32x4 v = *(const f32x4*)(src + (size_t)(k0 + kk) * N + n0 + n4);
        if (scale) v = v * scale[k0 + kk];
        tl[kk * 65 + n4] = v[0]; tl[kk * 65 + n4 + 1] = v[1]; tl[kk * 65 + n4 + 2] = v[2]; tl[kk * 65 + n4 + 3] = v[3];
    }
    __syncthreads();
    const int n = tid >> 3, kc = (tid & 7) * 8; float o[8];
#pragma unroll
    for (int e = 0; e < 8; ++e) o[e] = tl[(kc + e) * 65 + n];
    *(u32x4*)(dst + (size_t)(n0 + n) * K + k0 + kc) = pack8(o);
    __syncthreads();
}
__device__ __forceinline__ void phase0(const Ctx& cx, const Params& p, LAS unsigned char* lds) {
    unsigned char* ws = p.ws; LAS float* tl = (LAS float*)lds;
    for (int j = cx.bid; j < 4096; j += cx.nb) {
        if (j < 2560) transpose_tile(cx, p.w_in, (bf16_t*)(ws + OFF_WIN), p.g_mix, 1024, 10240, j, tl);
        else if (j < 2816) transpose_tile(cx, p.w_pa, (bf16_t*)(ws + OFF_WA), nullptr, 1024, 1024, j - 2560, tl);
        else if (j < 3328) transpose_tile(cx, p.w_pb, (bf16_t*)(ws + OFF_WB), nullptr, 2048, 1024, j - 2816, tl);
        else if (j < 3584) transpose_tile(cx, p.w_out, (bf16_t*)(ws + OFF_WO), nullptr, 1024, 1024, j - 3328, tl);
        else transpose_tile(cx, p.w_q, (bf16_t*)(ws + OFF_WQ), p.g_ffn, 1024, 2048, j - 3584, tl);
    }
    const size_t gtid = (size_t)cx.bid * 512 + cx.tid, nth = (size_t)cx.nb * 512;
    for (size_t i = gtid; i < 16384; i += nth) { ((bf16_t*)(ws + OFF_K1))[i] = f2bf(p.k1[i]); ((bf16_t*)(ws + OFF_K2))[i] = f2bf(p.k2[i]); }
    for (size_t i = gtid; i < (size_t)NTOK * 6; i += nth) ((float*)(ws + OFF_SSV))[i] = 0.f;
    const int wid = __builtin_amdgcn_readfirstlane(cx.tid >> 6), lane = cx.tid & 63;
    bf16_t* xb = (bf16_t*)((unsigned char*)p.out + OUT_XB);
    for (int r = cx.bid * 8 + wid; r < NTOK; r += cx.nb * 8) {
        const float* xr = xrow(p, r); f32x4 v[4]; float ss = 0.f;
#pragma unroll
        for (int j = 0; j < 4; ++j) { v[j] = *(const f32x4*)(xr + lane * 8 + (j >> 1) * 512 + (j & 1) * 4); ss += v[j][0] * v[j][0] + v[j][1] * v[j][1] + v[j][2] * v[j][2] + v[j][3] * v[j][3]; }
        ss = wave_sum(ss, lane);
        const float rs = rsq(ss * (1.f / 1024.f) + EPS);
#pragma unroll
        for (int j = 0; j < 2; ++j)
            *(u32x4*)(xb + (size_t)r * 1024 + lane * 8 + j * 512) = (u32x4){pk_bf16(v[2 * j][0] * rs, v[2 * j][1] * rs), pk_bf16(v[2 * j][2] * rs, v[2 * j][3] * rs),
                                                                          pk_bf16(v[2 * j + 1][0] * rs, v[2 * j + 1][1] * rs), pk_bf16(v[2 * j + 1][2] * rs, v[2 * j + 1][3] * rs)};
    }
}

__device__ __forceinline__ void retention_unit(const Ctx& cx, LAS unsigned char* lds, bf16_t* Z, int zrow0, int grow0, int nchunks, int Lc, int pos0, int h, int slice,
                               const float* s0, float* s_out, float* sso) {
    LAS bf16_t* Qs = (LAS bf16_t*)lds; LAS bf16_t* Ks = (LAS bf16_t*)(lds + 33792); LAS bf16_t* ST = (LAS bf16_t*)(lds + 67584);
    LAS bf16_t* VT = (LAS bf16_t*)(lds + 101376); LAS bf16_t* Ps = (LAS bf16_t*)(lds + 110592);
    const int tid = cx.tid, wid = __builtin_amdgcn_readfirstlane(tid >> 6), lane = tid & 63, fr = lane & 15, fq = lane >> 4;
    const float l2g = log2f(1.f - exp2f(-5.f - (float)h));
    f32x4 accS[2][4];
#pragma unroll
    for (int dt = 0; dt < 2; ++dt)
#pragma unroll
        for (int dvt = 0; dvt < 4; ++dvt) {
#pragma unroll
            for (int j = 0; j < 4; ++j) { const int d = (2 * wid + dt) * 16 + fq * 4 + j; accS[dt][dvt][j] = s0 ? s0[(size_t)d * 512 + slice * 64 + dvt * 16 + fr] : 0.f; }
            *(LAS u32x2*)(ST + (dvt * 16 + fr) * 264 + (2 * wid + dt) * 16 + fq * 4) = (u32x2){pk_bf16(accS[dt][dvt][0], accS[dt][dvt][1]), pk_bf16(accS[dt][dvt][2], accS[dt][dvt][3])};
        }
    const float sdec = fexp2(l2g * (float)Lc);
    __syncthreads();
    u32x4 rq1[2], rq2[2], rk1[2], rk2[2], rv; u32x2 rsg[2];
    const int vm = tid >> 3, vc0 = (tid & 7) * 8;
    auto fetch = [&](int c) {
        const size_t zr = (size_t)(zrow0 + c * 64);
#pragma unroll
        for (int it = 0; it < 2; ++it) {
            const int item = tid + 512 * it, n = item >> 4, dc = (item & 15) * 8;
            rq1[it] = (u32x4){0, 0, 0, 0}; rq2[it] = rq1[it]; rk1[it] = rq1[it]; rk2[it] = rq1[it];
            if (n < Lc) {
                const bf16_t* zp = Z + (zr + n) * INC + 2048 + h * 256 + dc;
                rq1[it] = *(const u32x4*)zp; rq2[it] = *(const u32x4*)(zp + 128); rk1[it] = *(const u32x4*)(zp + 1024); rk2[it] = *(const u32x4*)(zp + 1152);
            }
        }
        rv = (u32x4){0, 0, 0, 0};
        if (vm < Lc) rv = *(const u32x4*)(Z + (zr + vm) * INC + 4096 + h * 512 + slice * 64 + vc0);
#pragma unroll
        for (int i = 0; i < 2; ++i) {
            rsg[i] = (u32x2){0, 0};
            const int n = (wid >> 1) * 16 + fr;
            if (n < Lc) rsg[i] = *(const u32x2*)(Z + (zr + n) * INC + 6144 + h * 512 + slice * 64 + (2 * (wid & 1) + i) * 16 + fq * 4);
        }
    };
    fetch(0);
    for (int c = 0; c < nchunks; ++c) {
        const size_t zr = (size_t)(zrow0 + c * 64);
#pragma unroll
        for (int it = 0; it < 2; ++it) {
            const int item = tid + 512 * it, n = item >> 4, dc = (item & 15) * 8;
            *(LAS u32x4*)(Qs + n * 264 + dc) = rq1[it]; *(LAS u32x4*)(Qs + n * 264 + 128 + dc) = rq2[it];
            *(LAS u32x4*)(Ks + n * 264 + dc) = rk1[it]; *(LAS u32x4*)(Ks + n * 264 + 128 + dc) = rk2[it];
        }
        {
            float v[8]; unpack8(rv, v);
            const float kd = fexp2(l2g * (float)(Lc - 1 - vm));
#pragma unroll
            for (int e = 0; e < 8; ++e) v[e] *= kd;
            *(LAS u32x4*)(VT + vm * 72 + vc0) = pack8(v);
        }
        __syncthreads();
        u32x2 sgc[2] = {rsg[0], rsg[1]};
        if (c + 1 < nchunks) fetch(c + 1);
        const int nt = wid >> 1;
#pragma unroll
        for (int mi = 0; mi < 2; ++mi) {
            const int mt = 2 * (wid & 1) + mi; f32x4 acc = (f32x4){0.f, 0.f, 0.f, 0.f};
            if (mt <= nt) {
#pragma unroll
                for (int ks = 0; ks < 8; ++ks) {
                    const bf16x8 a = *(const LAS bf16x8*)(Qs + (nt * 16 + fr) * 264 + ks * 32 + fq * 8), b = *(const LAS bf16x8*)(Ks + (mt * 16 + fr) * 264 + ks * 32 + fq * 8);
                    acc = MFMA16(a, b, acc);
                }
            }
#pragma unroll
            for (int j = 0; j < 4; ++j) {
                const int n = nt * 16 + fq * 4 + j, m = mt * 16 + fr;
                const float val = (m <= n) ? acc[j] * fexp2(l2g * (float)(n - (Lc - 1))) : 0.f;
                Ps[n * 72 + m] = f2bf(val);
            }
        }
        f32x4 accO[2];
#pragma unroll
        for (int i = 0; i < 2; ++i) {
            const int dvt = 2 * (wid & 1) + i; accO[i] = (f32x4){0.f, 0.f, 0.f, 0.f};
#pragma unroll
            for (int ks = 0; ks < 8; ++ks) {
                const bf16x8 a = *(const LAS bf16x8*)(ST + (dvt * 16 + fr) * 264 + ks * 32 + fq * 8), b = *(const LAS bf16x8*)(Qs + (nt * 16 + fr) * 264 + ks * 32 + fq * 8);
                accO[i] = MFMA16(a, b, accO[i]);
            }
            const float qd = fexp2(l2g * (float)(nt * 16 + fr + 1));
            accO[i] = accO[i] * qd;
        }
        __syncthreads();
#pragma unroll
        for (int i = 0; i < 2; ++i) {
            const int dvt = 2 * (wid & 1) + i;
#pragma unroll
            for (int ks = 0; ks < 2; ++ks) {
                const bf16x8 a = tr_frag(VT + ks * 32 * 72 + dvt * 16, 72, lane), b = *(const LAS bf16x8*)(Ps + (nt * 16 + fr) * 72 + ks * 32 + fq * 8);
                accO[i] = MFMA16(a, b, accO[i]);
            }
        }
#pragma unroll
        for (int dt = 0; dt < 2; ++dt)
#pragma unroll
            for (int dvt = 0; dvt < 4; ++dvt) accS[dt][dvt] = accS[dt][dvt] * sdec;
#pragma unroll
        for (int ks = 0; ks < 2; ++ks) {
            bf16x8 bv[4];
#pragma unroll
            for (int dvt = 0; dvt < 4; ++dvt) bv[dvt] = tr_frag(VT + ks * 32 * 72 + dvt * 16, 72, lane);
#pragma unroll
            for (int dt = 0; dt < 2; ++dt) {
                const bf16x8 a = tr_frag(Ks + ks * 32 * 264 + (2 * wid + dt) * 16, 264, lane);
#pragma unroll
                for (int dvt = 0; dvt < 4; ++dvt) accS[dt][dvt] = MFMA16(a, bv[dvt], accS[dt][dvt]);
            }
        }
#pragma unroll
        for (int dt = 0; dt < 2; ++dt)
#pragma unroll
            for (int dvt = 0; dvt < 4; ++dvt)
                *(LAS u32x2*)(ST + (dvt * 16 + fr) * 264 + (2 * wid + dt) * 16 + fq * 4) = (u32x2){pk_bf16(accS[dt][dvt][0], accS[dt][dvt][1]), pk_bf16(accS[dt][dvt][2], accS[dt][dvt][3])};
        {
            float ss = 0.f; const int n = nt * 16 + fr;
#pragma unroll
            for (int i = 0; i < 2; ++i) {
                const int dvt = 2 * (wid & 1) + i;
                ss += accO[i][0] * accO[i][0] + accO[i][1] * accO[i][1] + accO[i][2] * accO[i][2] + accO[i][3] * accO[i][3];
                if (n < Lc) *(u32x2*)(Z + (zr + n) * INC + 4096 + h * 512 + slice * 64 + dvt * 16 + fq * 4) =
                    (u32x2){pk_bf16(accO[i][0] * bf_lo(sgc[i][0]), accO[i][1] * bf_hi(sgc[i][0])), pk_bf16(accO[i][2] * bf_lo(sgc[i][1]), accO[i][3] * bf_hi(sgc[i][1]))};
            }
            ss += shx(ss, 16, lane); ss += shx(ss, 32, lane);
            if (fq == 0 && n < Lc) atomicAdd(sso + (size_t)(grow0 + c * 64 + n) * 4 + h, ss);
        }
        __syncthreads();
    }
#pragma unroll
    for (int dt = 0; dt < 2; ++dt)
#pragma unroll
        for (int dvt = 0; dvt < 4; ++dvt)
#pragma unroll
            for (int j = 0; j < 4; ++j) { const int d = (2 * wid + dt) * 16 + fq * 4 + j; s_out[(size_t)d * 512 + slice * 64 + dvt * 16 + fr] = accS[dt][dvt][j]; }
}

__device__ __forceinline__ void sgu_unit(const Ctx& cx, const Params& p, LAS unsigned char* lds, bf16_t* Z, int zrow0, int grow0, int rows, int g, float* vout, const float* ssv, bool load_w) {
    LAS bf16_t* WS = (LAS bf16_t*)lds; LAS bf16_t* VT = (LAS bf16_t*)(lds + 34816);
    const int tid = cx.tid, wid = __builtin_amdgcn_readfirstlane(tid >> 6), lane = tid & 63, fr = lane & 15, fq = lane >> 4;
    if (load_w)
#pragma unroll
    for (int it = 0; it < 4; ++it) {
        const int item = tid + 512 * it, n = item >> 4, m0 = (item & 15) * 8;
        const float* src = p.w_s + ((size_t)g * 128 + n) * 128 + m0;
        const f32x4 a = *(const f32x4*)src, b = *(const f32x4*)(src + 4); float v[8];
#pragma unroll
        for (int e = 0; e < 4; ++e) { v[e] = (m0 + e <= n) ? a[e] : 0.f; v[4 + e] = (m0 + 4 + e <= n) ? b[e] : 0.f; }
        *(LAS u32x4*)(WS + n * 136 + m0) = pack8(v);
    }
#pragma unroll
    for (int it = 0; it < 4; ++it) {
        const int item = tid + 512 * it, m = item >> 4, d0 = (item & 15) * 8; float v[8];
#pragma unroll
        for (int e = 0; e < 8; ++e) v[e] = 0.f;
        if (m < rows) {
            unpack8(*(const u32x4*)(Z + (size_t)(zrow0 + m) * INC + 1024 + g * 128 + d0), v);
            const float rs = rsq(ssv[grow0 + m] * (1.f / 1024.f) + EPS);
            const f32x4 g0 = *(const f32x4*)(p.g_sgu + g * 128 + d0), g1 = *(const f32x4*)(p.g_sgu + g * 128 + d0 + 4);
#pragma unroll
            for (int e = 0; e < 4; ++e) { v[e] *= rs * g0[e]; v[4 + e] *= rs * g1[e]; }
            if (vout) { *(f32x4*)(vout + (size_t)m * 1024 + g * 128 + d0) = (f32x4){v[0], v[1], v[2], v[3]}; *(f32x4*)(vout + (size_t)m * 1024 + g * 128 + d0 + 4) = (f32x4){v[4], v[5], v[6], v[7]}; }
        }
        *(LAS u32x4*)(VT + m * 136 + d0) = pack8(v);
    }
    u32x2 uu[8]; float bias = 0.f;
    if (wid * 16 < rows) {
        bias = p.b_s[g * 128 + wid * 16 + fr];
#pragma unroll
        for (int dt = 0; dt < 8; ++dt) uu[dt] = *(const u32x2*)(Z + (size_t)(zrow0 + wid * 16 + fr) * INC + g * 128 + dt * 16 + fq * 4);
    }
    __syncthreads();
    if (wid * 16 < rows) {
        const int nks = (wid >> 1) + 1;
        f32x4 acc[8];
#pragma unroll
        for (int dt = 0; dt < 8; ++dt) acc[dt] = (f32x4){0.f, 0.f, 0.f, 0.f};
        for (int ks = 0; ks < nks; ++ks) {
            const bf16x8 b = *(const LAS bf16x8*)(WS + (wid * 16 + fr) * 136 + ks * 32 + fq * 8);
#pragma unroll
            for (int dt = 0; dt < 8; ++dt) { const bf16x8 a = tr_frag(VT + ks * 32 * 136 + dt * 16, 136, lane); acc[dt] = MFMA16(a, b, acc[dt]); }
        }
        const int n = wid * 16 + fr;
#pragma unroll
        for (int dt = 0; dt < 8; ++dt) {
            bf16_t* up = Z + (size_t)(zrow0 + n) * INC + g * 128 + dt * 16 + fq * 4;
            *(u32x2*)up = (u32x2){pk_bf16(bf_lo(uu[dt][0]) * (acc[dt][0] + bias), bf_hi(uu[dt][0]) * (acc[dt][1] + bias)), pk_bf16(bf_lo(uu[dt][1]) * (acc[dt][2] + bias), bf_hi(uu[dt][1]) * (acc[dt][3] + bias))};
        }
    }
    __syncthreads();
}

__device__ __forceinline__ void phase2(const Ctx& cx, const Params& p, LAS unsigned char* lds, int hf) {
    unsigned char* ws = p.ws; bf16_t* Z = (bf16_t*)(ws + OFF_Z); float* sso = (float*)(ws + OFF_SSO); const float* ssv = (const float*)(ws + OFF_SSV);
    const int rowbase = hf ? NH0 : 0;
    for (int u = cx.bid; u < 256; u += cx.nb) {
        const int slice = u & 7, h = (u >> 3) & 3, bl = u >> 5, b = hf * 8 + bl;
        retention_unit(cx, lds, Z, bl * 2048, rowbase + bl * 2048, 32, 64, 0, h, slice, nullptr, p.out + O_SP + ((size_t)b * 4 + h) * 256 * 512, sso);
    }
    if (hf == 0) {
        for (int u = cx.bid; u < 512; u += cx.nb) {
            const int slice = u & 7, h = (u >> 3) & 3, b = u >> 5;
            retention_unit(cx, lds, Z, 16384 + b * 16, 16384 + b * 16, 1, 16, 1024, h, slice, p.state + ((size_t)b * 4 + h) * 256 * 512,
                           p.out + O_SS + ((size_t)b * 4 + h) * 256 * 512, sso);
        }
    }
    const int nprompt = 128 * 8, nsgu = nprompt + (hf == 0 ? 16 * 8 : 0);
    int last_g = -1;
    for (int u = cx.bid; u < nsgu; u += cx.nb) {
        if (u < nprompt) { const int g = u & 7, ci = u >> 3; sgu_unit(cx, p, lds, Z, ci * 128, rowbase + ci * 128, 128, g, nullptr, ssv, g != last_g); last_g = g; }
        else { const int v = u - nprompt, g = v & 7, b = v >> 3; sgu_unit(cx, p, lds, Z, 16384 + b * 16, 16384 + b * 16, 16, g, p.out + O_SV + (size_t)b * 16 * 1024, ssv, g != last_g); last_g = g; }
    }
}

#define CE_DESC(x, i, l) do { const float _a = fmaxf(x[i], x[l]), _b = fminf(x[i], x[l]); x[i] = _a; x[l] = _b; } while (0)
__device__ __forceinline__ void bitonic_sort16_desc(float (&x)[16]) {
#pragma unroll
    for (int k = 2; k <= 16; k <<= 1)
#pragma unroll
        for (int j = k >> 1; j > 0; j >>= 1)
#pragma unroll
            for (int i = 0; i < 16; ++i) {
                const int l = i ^ j;
                if (l > i) { if ((i & k) == 0 || k == 16) CE_DESC(x, i, l); else CE_DESC(x, l, i); }
            }
}
__device__ __forceinline__ void bitonic_merge16_desc(float (&x)[16]) {
#pragma unroll
    for (int j = 8; j > 0; j >>= 1)
#pragma unroll
        for (int i = 0; i < 16; ++i) { const int l = i ^ j; if (l > i) CE_DESC(x, i, l); }
}
#define TOPK_INS_FROM(L, x, S0) do { float _v = (x); _Pragma("unroll") for (int _i = (S0); _i < 16; ++_i) { const float _h = fmaxf(L[_i], _v); _v = fminf(L[_i], _v); L[_i] = _h; } } while (0)
__device__ __forceinline__ void phase7(const Ctx& cx, const Params& p, LAS unsigned char* lds) {
    unsigned char* ws = p.ws; const bf16_t* QP = (const bf16_t*)(ws + OFF_QP); int* ids = (int*)(ws + OFF_IDS); float* wts = (float*)(ws + OFF_WTS);
    LAS bf16_t* KEYS = (LAS bf16_t*)lds;
    LAS float* SC = (LAS float*)(lds + 69632);
    LAS float* TP = (LAS float*)(lds + 69632 + 67584);
    const int tid = cx.tid, wid = __builtin_amdgcn_readfirstlane(tid >> 6), lane = tid & 63, fr = lane & 15, fq = lane >> 4;
#pragma unroll
    for (int it = 0; it < 8; ++it) {
        const int idx = tid + 512 * it, tab = idx >> 11, row = (idx >> 4) & 127, c8 = (idx & 15) * 8;
        *(LAS u32x4*)(KEYS + tab * 17408 + row * 136 + c8) = *(const u32x4*)((const bf16_t*)(ws + (tab ? OFF_K2 : OFF_K1)) + row * 128 + c8);
    }
    bf16x8 a[2][4], an[2][4];
    auto load_a = [&](int tile, bf16x8 (&d)[2][4]) {
#pragma unroll
        for (int half = 0; half < 2; ++half)
#pragma unroll
            for (int ks = 0; ks < 4; ++ks) d[half][ks] = *(const bf16x8*)(QP + (size_t)(tile * 16 + fr) * 2048 + wid * 256 + half * 128 + ks * 32 + fq * 8);
    };
    if (cx.bid < NTOK / 16) load_a(cx.bid, an);
    __syncthreads();
    const size_t cv_end = CONV_ITEMS * (size_t)(cx.bid + 1) / (size_t)cx.nb; size_t cv_pos = CONV_ITEMS * (size_t)cx.bid / (size_t)cx.nb;
    for (int tile = cx.bid; tile < NTOK / 16; tile += cx.nb) {
        const int row0 = tile * 16;
#pragma unroll
        for (int half = 0; half < 2; ++half)
#pragma unroll
            for (int ks = 0; ks < 4; ++ks) a[half][ks] = an[half][ks];
        if (tile + cx.nb < NTOK / 16) load_a(tile + cx.nb, an);
#pragma unroll
        for (int half = 0; half < 2; ++half) {
#pragma unroll
            for (int nt = 0; nt < 8; ++nt) {
                f32x4 acc = (f32x4){0.f, 0.f, 0.f, 0.f};
#pragma unroll
                for (int ks = 0; ks < 4; ++ks) acc = MFMA16(a[half][ks], *(const LAS bf16x8*)(KEYS + half * 17408 + (nt * 16 + fr) * 136 + ks * 32 + fq * 8), acc);
#pragma unroll
                for (int j = 0; j < 4; ++j) {
                    const int t = fq * 4 + j, list = t * 8 + wid, n = nt * 16 + fr;
                    SC[list * 132 + ((n + 8 * fq) & 127)] = __uint_as_float((__float_as_uint(acc[j]) & ~127u) | (unsigned)n);
                }
            }
            __syncthreads();
            if (tid < 256) {
                const int list = tid >> 1, part = tid & 1; const LAS float* sp = SC + list * 132 + part * 64;
                float T[16];
#pragma unroll
                for (int i = 0; i < 4; ++i) { const f32x4 v = *(const LAS f32x4*)(sp + i * 4); T[4 * i] = v[0]; T[4 * i + 1] = v[1]; T[4 * i + 2] = v[2]; T[4 * i + 3] = v[3]; }
                bitonic_sort16_desc(T);
#pragma unroll 1
                for (int grp = 1; grp < 4; ++grp) {
                    float G[16];
#pragma unroll
                    for (int i = 0; i < 4; ++i) { const f32x4 v = *(const LAS f32x4*)(sp + grp * 16 + i * 4); G[4 * i] = v[0]; G[4 * i + 1] = v[1]; G[4 * i + 2] = v[2]; G[4 * i + 3] = v[3]; }
                    bitonic_sort16_desc(G);
#pragma unroll
                    for (int i = 0; i < 16; ++i) T[i] = fmaxf(T[i], G[15 - i]);
                    bitonic_merge16_desc(T);
                }
                float O[16];
#pragma unroll
                for (int i = 0; i < 16; ++i) O[i] = __int_as_float(__builtin_amdgcn_update_dpp(0, __float_as_int(T[i]), 0xB1, 0xF, 0xF, true));
#pragma unroll
                for (int i = 0; i < 16; ++i) T[i] = fmaxf(T[i], O[15 - i]);
                bitonic_merge16_desc(T);
                if (part == 0) {
#pragma unroll
                    for (int i = 0; i < 4; ++i) *(LAS f32x4*)(TP + (list * 2 + half) * 16 + i * 4) = (f32x4){T[4 * i], T[4 * i + 1], T[4 * i + 2], T[4 * i + 3]};
                }
            } else if (cv_pos + (size_t)(tid - 256) < cv_end) convert_item(p, ws, cv_pos + (size_t)(tid - 256));
            cv_pos += 256;
            __syncthreads();
        }
        if (tid < 128) {
            float v1[16], v2[16], L[16];
#pragma unroll
            for (int i = 0; i < 4; ++i) {
                const f32x4 va = *(const LAS f32x4*)(TP + (tid * 2) * 16 + i * 4), vb = *(const LAS f32x4*)(TP + (tid * 2 + 1) * 16 + i * 4);
#pragma unroll
                for (int e = 0; e < 4; ++e) { v1[4 * i + e] = va[e]; v2[4 * i + e] = vb[e]; }
            }
#pragma unroll
            for (int jj = 0; jj < 16; ++jj) { const float c = v1[0] + v2[jj]; L[jj] = __uint_as_float((__float_as_uint(c) & ~255u) | (unsigned)jj); }
#pragma unroll
            for (int i = 1; i < 16; ++i)
#pragma unroll
                for (int jj = 0; jj < 16; ++jj)
                    if ((i + 1) * (jj + 1) <= 16) { const float c = v1[i] + v2[jj]; TOPK_INS_FROM(L, __uint_as_float((__float_as_uint(c) & ~255u) | (unsigned)(i * 16 + jj)), (i + 1) * (jj + 1) - 1); }
            float ex[16], sum = 0.f;
#pragma unroll
            for (int k = 0; k < 16; ++k) { ex[k] = fexp2((L[k] - L[0]) * 1.44269504f); sum += ex[k]; }
            const float rinv = 1.f / sum;
#pragma unroll
            for (int k = 0; k < 16; ++k) {
                const unsigned code = __float_as_uint(L[k]) & 255u;
                const unsigned e1 = __float_as_uint(TP[(tid * 2) * 16 + (code >> 4)]) & 127u, e2 = __float_as_uint(TP[(tid * 2 + 1) * 16 + (code & 15u)]) & 127u;
                ((LAS int*)SC)[tid * 16 + k] = (int)(e1 * 128u + e2); SC[2048 + tid * 16 + k] = ex[k] * rinv;
            }
        }
        __syncthreads();
        *(u32x4*)(ids + (size_t)row0 * 128 + tid * 4) = *(const LAS u32x4*)((LAS int*)SC + tid * 4);
        *(f32x4*)(wts + (size_t)row0 * 128 + tid * 4) = *(const LAS f32x4*)(SC + 2048 + tid * 4);
        __syncthreads();
    }
    for (size_t it = cv_pos + tid; it < cv_end; it += 512) convert_item(p, ws, it);
}

__device__ __forceinline__ void phase8(const Ctx& cx, const Params& p, LAS unsigned char* lds) {
    unsigned char* ws = p.ws; const unsigned char* EU = ws + OFF_EU; const unsigned char* EV = ws + OFF_EV;
    const int* ids = (const int*)(ws + OFF_IDS); const float* wts = (const float*)(ws + OFF_WTS);
    const float* ss2 = (const float*)(ws + OFF_SS2);
    const int tid = cx.tid, wid = __builtin_amdgcn_readfirstlane(tid >> 6), lane = tid & 63, fr = lane & 15, fq = lane >> 4;
    const int nfull = (NTOK / (cx.nb * 8)) * (cx.nb * 8);
    const unsigned char* ET = ws + OFF_EU;
    int nid0 = 0, nid1 = 0; float nw0 = 0.f, nw1 = 0.f, nr2 = 0.f;
    auto fetch_ids = [&](int r, int& i0_, int& i1_, float& a0, float& a1, float& rr) {
        i0_ = ids[(size_t)r * 128 + lane] & 16383; i1_ = ids[(size_t)r * 128 + 64 + lane] & 16383;
        a0 = wts[(size_t)r * 128 + lane]; a1 = wts[(size_t)r * 128 + 64 + lane];
        rr = rsq(ss2[r] * (1.f / 1024.f) + EPS) * (1.f / EU_SCALE);
    };
    if (cx.bid * 8 + wid < nfull) fetch_ids(cx.bid * 8 + wid, nid0, nid1, nw0, nw1, nr2);
    for (int r = cx.bid * 8 + wid; r < nfull; r += cx.nb * 8) {
        const int id0 = nid0, id1 = nid1; const float w0 = nw0, w1 = nw1, r2 = nr2;
        float* yr = yrow(p, r);
        f32x2 tq[4][8];
#pragma unroll
        for (int j = 0; j < 4; ++j)
#pragma unroll
            for (int q = 0; q < 4; ++q) { const f32x4 v = *(const f32x4*)(yr + (fr + 16 * j) * 16 + q * 4); tq[j][2 * q] = (f32x2){v[0], v[1]}; tq[j][2 * q + 1] = (f32x2){v[2], v[3]}; }
        if (r + cx.nb * 8 < nfull) fetch_ids(r + cx.nb * 8, nid0, nid1, nw0, nw1, nr2);
        f32x2 acc[4][8];
#pragma unroll
        for (int j = 0; j < 4; ++j)
#pragma unroll
            for (int q = 0; q < 8; ++q) acc[j][q] = (f32x2){0.f, 0.f};
#pragma unroll 2
        for (int it = 0; it < 32; ++it) {
            const int src = ((it & 15) << 2) + fq;
            const int e = it < 16 ? shl_(id0, src) : shl_(id1, src);
            const float w = it < 16 ? shl_(w0, src) : shl_(w1, src);
            const unsigned char* rp = ET + (size_t)e * 2048 + fr * 16;
            u32x4 du[4], dv[4];
#pragma unroll
            for (int j = 0; j < 4; ++j) { du[j] = *(const u32x4*)(rp + j * 256); dv[j] = *(const u32x4*)(rp + 1024 + j * 256); }
            f32x2 s2 = (f32x2){0.f, 0.f};
#pragma unroll
            for (int j = 0; j < 4; ++j)
#pragma unroll
                for (int q = 0; q < 4; ++q) {
                    s2 = __builtin_amdgcn_cvt_pk_f32_fp8((int)du[j][q], false) * tq[j][2 * q] + s2;
                    s2 = __builtin_amdgcn_cvt_pk_f32_fp8((int)du[j][q], true) * tq[j][2 * q + 1] + s2;
                }
            const float sd = row16_sum(s2[0] + s2[1]);
            const float c = w * gelu_t(r2 * sd) * (1.f / EV_SCALE); const f32x2 cc = (f32x2){c, c};
#pragma unroll
            for (int j = 0; j < 4; ++j)
#pragma unroll
                for (int q = 0; q < 4; ++q) {
                    acc[j][2 * q] = __builtin_amdgcn_cvt_pk_f32_fp8((int)dv[j][q], false) * cc + acc[j][2 * q];
                    acc[j][2 * q + 1] = __builtin_amdgcn_cvt_pk_f32_fp8((int)dv[j][q], true) * cc + acc[j][2 * q + 1];
                }
        }
        float ss = 0.f;
#pragma unroll
        for (int j = 0; j < 4; ++j)
#pragma unroll
            for (int q = 0; q < 8; ++q)
#pragma unroll
                for (int h2 = 0; h2 < 2; ++h2) { float v = acc[j][q][h2]; v += shx(v, 16, lane); v += shx(v, 32, lane); acc[j][q][h2] = v; }
        if (fq == 0) {
#pragma unroll
            for (int j = 0; j < 4; ++j)
#pragma unroll
                for (int q = 0; q < 4; ++q) {
                    const f32x4 xv = *(const f32x4*)(yr + (fr + 16 * j) * 16 + q * 4);
                    acc[j][2 * q][0] += xv[0]; acc[j][2 * q][1] += xv[1]; acc[j][2 * q + 1][0] += xv[2]; acc[j][2 * q + 1][1] += xv[3];
                    ss += acc[j][2 * q][0] * acc[j][2 * q][0] + acc[j][2 * q][1] * acc[j][2 * q][1] + acc[j][2 * q + 1][0] * acc[j][2 * q + 1][0] + acc[j][2 * q + 1][1] * acc[j][2 * q + 1][1];
                }
        }
        ss = wave_sum(ss, lane);
        const float rs = rsq(ss * (1.f / 1024.f) + EPS);
        if (fq == 0) {
#pragma unroll
            for (int j = 0; j < 4; ++j)
#pragma unroll
                for (int q = 0; q < 4; ++q) {
                    const f32x4 g0 = *(const f32x4*)(p.g_final + (fr + 16 * j) * 16 + q * 4);
                    *(f32x4*)(yr + (fr + 16 * j) * 16 + q * 4) = (f32x4){acc[j][2 * q][0], acc[j][2 * q][1], acc[j][2 * q + 1][0], acc[j][2 * q + 1][1]} * rs * g0;
                }
        }
    }
    LAS float* cfb = (LAS float*)lds; LAS float* part = (LAS float*)(lds + 4096);
    __syncthreads();
    for (int r = nfull + cx.bid; r < NTOK; r += cx.nb) {
        const int id0 = ids[(size_t)r * 128 + lane] & 16383, id1 = ids[(size_t)r * 128 + 64 + lane] & 16383;
        const float w0 = wts[(size_t)r * 128 + lane], w1 = wts[(size_t)r * 128 + 64 + lane];
        const float r2 = rsq(ss2[r] * (1.f / 1024.f) + EPS) * (1.f / EU_SCALE);
        float* yr = yrow(p, r);
        f32x2 tq[4][8];
#pragma unroll
        for (int j = 0; j < 4; ++j)
#pragma unroll
            for (int q = 0; q < 4; ++q) { const f32x4 v = *(const f32x4*)(yr + (fr + 16 * j) * 16 + q * 4); tq[j][2 * q] = (f32x2){v[0], v[1]}; tq[j][2 * q + 1] = (f32x2){v[2], v[3]}; }
#pragma unroll
        for (int i4 = 0; i4 < 4; ++i4) {
            const int it = wid * 4 + i4, src = ((it & 15) << 2) + fq;
            const int e = it < 16 ? shl_(id0, src) : shl_(id1, src);
            const float w = it < 16 ? shl_(w0, src) : shl_(w1, src);
            const unsigned char* rp = ET + (size_t)e * 2048 + fr * 16;
            u32x4 d[4];
#pragma unroll
            for (int j = 0; j < 4; ++j) d[j] = *(const u32x4*)(rp + j * 256);
            f32x2 s2 = (f32x2){0.f, 0.f};
#pragma unroll
            for (int j = 0; j < 4; ++j)
#pragma unroll
                for (int q = 0; q < 4; ++q) {
                    s2 = __builtin_amdgcn_cvt_pk_f32_fp8((int)d[j][q], false) * tq[j][2 * q] + s2;
                    s2 = __builtin_amdgcn_cvt_pk_f32_fp8((int)d[j][q], true) * tq[j][2 * q + 1] + s2;
                }
            const float sd = row16_sum(s2[0] + s2[1]);
            if (fr == 0) cfb[it * 4 + fq] = w * gelu_t(r2 * sd) * (1.f / EV_SCALE);
        }
        __syncthreads();
        const float c0 = cfb[lane], c1 = cfb[64 + lane];
        const int idsel = wid < 4 ? id0 : id1; const float csel = wid < 4 ? c0 : c1;
        f32x2 acc[8];
#pragma unroll
        for (int i = 0; i < 8; ++i) acc[i] = (f32x2){0.f, 0.f};
#pragma unroll
        for (int k16 = 0; k16 < 16; ++k16) {
            const int kk = (wid & 3) * 16 + k16;
            const int e = __builtin_amdgcn_readlane(idsel, kk); const float c = __int_as_float(__builtin_amdgcn_readlane(__float_as_int(csel), kk));
            const u32x4 v = *(const u32x4*)(ET + (size_t)e * 2048 + 1024 + lane * 16); const f32x2 cc = (f32x2){c, c};
#pragma unroll
            for (int q = 0; q < 4; ++q) { acc[2 * q] = __builtin_amdgcn_cvt_pk_f32_fp8((int)v[q], false) * cc + acc[2 * q]; acc[2 * q + 1] = __builtin_amdgcn_cvt_pk_f32_fp8((int)v[q], true) * cc + acc[2 * q + 1]; }
        }
#pragma unroll
        for (int q = 0; q < 4; ++q) *(LAS f32x4*)(part + (wid * 64 + lane) * 16 + q * 4) = (f32x4){acc[2 * q][0], acc[2 * q][1], acc[2 * q + 1][0], acc[2 * q + 1][1]};
        __syncthreads();
        if (wid == 0) {
            float ss = 0.f; f32x4 x[4];
#pragma unroll
            for (int j = 0; j < 4; ++j) {
                x[j] = *(const f32x4*)(yr + lane * 16 + j * 4);
#pragma unroll
                for (int w8 = 0; w8 < 8; ++w8) x[j] += *(const LAS f32x4*)(part + (w8 * 64 + lane) * 16 + j * 4);
                ss += x[j][0] * x[j][0] + x[j][1] * x[j][1] + x[j][2] * x[j][2] + x[j][3] * x[j][3];
            }
            ss = wave_sum(ss, lane);
            const float rs = rsq(ss * (1.f / 1024.f) + EPS);
#pragma unroll
            for (int j = 0; j < 4; ++j) { const f32x4 g0 = *(const f32x4*)(p.g_final + lane * 16 + j * 4); *(f32x4*)(yr + lane * 16 + j * 4) = x[j] * rs * g0; }
        }
        __syncthreads();
    }
}

__device__ __forceinline__ void strip_mma(const bf16_t* A, int lda, const bf16_t* Bt, int ldb, int K, int c, int wid, int fr, int fq, f32x4 (&acc)[2]) {
#pragma unroll 2
    for (int ks = 0; ks < K / 32; ks += 4) {
        bf16x8 a[2][4], b[4];
#pragma unroll
        for (int u = 0; u < 4; ++u) {
            b[u] = *(const bf16x8*)(Bt + (size_t)(16 * c + fr) * ldb + (ks + u) * 32 + fq * 8);
#pragma unroll
            for (int i = 0; i < 2; ++i) a[i][u] = *(const bf16x8*)(A + (size_t)((2 * wid + i) * 16 + fr) * lda + (ks + u) * 32 + fq * 8);
        }
#pragma unroll
        for (int u = 0; u < 4; ++u)
#pragma unroll
            for (int i = 0; i < 2; ++i) acc[i] = MFMA16(a[i][u], b[u], acc[i]);
    }
}
__device__ __forceinline__ void sample_merge(const Ctx& cx, const Params& p) {
    unsigned char* ws = p.ws; const bf16_t* Zs = (const bf16_t*)(ws + OFF_Z) + (size_t)16384 * INC; bf16_t* M1 = (bf16_t*)(ws + OFF_M1) + (size_t)16384 * 1024;
    const int tid = cx.tid, wid = __builtin_amdgcn_readfirstlane(tid >> 6), lane = tid & 63, fr = lane & 15, fq = lane >> 4;
    for (int c = cx.bid; c < 64; c += cx.nb) {
        f32x4 aa[2] = {(f32x4){0.f, 0.f, 0.f, 0.f}, (f32x4){0.f, 0.f, 0.f, 0.f}}, ab[2] = {(f32x4){0.f, 0.f, 0.f, 0.f}, (f32x4){0.f, 0.f, 0.f, 0.f}};
        strip_mma(Zs, INC, (const bf16_t*)(ws + OFF_WA), 1024, 1024, c, wid, fr, fq, aa);
#pragma unroll 1
        for (int hh = 0; hh < 4; ++hh) {
            f32x4 ah[2] = {(f32x4){0.f, 0.f, 0.f, 0.f}, (f32x4){0.f, 0.f, 0.f, 0.f}};
            strip_mma(Zs + 4096 + hh * 512, INC, (const bf16_t*)(ws + OFF_WB) + hh * 512, 2048, 512, c, wid, fr, fq, ah);
#pragma unroll
            for (int i = 0; i < 2; ++i)
#pragma unroll
                for (int j = 0; j < 4; ++j) ab[i][j] += ah[i][j] * rsq(((const float*)(ws + OFF_SSO))[(size_t)(16384 + (2 * wid + i) * 16 + fq * 4 + j) * 4 + hh] * (1.f / 512.f) + EPS);
        }
#pragma unroll
        for (int i = 0; i < 2; ++i)
#pragma unroll
            for (int j = 0; j < 4; ++j) {
                const int row = (2 * wid + i) * 16 + fq * 4 + j, col = 16 * c + fr;
                const float ga = bf_lo((unsigned)Zs[(size_t)row * INC + 8192 + col]), gb = bf_lo((unsigned)Zs[(size_t)row * INC + 9216 + col]);
                M1[(size_t)row * 1024 + col] = f2bf(ga * aa[i][j] + gb * ab[i][j]);
            }
    }
}
__device__ __forceinline__ void sample_x2(const Ctx& cx, const Params& p) {
    unsigned char* ws = p.ws; bf16_t* X2b = (bf16_t*)(ws + OFF_X2B) + (size_t)16384 * 1024; float* ss2 = (float*)(ws + OFF_SS2) + 16384;
    const int tid = cx.tid, wid = __builtin_amdgcn_readfirstlane(tid >> 6), lane = tid & 63, fr = lane & 15, fq = lane >> 4;
    for (int c = cx.bid; c < 64; c += cx.nb) {
        f32x4 acc[2] = {(f32x4){0.f, 0.f, 0.f, 0.f}, (f32x4){0.f, 0.f, 0.f, 0.f}};
        strip_mma((const bf16_t*)(ws + OFF_M1) + (size_t)16384 * 1024, 1024, (const bf16_t*)(ws + OFF_WO), 1024, 1024, c, wid, fr, fq, acc);
#pragma unroll
        for (int i = 0; i < 2; ++i)
#pragma unroll
            for (int j = 0; j < 4; ++j) {
                const int row = (2 * wid + i) * 16 + fq * 4 + j, col = 16 * c + fr;
                const float v = p.xs[(size_t)row * 1024 + col] + acc[i][j];
                p.out[O_YS + (size_t)row * 1024 + col] = v; X2b[(size_t)row * 1024 + col] = f2bf(v);
                const float sq = row16_sum(v * v);
                if (fr == 0) atomicAdd(ss2 + row, sq);
            }
    }
}
__device__ __forceinline__ void sample_query(const Ctx& cx, const Params& p) {
    unsigned char* ws = p.ws; bf16_t* QP = (bf16_t*)(ws + OFF_QP) + (size_t)16384 * 2048; const float* ss2 = (const float*)(ws + OFF_SS2) + 16384;
    const int tid = cx.tid, wid = __builtin_amdgcn_readfirstlane(tid >> 6), lane = tid & 63, fr = lane & 15, fq = lane >> 4;
    for (int c = cx.bid; c < 128; c += cx.nb) {
        f32x4 acc[2] = {(f32x4){0.f, 0.f, 0.f, 0.f}, (f32x4){0.f, 0.f, 0.f, 0.f}};
        strip_mma((const bf16_t*)(ws + OFF_X2B) + (size_t)16384 * 1024, 1024, (const bf16_t*)(ws + OFF_WQ), 1024, 1024, c, wid, fr, fq, acc);
#pragma unroll
        for (int i = 0; i < 2; ++i)
#pragma unroll
            for (int j = 0; j < 4; ++j) {
                const int row = (2 * wid + i) * 16 + fq * 4 + j, col = 16 * c + fr;
                QP[(size_t)row * 2048 + col] = f2bf(acc[i][j] * rsq(ss2[row] * (1.f / 1024.f) + EPS));
            }
    }
}

__device__ __forceinline__ void run_phase(const Params& p, LAS unsigned char* lds, int ph, const Ctx& cx) {
    unsigned char* ws = p.ws; pg8::StaticOrder S; pg8::Gemm g;
    bf16_t* Z = (bf16_t*)(ws + OFF_Z); bf16_t* T1 = (bf16_t*)((unsigned char*)p.out + OUT_T1);
    if (ph == 0) { phase0(cx, p, lds); return; }
    if (ph >= 1 && ph <= 8) {
        const int hf = (ph - 1) >> 2, sub = (ph - 1) & 3, rowbase = hf ? NH0 : 0, nM = hf ? 64 : 65;
        if (sub == 0) {
            g.A = (const bf16_t*)((unsigned char*)p.out + OUT_XB) + (size_t)rowbase * 1024; g.Bt = (const bf16_t*)(ws + OFF_WIN); g.lda = 1024; g.ldb = 1024; g.K = 1024;
            S.init(nM, 40, cx.nb, cx.bid);
            EpiIn E{Z, (const float*)(ws + OFF_R1), (float*)(ws + OFF_SSV), p.b_gate, rowbase};
            pg8::gemm_phase(cx, lds, g, S, E);
        } else if (sub == 1) phase2(cx, p, lds, hf);
#ifdef DBG_SKIP_P3
        else if (sub == 2) { }
#else
        else if (sub == 2) { }
#endif
        else {
            S.init(64, 4, cx.nb, cx.bid);
            g.A = Z; g.Bt = (const bf16_t*)(ws + OFF_WA); g.lda = INC; g.ldb = 1024; g.K = 1024;
            EpiT1 E1{T1, Z}; pg8::gemm_phase(cx, lds, g, S, E1);
            g.A = Z + 4096; g.Bt = (const bf16_t*)(ws + OFF_WB); g.lda = INC; g.ldb = 2048; g.K = 2048;
            EpiM1 E2{T1, Z, (bf16_t*)(ws + OFF_M1), rowbase, (const float*)(ws + OFF_SSO)}; pg8::gemm_phase(cx, lds, g, S, E2);
            if (hf == 0) sample_merge(cx, p);
        }
        return;
    }
#ifdef DBG_YCONST
    if (ph >= 9 && ph <= 11) return;
#endif
    if (ph == 9) {
        g.A = (const bf16_t*)(ws + OFF_M1); g.Bt = (const bf16_t*)(ws + OFF_WO); g.lda = 1024; g.ldb = 1024; g.K = 1024;
        S.init(128, 4, cx.nb, cx.bid, 64);
        EpiX2 E{p.xp, p.xs, p.out, (bf16_t*)(ws + OFF_X2B), (float*)(ws + OFF_SS2)}; pg8::gemm_phase(cx, lds, g, S, E);
        sample_x2(cx, p); return;
    }
    if (ph == 10) {
        g.A = (const bf16_t*)(ws + OFF_X2B); g.Bt = (const bf16_t*)(ws + OFF_WQ); g.lda = 1024; g.ldb = 1024; g.K = 1024;
        S.init(128, 8, cx.nb, cx.bid, 64);
        EpiQP E{(bf16_t*)(ws + OFF_QP), (const float*)(ws + OFF_SS2)}; pg8::gemm_phase(cx, lds, g, S, E);
        sample_query(cx, p); return;
    }
    if (ph == 11) { phase7(cx, p, lds); return; }
    if (ph == 12) { phase8(cx, p, lds); return; }
}
constexpr int NPHASE = 13;

extern __shared__ __attribute__((aligned(16))) unsigned char dyn_smem[];

#if ONE_LAUNCH
__device__ __forceinline__ void grid_barrier(unsigned* ctr, unsigned target, int tid) {
    asm volatile("s_waitcnt vmcnt(0)" ::: "memory");
    __syncthreads();
    if (tid == 0) {
        __builtin_amdgcn_fence(__ATOMIC_RELEASE, "agent");
        asm volatile("s_waitcnt vmcnt(0)" ::: "memory");
        __hip_atomic_fetch_add(ctr, 1u, __ATOMIC_RELAXED, __HIP_MEMORY_SCOPE_AGENT);
        while (__hip_atomic_load(ctr, __ATOMIC_RELAXED, __HIP_MEMORY_SCOPE_AGENT) < target) __builtin_amdgcn_s_sleep(1);
        __builtin_amdgcn_fence(__ATOMIC_ACQUIRE, "agent");
        asm volatile("s_waitcnt vmcnt(0)" ::: "memory");
    }
    __syncthreads();
}
__global__ __launch_bounds__(512, 2) void mega_kernel(Params p) {
#if defined(__HIP_DEVICE_COMPILE__)
    LAS unsigned char* lds = (LAS unsigned char*)dyn_smem;
    cg::grid_group grid = cg::this_grid();
    const int wave0 = __builtin_amdgcn_readfirstlane((int)threadIdx.x >> 6);
    unsigned nbar = 0;
    { int never = 0; asm volatile("" : "+s"(never));
      if (never == 1000) grid.sync(); }
#pragma nounroll
    for (int ph = 0; ph < NPHASE; ++ph) {
        int phv = ph; asm volatile("" : "+s"(phv));
        int wv = wave0; asm volatile("" : "+s"(wv));
        int ln = (int)__builtin_amdgcn_mbcnt_hi(~0u, __builtin_amdgcn_mbcnt_lo(~0u, 0u)); asm volatile("" : "+v"(ln));
        Ctx cx; cx.tid = wv * 64 + ln; cx.bid = blockIdx.x; cx.nb = gridDim.x;
        asm volatile("" : "+s"(cx.bid)); asm volatile("" : "+s"(cx.nb));
        auto ka = __builtin_amdgcn_kernarg_segment_ptr(); asm volatile("" : "+s"(ka));
        const Params pl = *(const Params __attribute__((address_space(4)))*)(unsigned long long)ka;
        unsigned lo = 0; asm volatile("" : "+s"(lo));
        if (ph == 3 || ph == 7) continue;
        run_phase(pl, lds + lo, phv, cx);
        if (ph + 1 < NPHASE) { ++nbar; grid_barrier((unsigned*)(pl.ws + OFF_BAR), nbar * (unsigned)cx.nb, cx.tid); }
    }
#endif
}
#else
__global__ __launch_bounds__(512, 2) void stage_kernel(Params p, int ph) {
    LAS unsigned char* lds = (LAS unsigned char*)dyn_smem;
    Ctx cx; cx.tid = threadIdx.x; cx.bid = blockIdx.x; cx.nb = gridDim.x;
    run_phase(p, lds, ph, cx);
}
#endif

extern "C" void kernel_launch(void* const* d_in, const int* in_sizes, int n_in, void* d_out, int out_size, void* d_ws, size_t ws_size, hipStream_t stream) {
    Params p; memset(&p, 0, sizeof(p));
    p.xp = (const float*)d_in[0]; p.xs = (const float*)d_in[1]; p.state = (const float*)d_in[2]; p.w_in = (const float*)d_in[3]; p.w_s = (const float*)d_in[4];
    p.b_s = (const float*)d_in[5]; p.g_sgu = (const float*)d_in[6]; p.w_pa = (const float*)d_in[7]; p.w_pb = (const float*)d_in[8]; p.b_gate = (const float*)d_in[9];
    p.w_out = (const float*)d_in[10]; p.g_mix = (const float*)d_in[11]; p.g_ffn = (const float*)d_in[12]; p.w_q = (const float*)d_in[13]; p.k1 = (const float*)d_in[14];
    p.k2 = (const float*)d_in[15]; p.eu = (const float*)d_in[16]; p.ev = (const float*)d_in[17]; p.g_final = (const float*)d_in[18];
    p.out = (float*)d_out; p.ws = (unsigned char*)d_ws;
    if (ws_size < WS_NEED) { fprintf(stderr, "workspace too small: %zu < %zu\n", ws_size, (size_t)WS_NEED); return; }
#if ONE_LAUNCH
    static int grid_blocks = 0;
    if (!grid_blocks) {
        (void)hipFuncSetAttribute((const void*)mega_kernel, hipFuncAttributeMaxDynamicSharedMemorySize, LDS_BYTES);
        int dev = 0, cus = 0, per_cu = 0;
        hipGetDevice(&dev); hipDeviceGetAttribute(&cus, hipDeviceAttributeMultiprocessorCount, dev);
        hipOccupancyMaxActiveBlocksPerMultiprocessor(&per_cu, mega_kernel, 512, LDS_BYTES);
        if (per_cu < 1) per_cu = 1;
        grid_blocks = cus * 1;
    }
    (void)hipMemsetAsync((unsigned char*)d_ws + OFF_BAR, 0, 256, stream);
    void* args[] = {&p};
    hipError_t e = hipLaunchCooperativeKernel((const void*)mega_kernel, dim3(grid_blocks), dim3(512), args, LDS_BYTES, stream);
    if (e != hipSuccess) fprintf(stderr, "cooperative launch failed: %s (grid %d)\n", hipGetErrorString(e), grid_blocks);
#else
    static bool attr = false;
    if (!attr) { (void)hipFuncSetAttribute((const void*)stage_kernel, hipFuncAttributeMaxDynamicSharedMemorySize, LDS_BYTES); attr = true; }
    for (int ph = 0; ph < NPHASE; ++ph) hipLaunchKernelGGL(stage_kernel, dim3(256), dim3(512), LDS_BYTES, stream, p, ph);
#endif
}
```

```cpp
#include <hip/hip_runtime.h>
#include <hip/hip_cooperative_groups.h>
#include <cstdio>
#include <cstring>
namespace cg = cooperative_groups;

#ifndef ONE_LAUNCH
#define ONE_LAUNCH 1
#endif

#define LAS __attribute__((address_space(3)))
typedef unsigned short bf16_t;
typedef short bf16x8 __attribute__((ext_vector_type(8)));
typedef float f32x4 __attribute__((ext_vector_type(4)));
typedef unsigned u32x4 __attribute__((ext_vector_type(4)));
typedef unsigned u32x2 __attribute__((ext_vector_type(2)));
typedef __bf16 bf16x2_t __attribute__((ext_vector_type(2)));

constexpr int DM = 1024, NTOK = 33024, NH0 = 16640, INC = 10240;
constexpr float EPS = 1e-6f;
constexpr int LDS_BYTES = 153600;
constexpr float EU_SCALE = 64.f, EV_SCALE = 64.f;

constexpr size_t OFF_WIN = 0;
constexpr size_t OFF_WA  = OFF_WIN + (size_t)10240 * 1024 * 2;
constexpr size_t OFF_WB  = OFF_WA + (size_t)1024 * 1024 * 2;
constexpr size_t OFF_WO  = OFF_WB + (size_t)1024 * 2048 * 2;
constexpr size_t OFF_WQ  = OFF_WO + (size_t)1024 * 1024 * 2;
constexpr size_t OFF_EU  = OFF_WQ + (size_t)2048 * 1024 * 2;
constexpr size_t OFF_EV  = OFF_EU + (size_t)16384 * 1024 * 2;
constexpr size_t OFF_K1  = OFF_EV + (size_t)16384 * 1024 * 2;
constexpr size_t OFF_K2  = OFF_K1 + 32768;
constexpr size_t OFF_M1  = OFF_K2 + 32768;
constexpr size_t OFF_R1  = OFF_M1 + (size_t)NTOK * 1024 * 2;
constexpr size_t OFF_SSV = OFF_R1 + (size_t)NTOK * 4;
constexpr size_t OFF_SS2 = OFF_SSV + (size_t)NTOK * 4;
constexpr size_t OFF_SSO = OFF_SS2 + (size_t)NTOK * 4;
constexpr size_t OFF_Z   = OFF_SSO + (size_t)NTOK * 16;
constexpr size_t Z_BYTES = (size_t)NH0 * INC * 2;
constexpr size_t OFF_BAR = OFF_Z + Z_BYTES;
constexpr size_t WS_NEED = OFF_BAR + 256;
constexpr size_t OFF_X2B = OFF_Z;
constexpr size_t OFF_QP  = OFF_X2B + (size_t)NTOK * 1024 * 2;
constexpr size_t OFF_IDS = OFF_QP + (size_t)NTOK * 2048 * 2;
constexpr size_t OFF_WTS = OFF_IDS + (size_t)NTOK * 128 * 4;
constexpr size_t OUT_XB = 0;
constexpr size_t OUT_T1 = (size_t)NTOK * 1024 * 2;
constexpr size_t O_YP = 0, O_YS = (size_t)32768 * 1024, O_SP = O_YS + (size_t)256 * 1024, O_SS = O_SP + (size_t)16 * 4 * 256 * 512,
                 O_SV = O_SS + (size_t)16 * 4 * 256 * 512;

struct Params {
    const float *xp, *xs, *state, *w_in, *w_s, *b_s, *g_sgu, *w_pa, *w_pb, *b_gate, *w_out, *g_mix, *g_ffn, *w_q, *k1, *k2, *eu, *ev, *g_final;
    float* out;
    unsigned char* ws;
};

struct Ctx { int tid, bid, nb; };

__device__ __forceinline__ float bf_lo(unsigned u) { return __uint_as_float(u << 16); }
__device__ __forceinline__ float bf_hi(unsigned u) { return __uint_as_float(u & 0xffff0000u); }
typedef float f32x2 __attribute__((ext_vector_type(2)));
__device__ __forceinline__ unsigned pk_bf16(float lo, float hi) {
    f32x2 v = {lo, hi}; bf16x2_t b = __builtin_convertvector(v, bf16x2_t); return __builtin_bit_cast(unsigned, b);
}
__device__ __forceinline__ bf16_t f2bf(float f) { return (bf16_t)(pk_bf16(f, 0.f) & 0xffffu); }
__device__ __forceinline__ float fexp2(float x) { return __builtin_amdgcn_exp2f(x); }
__device__ __forceinline__ float frcp(float x) { return __builtin_amdgcn_rcpf(x); }
__device__ __forceinline__ float sigm(float x) { return frcp(1.f + fexp2(-1.44269504f * x)); }
__device__ __forceinline__ float gelu_t(float x) { const float u = 0.7978845608f * (x + 0.044715f * x * x * x); return x * frcp(1.f + fexp2(-2.88539008f * u)); }
__device__ __forceinline__ float rsq(float x) { return __builtin_amdgcn_rsqf(x); }
__device__ __forceinline__ f32x2 sigm2(f32x2 x) {
    const f32x2 t = x * (-1.44269504f); f32x2 e; e.x = fexp2(t.x); e.y = fexp2(t.y);
    const f32x2 d = e + 1.f; f32x2 r; r.x = frcp(d.x); r.y = frcp(d.y); return r;
}
__device__ __forceinline__ f32x2 gelu_t2(f32x2 x) {
    const f32x2 w = (x * x) * (-0.10294324f) + (-2.3022082f), t = x * w;
    f32x2 e; e.x = fexp2(t.x); e.y = fexp2(t.y);
    const f32x2 d = e + 1.f;
    f32x2 r; r.x = frcp(d.x); r.y = frcp(d.y);
    return x * r;
}
__device__ __forceinline__ const float* xrow(const Params& p, int ir) {
    return ir < 16384 ? p.xp + (size_t)ir * 1024 : (ir < 16640 ? p.xs + (size_t)(ir - 16384) * 1024 : p.xp + (size_t)(ir - 256) * 1024);
}
__device__ __forceinline__ float* yrow(const Params& p, int ir) {
    return ir < 16384 ? p.out + O_YP + (size_t)ir * 1024 : (ir < 16640 ? p.out + O_YS + (size_t)(ir - 16384) * 1024 : p.out + O_YP + (size_t)(ir - 256) * 1024);
}
__device__ __forceinline__ float shx(float v, int m, int lane) { return __int_as_float(__builtin_amdgcn_ds_bpermute((lane ^ m) << 2, __float_as_int(v))); }
__device__ __forceinline__ float shl_(float v, int src) { return __int_as_float(__builtin_amdgcn_ds_bpermute(src << 2, __float_as_int(v))); }
__device__ __forceinline__ int shl_(int v, int src) { return __builtin_amdgcn_ds_bpermute(src << 2, v); }
__device__ __forceinline__ float wave_sum(float v, int lane) {
#pragma unroll
    for (int o = 32; o >= 1; o >>= 1) v += shx(v, o, lane);
    return v;
}
__device__ __forceinline__ float row16_sum(float s) {
    s += __int_as_float(__builtin_amdgcn_update_dpp(0, __float_as_int(s), 0xB1, 0xF, 0xF, true));
    s += __int_as_float(__builtin_amdgcn_update_dpp(0, __float_as_int(s), 0x4E, 0xF, 0xF, true));
    s += __int_as_float(__builtin_amdgcn_update_dpp(0, __float_as_int(s), 0x141, 0xF, 0xF, true));
    s += __int_as_float(__builtin_amdgcn_update_dpp(0, __float_as_int(s), 0x140, 0xF, 0xF, true));
    return s;
}
__device__ __forceinline__ float dot2bf(unsigned a, unsigned b, float c) {
    return __builtin_amdgcn_fdot2_f32_bf16(__builtin_bit_cast(bf16x2_t, a), __builtin_bit_cast(bf16x2_t, b), c, false);
}
typedef short s16x4 __attribute__((ext_vector_type(4)));
__device__ __forceinline__ bf16x8 tr_frag(const LAS bf16_t* tile, int stride, int lane) {
    const LAS bf16_t* a0 = tile + (8 * (lane >> 4) + ((lane >> 2) & 3)) * stride + 4 * (lane & 3);
    const s16x4 lo = __builtin_amdgcn_ds_read_tr16_b64_v4i16((LAS s16x4*)a0), hi = __builtin_amdgcn_ds_read_tr16_b64_v4i16((LAS s16x4*)(a0 + 4 * stride));
    return (bf16x8){lo[0], lo[1], lo[2], lo[3], hi[0], hi[1], hi[2], hi[3]};
}
#define MFMA16(a, b, c) __builtin_amdgcn_mfma_f32_16x16x32_bf16((a), (b), (c), 0, 0, 0)

namespace pg8 {
constexpr int BM = 256, BK = 64, HALF = 128, HTB = HALF * BK * 2, STAGE_BYTES = 8 * HTB, NXCD = 8, WGM = 4;
__device__ __forceinline__ int lds_byte(int r, int c) { const int st = (r >> 4) * 2 + (c >> 5), rr = r & 15, cc = c & 31, ob = rr * 64 + cc * 2; return st * 1024 + (ob ^ (((ob >> 9) & 1) << 5)); }
__device__ __forceinline__ void stage_rc(int b, int& R, int& C) { const int st = b / 1024, sb = b % 1024, swz = sb ^ (((sb >> 9) & 1) << 5); R = (st >> 1) * 16 + swz / 64; C = (st & 1) * 32 + (swz % 64) / 2; }
__device__ __forceinline__ int perm32(int rho) { const int n = rho >> 4, i = rho & 15; return 8 * (i >> 2) + 4 * n + (i & 3); }
struct Unit { int pm, pn; };
struct Gemm { const bf16_t* A; const bf16_t* Bt; int lda, ldb, K; };
struct StaticOrder {
    int nM, nN, nwg, G, c, skip;
    __device__ void init(int nM_, int nN_, int G_, int c_, int skip_ = 1 << 30) { nM = nM_; nN = nN_; nwg = nM * nN; G = G_; c = c_; skip = skip_; }
    __device__ bool next(int i, Unit& u) const {
        const long L = (long)i * G + c; if (L >= nwg) return false;
        int wgid = (int)L; { const int q = nwg / NXCD, r = nwg % NXCD, xcd = wgid % NXCD, off = wgid / NXCD; wgid = (xcd < r ? xcd * (q + 1) : r * (q + 1) + (xcd - r) * q) + off; }
        const int nig = WGM * nN, gid = wgid / nig, fm = gid * WGM, gsz = (nM - fm) < WGM ? (nM - fm) : WGM;
        u.pm = fm + ((wgid % nig) % gsz); u.pn = (wgid % nig) / gsz; if (u.pm >= skip) ++u.pm; return true;
    }
};

template <class Epi>
__device__ __forceinline__ void gemm_phase(const Ctx& cx, LAS unsigned char* lds, const Gemm g, const StaticOrder& S, const Epi& E) {
    const int tid = cx.tid, wid = __builtin_amdgcn_readfirstlane(tid >> 6), lane = tid & 63, wr = wid >> 2, wc = wid & 3, fr = lane & 15, fq = lane >> 4;
    const int K = g.K, nt = K / BK;
    unsigned voffA[2], voffB[2];
#pragma unroll
    for (int i = 0; i < 2; ++i) { int R, C; stage_rc(tid * 16 + i * 8192, R, C); const int Rb = (R & ~31) + perm32(R & 31);
        voffA[i] = (unsigned)(R * g.lda + C) * 2u; voffB[i] = (unsigned)(Rb * g.ldb + C) * 2u; }
    const size_t kstep = (size_t)(BK * 2);
    const size_t hstepA = (size_t)HALF * g.lda * 2, hstepB = (size_t)HALF * g.ldb * 2;
    const size_t tstepA = 2 * hstepA, tstepB = 2 * hstepB;
    const unsigned ldsw = (unsigned)wid * 1024u;
    const int aoff = lds_byte(wr * 64 + fr, fq * 8), boff = lds_byte(wc * 32 + fr, fq * 8);
#define PG8_SA(b, h) (((b) * 2 + (h)) * HTB)
#define PG8_SB(b, h) ((4 + (b) * 2 + (h)) * HTB)
#define PG8_STAGE(bufoff, gbase, voff) do { _Pragma("unroll") for (int _i = 0; _i < 2; ++_i) \
        __builtin_amdgcn_global_load_lds((const unsigned*)((const char*)(gbase) + (voff)[_i]), (LAS unsigned*)(lds + (bufoff) + ldsw + _i * 8192), 16, 0, 0); } while (0)
#define PG8_LDA(dst, b, h) do { _Pragma("unroll") for (int m = 0; m < 4; ++m) _Pragma("unroll") for (int k = 0; k < 2; ++k) dst[m][k] = *(const LAS bf16x8*)(lds + PG8_SA(b, h) + aoff + m * 2048 + k * 1024); } while (0)
#define PG8_LDB(dst, b, h) do { _Pragma("unroll") for (int n = 0; n < 2; ++n) _Pragma("unroll") for (int k = 0; k < 2; ++k) dst[n][k] = *(const LAS bf16x8*)(lds + PG8_SB(b, h) + boff + n * 2048 + k * 1024); } while (0)
#define PG8_MMA(ai, bj, At, Bt) do { __builtin_amdgcn_s_setprio(1); _Pragma("unroll") for (int m = 0; m < 4; ++m) _Pragma("unroll") for (int n = 0; n < 2; ++n) _Pragma("unroll") for (int k = 0; k < 2; ++k) \
        acc[ai][bj][m][n] = __builtin_amdgcn_mfma_f32_16x16x32_bf16(Bt[n][k], At[m][k], acc[ai][bj][m][n], 0, 0, 0); __builtin_amdgcn_s_setprio(0); } while (0)
#define PG8_WAIT_V(n) asm volatile("s_waitcnt vmcnt(" #n ")" ::: "memory")
#define PG8_WAIT_L(n) asm volatile("s_waitcnt lgkmcnt(" #n ")" ::: "memory")
#define PG8_BAR __builtin_amdgcn_s_barrier()
#define PG8_SCHED __builtin_amdgcn_sched_barrier(0)
    Unit cur, nxt; int ui = 0;
    if (!S.next(0, cur)) return;
    f32x4 acc[2][2][4][2];
#pragma unroll
    for (int a = 0; a < 2; ++a)
#pragma unroll
        for (int b = 0; b < 2; ++b)
#pragma unroll
            for (int m = 0; m < 4; ++m)
#pragma unroll
                for (int n = 0; n < 2; ++n) acc[a][b][m][n] = (f32x4){0.f, 0.f, 0.f, 0.f};
    bf16x8 At[4][2], B0[2][2], B1[2][2];
    const char* cA = (const char*)g.A + (size_t)cur.pm * tstepA; const char* cB = (const char*)g.Bt + (size_t)cur.pn * tstepB;
    if constexpr (Epi::RESCALE) E.prep((LAS float*)(lds + STAGE_BYTES), cur, tid);
    PG8_STAGE(PG8_SB(0, 0), cB, voffB); PG8_STAGE(PG8_SA(0, 0), cA, voffA); PG8_STAGE(PG8_SB(0, 1), cB + hstepB, voffB); PG8_STAGE(PG8_SA(0, 1), cA + hstepA, voffA);
    if (wr == 1) PG8_BAR;
    PG8_WAIT_V(4); PG8_BAR;
    PG8_STAGE(PG8_SB(1, 0), cB + kstep, voffB); PG8_STAGE(PG8_SA(1, 0), cA + kstep, voffA); PG8_STAGE(PG8_SB(1, 1), cB + hstepB + kstep, voffB);
    PG8_WAIT_V(6); PG8_BAR;
    for (;;) {
        const bool has_next = S.next(ui + 1, nxt);
        if constexpr (Epi::RESCALE) { if (has_next) E.prep((LAS float*)(lds + STAGE_BYTES) + ((ui + 1) & 1) * 1024, nxt, tid); }
        const char* nA = has_next ? (const char*)g.A + (size_t)nxt.pm * tstepA : cA; const char* nB = has_next ? (const char*)g.Bt + (size_t)nxt.pn * tstepB : cB;
        for (int t = 0; t < nt; t += 2) {
            const bool last = (t == nt - 2);
            const char* a1 = cA + (size_t)(t + 1) * kstep;
            const char* a2 = last ? nA : cA + (size_t)(t + 2) * kstep; const char* b2 = last ? nB : cB + (size_t)(t + 2) * kstep;
            const char* a3 = a2 + kstep; const char* b3 = b2 + kstep;
            PG8_LDB(B0, 0, 0); PG8_SCHED; PG8_LDA(At, 0, 0); PG8_STAGE(PG8_SA(1, 1), a1 + hstepA, voffA);
            PG8_WAIT_L(8); PG8_BAR; PG8_WAIT_L(0); PG8_MMA(0, 0, At, B0); PG8_BAR; PG8_SCHED;
            PG8_LDB(B1, 0, 1); PG8_STAGE(PG8_SB(0, 0), b2, voffB);
            PG8_BAR; PG8_WAIT_L(0); PG8_MMA(0, 1, At, B1); PG8_BAR;
            PG8_LDA(At, 0, 1); PG8_STAGE(PG8_SA(0, 0), a2, voffA);
            PG8_BAR; PG8_WAIT_L(0); PG8_MMA(1, 0, At, B0); PG8_BAR; PG8_SCHED;
            PG8_STAGE(PG8_SB(0, 1), b2 + hstepB, voffB);
            PG8_WAIT_V(6); PG8_BAR; PG8_MMA(1, 1, At, B1); PG8_BAR;
            PG8_LDB(B0, 1, 0); PG8_SCHED; PG8_LDA(At, 1, 0); PG8_STAGE(PG8_SA(0, 1), a2 + hstepA, voffA);
            PG8_WAIT_L(8); PG8_BAR; PG8_WAIT_L(0); PG8_MMA(0, 0, At, B0); PG8_BAR; PG8_SCHED;
            PG8_LDB(B1, 1, 1); PG8_STAGE(PG8_SB(1, 0), b3, voffB);
            PG8_BAR; PG8_WAIT_L(0); PG8_MMA(0, 1, At, B1); PG8_BAR;
            PG8_LDA(At, 1, 1); PG8_STAGE(PG8_SA(1, 0), a3, voffA);
            PG8_BAR; PG8_WAIT_L(0); PG8_MMA(1, 0, At, B0); PG8_BAR; PG8_SCHED;
            PG8_STAGE(PG8_SB(1, 1), b3 + hstepB, voffB);
            PG8_WAIT_V(6); PG8_BAR; PG8_MMA(1, 1, At, B1); PG8_BAR;
            if constexpr (Epi::RESCALE) { if (((t + 2) & 7) == 0 && t + 2 < nt) E.mid(acc, (const LAS float*)(lds + STAGE_BYTES) + (ui & 1) * 1024, ((t + 2) >> 3) - 1, wr, fr); }
        }
        if constexpr (Epi::RESCALE) E.fin(acc, (const LAS float*)(lds + STAGE_BYTES) + (ui & 1) * 1024, cur, wr, wc, fr, fq); else E(acc, cur, wr, wc, fr, fq);
        if (!has_next) break;
#pragma unroll
        for (int a = 0; a < 2; ++a)
#pragma unroll
            for (int b = 0; b < 2; ++b)
#pragma unroll
                for (int m = 0; m < 4; ++m)
#pragma unroll
                    for (int n = 0; n < 2; ++n) acc[a][b][m][n] = (f32x4){0.f, 0.f, 0.f, 0.f};
        cur = nxt; cA = nA; cB = nB; ++ui;
    }
    PG8_WAIT_V(0);
    if (wr == 0) PG8_BAR;
    PG8_BAR;
#undef PG8_SA
#undef PG8_SB
#undef PG8_STAGE
#undef PG8_LDA
#undef PG8_LDB
#undef PG8_MMA
#undef PG8_WAIT_V
#undef PG8_WAIT_L
#undef PG8_BAR
#undef PG8_SCHED
}
}
using pg8::Unit;

__device__ __forceinline__ u32x4 pack8(const float (&v)[8]) { return (u32x4){pk_bf16(v[0], v[1]), pk_bf16(v[2], v[3]), pk_bf16(v[4], v[5]), pk_bf16(v[6], v[7])}; }
__device__ __forceinline__ void unpack8(const u32x4 u, float (&v)[8]) {
#pragma unroll
    for (int q = 0; q < 4; ++q) { v[2 * q] = bf_lo(u[q]); v[2 * q + 1] = bf_hi(u[q]); }
}

struct EpiIn {
    static constexpr bool RESCALE = false;
    bf16_t* Z; const float* r1; float* ssv; const float* b_gate; int rowbase;
    __device__ __forceinline__ void operator()(const f32x4 (&acc)[2][2][4][2], const Unit& u, int wr, int wc, int fr, int fq) const {
        const int pn = u.pn, lane = fr + 16 * fq;
        const int kind = pn < 4 ? 0 : pn < 8 ? 1 : pn < 12 ? 2 : pn < 16 ? 3 : pn < 24 ? 4 : pn < 32 ? 5 : 6;
        const int row0 = u.pm * 256 + wr * 64 + fr, col0 = pn * 256 + wc * 32 + 8 * fq;
        if (kind == 2 || kind == 3) {
            const float ksc = kind == 3 ? 0.0625f : 1.f;
            float inv8[8];
#pragma unroll
            for (int e = 0; e < 8; ++e) inv8[e] = fexp2(-(float)(wc * 32 + 8 * fq + e) * (13.287712379549449f / 127.f)) * 0.15915494309189535f;
#pragma unroll
            for (int ai = 0; ai < 2; ++ai)
#pragma unroll
                for (int m = 0; m < 4; ++m) {
                    const int row = row0 + ai * 128 + m * 16, gr = rowbase + row;
                    const float pos = (float)(gr < 16384 ? (gr & 2047) : (gr < 16640 ? 1024 + ((gr - 16384) & 15) : ((gr - 16640) & 2047)));
                    float v0[8], v1[8], o0[8], o1[8];
#pragma unroll
                    for (int e = 0; e < 4; ++e) { v0[e] = acc[ai][0][m][0][e]; v0[4 + e] = acc[ai][0][m][1][e]; v1[e] = acc[ai][1][m][0][e]; v1[4 + e] = acc[ai][1][m][1][e]; }
#pragma unroll
                    for (int e = 0; e < 8; e += 2) {
                        const float t0 = __builtin_amdgcn_fractf(pos * inv8[e]), t1 = __builtin_amdgcn_fractf(pos * inv8[e + 1]);
                        const f32x2 sn = (f32x2){__builtin_amdgcn_sinf(t0), __builtin_amdgcn_sinf(t1)}, cs = (f32x2){__builtin_amdgcn_cosf(t0), __builtin_amdgcn_cosf(t1)};
                        const f32x2 a = (f32x2){v0[e], v0[e + 1]} * ksc, b = (f32x2){v1[e], v1[e + 1]} * ksc;
                        const f32x2 r0 = a * cs - b * sn, r1 = a * sn + b * cs;
                        o0[e] = r0[0]; o0[e + 1] = r0[1]; o1[e] = r1[0]; o1[e + 1] = r1[1];
                    }
                    *(u32x4*)(Z + (size_t)row * INC + col0) = pack8(o0); *(u32x4*)(Z + (size_t)row * INC + col0 + 128) = pack8(o1);
                }
            return;
        }
#pragma unroll
        for (int ai = 0; ai < 2; ++ai)
#pragma unroll
            for (int m = 0; m < 4; ++m) {
                const int row = row0 + ai * 128 + m * 16; float ss = 0.f;
#pragma unroll
                for (int bj = 0; bj < 2; ++bj) {
                    const int col = col0 + bj * 128; float v[8];
#pragma unroll
                    for (int e = 0; e < 4; ++e) { v[e] = acc[ai][bj][m][0][e]; v[4 + e] = acc[ai][bj][m][1][e]; }
                    if (kind == 0 || kind == 1) {
#pragma unroll
                        for (int e = 0; e < 4; ++e) { const f32x2 gq = gelu_t2((f32x2){v[2 * e], v[2 * e + 1]}); v[2 * e] = gq[0]; v[2 * e + 1] = gq[1]; }
                        if (kind == 1) {
#pragma unroll
                            for (int e = 0; e < 8; ++e) ss += v[e] * v[e];
                        }
                    } else if (kind == 3) {
#pragma unroll
                        for (int e = 0; e < 8; ++e) v[e] *= 0.0625f;
                    } else if (kind == 5) {
#pragma unroll
                        for (int e = 0; e < 4; ++e) { const f32x2 xx = (f32x2){v[2 * e], v[2 * e + 1]}, q2 = xx * sigm2(xx); v[2 * e] = q2[0]; v[2 * e + 1] = q2[1]; }
                    } else if (kind == 6) {
                        const f32x4 b0 = *(const f32x4*)(b_gate + col - 8192), b1 = *(const f32x4*)(b_gate + col - 8192 + 4);
                        const float bb[8] = {b0[0], b0[1], b0[2], b0[3], b1[0], b1[1], b1[2], b1[3]};
#pragma unroll
                        for (int e = 0; e < 4; ++e) { const f32x2 q2 = sigm2((f32x2){v[2 * e] + bb[2 * e], v[2 * e + 1] + bb[2 * e + 1]}); v[2 * e] = q2[0]; v[2 * e + 1] = q2[1]; }
                    }
                    *(u32x4*)(Z + (size_t)row * INC + col) = pack8(v);
                }
                if (kind == 1) { ss += shx(ss, 16, lane); ss += shx(ss, 32, lane); if (fq == 0) atomicAdd(ssv + rowbase + row, ss); }
            }
    }
};
struct EpiT1 {
    static constexpr bool RESCALE = false;
    bf16_t* T1; const bf16_t* Z;
    __device__ __forceinline__ void operator()(const f32x4 (&acc)[2][2][4][2], const Unit& u, int wr, int wc, int fr, int fq) const {
        const int row0 = u.pm * 256 + wr * 64 + fr, col0 = u.pn * 256 + wc * 32 + 8 * fq;
#pragma unroll
        for (int ai = 0; ai < 2; ++ai)
#pragma unroll
            for (int m = 0; m < 4; ++m) {
                const int row = row0 + ai * 128 + m * 16;
#pragma unroll
                for (int bj = 0; bj < 2; ++bj) {
                    const int col = col0 + bj * 128; float v[8], gt[8];
                    unpack8(*(const u32x4*)(Z + (size_t)row * INC + 8192 + col), gt);
#pragma unroll
                    for (int e = 0; e < 4; ++e) { v[e] = acc[ai][bj][m][0][e] * gt[e]; v[4 + e] = acc[ai][bj][m][1][e] * gt[4 + e]; }
                    *(u32x4*)(T1 + (size_t)row * 1024 + col) = pack8(v);
                }
            }
    }
};
struct EpiM1 {
    static constexpr bool RESCALE = true;
    const bf16_t* T1; const bf16_t* Z; bf16_t* M1; int rowbase; const float* sso;
    __device__ __forceinline__ void prep(LAS float* tab, const Unit& u, int tid) const {
        if (tid < 256) {
            const f32x4 sv = *(const f32x4*)(sso + (size_t)(rowbase + u.pm * 256 + tid) * 4);
            const float c0 = sv[0] * (1.f / 512.f) + EPS, c1 = sv[1] * (1.f / 512.f) + EPS, c2 = sv[2] * (1.f / 512.f) + EPS, c3 = sv[3] * (1.f / 512.f) + EPS;
            *(LAS f32x4*)(tab + tid * 4) = (f32x4){__builtin_sqrtf(c1 * frcp(c0)), __builtin_sqrtf(c2 * frcp(c1)), __builtin_sqrtf(c3 * frcp(c2)), rsq(c3)};
        }
    }
    __device__ __forceinline__ void mid(f32x4 (&acc)[2][2][4][2], const LAS float* tab, int seg, int wr, int fr) const {
#pragma unroll
        for (int ai = 0; ai < 2; ++ai)
#pragma unroll
            for (int m = 0; m < 4; ++m) {
                const float f = tab[(ai * 128 + wr * 64 + m * 16 + fr) * 4 + seg];
#pragma unroll
                for (int bj = 0; bj < 2; ++bj)
#pragma unroll
                    for (int n = 0; n < 2; ++n) acc[ai][bj][m][n] = acc[ai][bj][m][n] * f;
            }
    }
    __device__ __forceinline__ void operator()(const f32x4 (&acc)[2][2][4][2], const Unit& u, int wr, int wc, int fr, int fq) const {}
    __device__ __forceinline__ void fin(const f32x4 (&acc)[2][2][4][2], const LAS float* tab, const Unit& u, int wr, int wc, int fr, int fq) const {
        const int row0 = u.pm * 256 + wr * 64 + fr, col0 = u.pn * 256 + wc * 32 + 8 * fq;
#pragma unroll
        for (int ai = 0; ai < 2; ++ai)
#pragma unroll
            for (int m = 0; m < 4; ++m) {
                const int row = row0 + ai * 128 + m * 16; const float rn3 = tab[(ai * 128 + wr * 64 + m * 16 + fr) * 4 + 3];
#pragma unroll
                for (int bj = 0; bj < 2; ++bj) {
                    const int col = col0 + bj * 128; float v[8], gt[8], t1[8];
                    unpack8(*(const u32x4*)(Z + (size_t)row * INC + 9216 + col), gt);
                    unpack8(*(const u32x4*)(T1 + (size_t)row * 1024 + col), t1);
#pragma unroll
                    for (int e = 0; e < 4; ++e) { v[e] = t1[e] + acc[ai][bj][m][0][e] * rn3 * gt[e]; v[4 + e] = t1[4 + e] + acc[ai][bj][m][1][e] * rn3 * gt[4 + e]; }
                    *(u32x4*)(M1 + (size_t)(rowbase + row) * 1024 + col) = pack8(v);
                }
            }
    }
};
struct EpiX2 {
    static constexpr bool RESCALE = false;
    const float* xp; const float* xs; float* out; bf16_t* X2b; float* ss2;
    __device__ __forceinline__ void operator()(const f32x4 (&acc)[2][2][4][2], const Unit& u, int wr, int wc, int fr, int fq) const {
        const int row0 = u.pm * 256 + wr * 64 + fr, col0 = u.pn * 256 + wc * 32 + 8 * fq, lane = fr + 16 * fq;
#pragma unroll
        for (int ai = 0; ai < 2; ++ai)
#pragma unroll
            for (int m = 0; m < 4; ++m) {
                const int row = row0 + ai * 128 + m * 16;
                const float* xr = row < 16384 ? xp + (size_t)row * 1024 : (row < 16640 ? xs + (size_t)(row - 16384) * 1024 : xp + (size_t)(row - 256) * 1024);
                float* yr = row < 16384 ? out + O_YP + (size_t)row * 1024 : (row < 16640 ? out + O_YS + (size_t)(row - 16384) * 1024 : out + O_YP + (size_t)(row - 256) * 1024);
                float ss = 0.f;
#pragma unroll
                for (int bj = 0; bj < 2; ++bj) {
                    const int col = col0 + bj * 128; float v[8];
                    const f32x4 x0 = *(const f32x4*)(xr + col), x1 = *(const f32x4*)(xr + col + 4);
#pragma unroll
                    for (int e = 0; e < 4; ++e) { v[e] = acc[ai][bj][m][0][e] + x0[e]; v[4 + e] = acc[ai][bj][m][1][e] + x1[e]; }
#pragma unroll
                    for (int e = 0; e < 8; ++e) ss += v[e] * v[e];
                    *(f32x4*)(yr + col) = (f32x4){v[0], v[1], v[2], v[3]}; *(f32x4*)(yr + col + 4) = (f32x4){v[4], v[5], v[6], v[7]};
                    *(u32x4*)(X2b + (size_t)row * 1024 + col) = pack8(v);
                }
                ss += shx(ss, 16, lane); ss += shx(ss, 32, lane); if (fq == 0) atomicAdd(ss2 + row, ss);
            }
    }
};
struct EpiQP {
    static constexpr bool RESCALE = false;
    bf16_t* QP; const float* ss2;
    __device__ __forceinline__ void operator()(const f32x4 (&acc)[2][2][4][2], const Unit& u, int wr, int wc, int fr, int fq) const {
        const int row0 = u.pm * 256 + wr * 64 + fr, col0 = u.pn * 256 + wc * 32 + 8 * fq;
#pragma unroll
        for (int ai = 0; ai < 2; ++ai)
#pragma unroll
            for (int m = 0; m < 4; ++m) {
                const int row = row0 + ai * 128 + m * 16; const float rs = rsq(ss2[row] * (1.f / 1024.f) + EPS);
#pragma unroll
                for (int bj = 0; bj < 2; ++bj) {
                    const int col = col0 + bj * 128; float v[8];
#pragma unroll
                    for (int e = 0; e < 4; ++e) { v[e] = acc[ai][bj][m][0][e] * rs; v[4 + e] = acc[ai][bj][m][1][e] * rs; }
                    *(u32x4*)(QP + (size_t)row * 2048 + col) = pack8(v);
                }
            }
    }
};

__device__ __forceinline__ void convert_item(const Params& p, unsigned char* ws, size_t i) {
        const int d = (int)((i * 16) & 1023);
        unsigned ou[4], ov[4];
#pragma unroll
        for (int q = 0; q < 4; ++q) {
            const f32x4 a = *(const f32x4*)(p.eu + i * 16 + q * 4), g0 = *(const f32x4*)(p.g_ffn + d + q * 4), c = *(const f32x4*)(p.ev + i * 16 + q * 4);
            int u = __builtin_amdgcn_cvt_pk_fp8_f32(a[0] * g0[0] * EU_SCALE, a[1] * g0[1] * EU_SCALE, 0, false);
            u = __builtin_amdgcn_cvt_pk_fp8_f32(a[2] * g0[2] * EU_SCALE, a[3] * g0[3] * EU_SCALE, u, true);
            int v = __builtin_amdgcn_cvt_pk_fp8_f32(c[0] * EV_SCALE, c[1] * EV_SCALE, 0, false);
            v = __builtin_amdgcn_cvt_pk_fp8_f32(c[2] * EV_SCALE, c[3] * EV_SCALE, v, true);
            ou[q] = (unsigned)u; ov[q] = (unsigned)v;
        }
        *(u32x4*)(ws + OFF_EU + (i >> 6) * 2048 + (i & 63) * 16) = (u32x4){ou[0], ou[1], ou[2], ou[3]};
        *(u32x4*)(ws + OFF_EU + (i >> 6) * 2048 + 1024 + (i & 63) * 16) = (u32x4){ov[0], ov[1], ov[2], ov[3]};
    }
constexpr size_t CONV_ITEMS = (size_t)16384 * 64;

__device__ __forceinline__ void transpose_tile(const Ctx& cx, const float* src, bf16_t* dst, const float* scale, int K, int N, int tile, LAS float* tl) {
    const int tn = N / 64, k0 = (tile / tn) * 64, n0 = (tile % tn) * 64, tid = cx.tid;
    const int n4 = (tid & 15) * 4, kr = tid >> 4;
#pragma unroll
    for (int i = 0; i < 2; ++i) {
        const int kk = kr + 32 * i; f32x4 v = *(const f32x4*)(src + (size_t)(k0 + kk) * N + n0 + n4);
        if (scale) v = v * scale[k0 + kk];
        tl[kk * 65 + n4] = v[0]; tl[kk * 65 + n4 + 1] = v[1]; tl[kk * 65 + n4 + 2] = v[2]; tl[kk * 65 + n4 + 3] = v[3];
    }
    __syncthreads();
    const int n = tid >> 3, kc = (tid & 7) * 8; float o[8];
#pragma unroll
    for (int e = 0; e < 8; ++e) o[e] = tl[(kc + e) * 65 + n];
    *(u32x4*)(dst + (size_t)(n0 + n) * K + k0 + kc) = pack8(o);
    __syncthreads();
}
__device__ __forceinline__ void phase0(const Ctx& cx, const Params& p, LAS unsigned char* lds) {
    unsigned char* ws = p.ws; LAS float* tl = (LAS float*)lds;
    for (int j = cx.bid; j < 4096; j += cx.nb) {
        if (j < 2560) transpose_tile(cx, p.w_in, (bf16_t*)(ws + OFF_WIN), p.g_mix, 1024, 10240, j, tl);
        else if (j < 2816) transpose_tile(cx, p.w_pa, (bf16_t*)(ws + OFF_WA), nullptr, 1024, 1024, j - 2560, tl);
        else if (j < 3328) transpose_tile(cx, p.w_pb, (bf16_t*)(ws + OFF_WB), nullptr, 2048, 1024, j - 2816, tl);
        else if (j < 3584) transpose_tile(cx, p.w_out, (bf16_t*)(ws + OFF_WO), nullptr, 1024, 1024, j - 3328, tl);
        else transpose_tile(cx, p.w_q, (bf16_t*)(ws + OFF_WQ), p.g_ffn, 1024, 2048, j - 3584, tl);
    }
    const size_t gtid = (size_t)cx.bid * 512 + cx.tid, nth = (size_t)cx.nb * 512;
    for (size_t i = gtid; i < 16384; i += nth) { ((bf16_t*)(ws + OFF_K1))[i] = f2bf(p.k1[i]); ((bf16_t*)(ws + OFF_K2))[i] = f2bf(p.k2[i]); }
    for (size_t i = gtid; i < (size_t)NTOK * 6; i += nth) ((float*)(ws + OFF_SSV))[i] = 0.f;
    const int wid = __builtin_amdgcn_readfirstlane(cx.tid >> 6), lane = cx.tid & 63;
    bf16_t* xb = (bf16_t*)((unsigned char*)p.out + OUT_XB);
    for (int r = cx.bid * 8 + wid; r < NTOK; r += cx.nb * 8) {
        const float* xr = xrow(p, r); f32x4 v[4]; float ss = 0.f;
#pragma unroll
        for (int j = 0; j < 4; ++j) { v[j] = *(const f32x4*)(xr + lane * 8 + (j >> 1) * 512 + (j & 1) * 4); ss += v[j][0] * v[j][0] + v[j][1] * v[j][1] + v[j][2] * v[j][2] + v[j][3] * v[j][3]; }
        ss = wave_sum(ss, lane);
        const float rs = rsq(ss * (1.f / 1024.f) + EPS);
#pragma unroll
        for (int j = 0; j < 2; ++j)
            *(u32x4*)(xb + (size_t)r * 1024 + lane * 8 + j * 512) = (u32x4){pk_bf16(v[2 * j][0] * rs, v[2 * j][1] * rs), pk_bf16(v[2 * j][2] * rs, v[2 * j][3] * rs),
                                                                          pk_bf16(v[2 * j + 1][0] * rs, v[2 * j + 1][1] * rs), pk_bf16(v[2 * j + 1][2] * rs, v[2 * j + 1][3] * rs)};
    }
}

__device__ __forceinline__ void retention_unit(const Ctx& cx, LAS unsigned char* lds, bf16_t* Z, int zrow0, int grow0, int nchunks, int Lc, int pos0, int h, int slice,
                               const float* s0, float* s_out, float* sso) {
    LAS bf16_t* Qs = (LAS bf16_t*)lds; LAS bf16_t* Ks = (LAS bf16_t*)(lds + 33792); LAS bf16_t* ST = (LAS bf16_t*)(lds + 67584);
    LAS bf16_t* VT = (LAS bf16_t*)(lds + 101376); LAS bf16_t* Ps = (LAS bf16_t*)(lds + 110592);
    const int tid = cx.tid, wid = __builtin_amdgcn_readfirstlane(tid >> 6), lane = tid & 63, fr = lane & 15, fq = lane >> 4;
    const float l2g = log2f(1.f - exp2f(-5.f - (float)h));
    f32x4 accS[2][4];
#pragma unroll
    for (int dt = 0; dt < 2; ++dt)
#pragma unroll
        for (int dvt = 0; dvt < 4; ++dvt) {
#pragma unroll
            for (int j = 0; j < 4; ++j) { const int d = (2 * wid + dt) * 16 + fq * 4 + j; accS[dt][dvt][j] = s0 ? s0[(size_t)d * 512 + slice * 64 + dvt * 16 + fr] : 0.f; }
            *(LAS u32x2*)(ST + (dvt * 16 + fr) * 264 + (2 * wid + dt) * 16 + fq * 4) = (u32x2){pk_bf16(accS[dt][dvt][0], accS[dt][dvt][1]), pk_bf16(accS[dt][dvt][2], accS[dt][dvt][3])};
        }
    const float sdec = fexp2(l2g * (float)Lc);
    __syncthreads();
    u32x4 rq1[2], rq2[2], rk1[2], rk2[2], rv; u32x2 rsg[2];
    const int vm = tid >> 3, vc0 = (tid & 7) * 8;
    auto fetch = [&](int c) {
        const size_t zr = (size_t)(zrow0 + c * 64);
#pragma unroll
        for (int it = 0; it < 2; ++it) {
            const int item = tid + 512 * it, n = item >> 4, dc = (item & 15) * 8;
            rq1[it] = (u32x4){0, 0, 0, 0}; rq2[it] = rq1[it]; rk1[it] = rq1[it]; rk2[it] = rq1[it];
            if (n < Lc) {
                const bf16_t* zp = Z + (zr + n) * INC + 2048 + h * 256 + dc;
                rq1[it] = *(const u32x4*)zp; rq2[it] = *(const u32x4*)(zp + 128); rk1[it] = *(const u32x4*)(zp + 1024); rk2[it] = *(const u32x4*)(zp + 1152);
            }
        }
        rv = (u32x4){0, 0, 0, 0};
        if (vm < Lc) rv = *(const u32x4*)(Z + (zr + vm) * INC + 4096 + h * 512 + slice * 64 + vc0);
#pragma unroll
        for (int i = 0; i < 2; ++i) {
            rsg[i] = (u32x2){0, 0};
            const int n = (wid >> 1) * 16 + fr;
            if (n < Lc) rsg[i] = *(const u32x2*)(Z + (zr + n) * INC + 6144 + h * 512 + slice * 64 + (2 * (wid & 1) + i) * 16 + fq * 4);
        }
    };
    fetch(0);
    for (int c = 0; c < nchunks; ++c) {
        const size_t zr = (size_t)(zrow0 + c * 64);
#pragma unroll
        for (int it = 0; it < 2; ++it) {
            const int item = tid + 512 * it, n = item >> 4, dc = (item & 15) * 8;
            *(LAS u32x4*)(Qs + n * 264 + dc) = rq1[it]; *(LAS u32x4*)(Qs + n * 264 + 128 + dc) = rq2[it];
            *(LAS u32x4*)(Ks + n * 264 + dc) = rk1[it]; *(LAS u32x4*)(Ks + n * 264 + 128 + dc) = rk2[it];
        }
        {
            float v[8]; unpack8(rv, v);
            const float kd = fexp2(l2g * (float)(Lc - 1 - vm));
#pragma unroll
            for (int e = 0; e < 8; ++e) v[e] *= kd;
            *(LAS u32x4*)(VT + vm * 72 + vc0) = pack8(v);
        }
        __syncthreads();
        u32x2 sgc[2] = {rsg[0], rsg[1]};
        if (c + 1 < nchunks) fetch(c + 1);
        const int nt = wid >> 1;
#pragma unroll
        for (int mi = 0; mi < 2; ++mi) {
            const int mt = 2 * (wid & 1) + mi; f32x4 acc = (f32x4){0.f, 0.f, 0.f, 0.f};
            if (mt <= nt) {
#pragma unroll
                for (int ks = 0; ks < 8; ++ks) {
                    const bf16x8 a = *(const LAS bf16x8*)(Qs + (nt * 16 + fr) * 264 + ks * 32 + fq * 8), b = *(const LAS bf16x8*)(Ks + (mt * 16 + fr) * 264 + ks * 32 + fq * 8);
                    acc = MFMA16(a, b, acc);
                }
            }
#pragma unroll
            for (int j = 0; j < 4; ++j) {
                const int n = nt * 16 + fq * 4 + j, m = mt * 16 + fr;
                const float val = (m <= n) ? acc[j] * fexp2(l2g * (float)(n - (Lc - 1))) : 0.f;
                Ps[n * 72 + m] = f2bf(val);
            }
        }
        f32x4 accO[2];
#pragma unroll
        for (int i = 0; i < 2; ++i) {
            const int dvt = 2 * (wid & 1) + i; accO[i] = (f32x4){0.f, 0.f, 0.f, 0.f};
#pragma unroll
            for (int ks = 0; ks < 8; ++ks) {
                const bf16x8 a = *(const LAS bf16x8*)(ST + (dvt * 16 + fr) * 264 + ks * 32 + fq * 8), b = *(const LAS bf16x8*)(Qs + (nt * 16 + fr) * 264 + ks * 32 + fq * 8);
                accO[i] = MFMA16(a, b, accO[i]);
            }
            const float qd = fexp2(l2g * (float)(nt * 16 + fr + 1));
            accO[i] = accO[i] * qd;
        }
        __syncthreads();
#pragma unroll
        for (int i = 0; i < 2; ++i) {
            const int dvt = 2 * (wid & 1) + i;
#pragma unroll
            for (int ks = 0; ks < 2; ++ks) {
                const bf16x8 a = tr_frag(VT + ks * 32 * 72 + dvt * 16, 72, lane), b = *(const LAS bf16x8*)(Ps + (nt * 16 + fr) * 72 + ks * 32 + fq * 8);
                accO[i] = MFMA16(a, b, accO[i]);
            }
        }
#pragma unroll
        for (int dt = 0; dt < 2; ++dt)
#pragma unroll
            for (int dvt = 0; dvt < 4; ++dvt) accS[dt][dvt] = accS[dt][dvt] * sdec;
#pragma unroll
        for (int ks = 0; ks < 2; ++ks) {
            bf16x8 bv[4];
#pragma unroll
            for (int dvt = 0; dvt < 4; ++dvt) bv[dvt] = tr_frag(VT + ks * 32 * 72 + dvt * 16, 72, lane);
#pragma unroll
            for (int dt = 0; dt < 2; ++dt) {
                const bf16x8 a = tr_frag(Ks + ks * 32 * 264 + (2 * wid + dt) * 16, 264, lane);
#pragma unroll
                for (int dvt = 0; dvt < 4; ++dvt) accS[dt][dvt] = MFMA16(a, bv[dvt], accS[dt][dvt]);
            }
        }
#pragma unroll
        for (int dt = 0; dt < 2; ++dt)
#pragma unroll
            for (int dvt = 0; dvt < 4; ++dvt)
                *(LAS u32x2*)(ST + (dvt * 16 + fr) * 264 + (2 * wid + dt) * 16 + fq * 4) = (u32x2){pk_bf16(accS[dt][dvt][0], accS[dt][dvt][1]), pk_bf16(accS[dt][dvt][2], accS[dt][dvt][3])};
        {
            float ss = 0.f; const int n = nt * 16 + fr;
#pragma unroll
            for (int i = 0; i < 2; ++i) {
                const int dvt = 2 * (wid & 1) + i;
                ss += accO[i][0] * accO[i][0] + accO[i][1] * accO[i][1] + accO[i][2] * accO[i][2] + accO[i][3] * accO[i][3];
                if (n < Lc) *(u32x2*)(Z + (zr + n) * INC + 4096 + h * 512 + slice * 64 + dvt * 16 + fq * 4) =
                    (u32x2){pk_bf16(accO[i][0] * bf_lo(sgc[i][0]), accO[i][1] * bf_hi(sgc[i][0])), pk_bf16(accO[i][2] * bf_lo(sgc[i][1]), accO[i][3] * bf_hi(sgc[i][1]))};
            }
            ss += shx(ss, 16, lane); ss += shx(ss, 32, lane);
            if (fq == 0 && n < Lc) atomicAdd(sso + (size_t)(grow0 + c * 64 + n) * 4 + h, ss);
        }
        __syncthreads();
    }
#pragma unroll
    for (int dt = 0; dt < 2; ++dt)
#pragma unroll
        for (int dvt = 0; dvt < 4; ++dvt)
#pragma unroll
            for (int j = 0; j < 4; ++j) { const int d = (2 * wid + dt) * 16 + fq * 4 + j; s_out[(size_t)d * 512 + slice * 64 + dvt * 16 + fr] = accS[dt][dvt][j]; }
}

__device__ __forceinline__ void sgu_unit(const Ctx& cx, const Params& p, LAS unsigned char* lds, bf16_t* Z, int zrow0, int grow0, int rows, int g, float* vout, const float* ssv, bool load_w) {
    LAS bf16_t* WS = (LAS bf16_t*)lds; LAS bf16_t* VT = (LAS bf16_t*)(lds + 34816);
    const int tid = cx.tid, wid = __builtin_amdgcn_readfirstlane(tid >> 6), lane = tid & 63, fr = lane & 15, fq = lane >> 4;
    if (load_w)
#pragma unroll
    for (int it = 0; it < 4; ++it) {
        const int item = tid + 512 * it, n = item >> 4, m0 = (item & 15) * 8;
        const float* src = p.w_s + ((size_t)g * 128 + n) * 128 + m0;
        const f32x4 a = *(const f32x4*)src, b = *(const f32x4*)(src + 4); float v[8];
#pragma unroll
        for (int e = 0; e < 4; ++e) { v[e] = (m0 + e <= n) ? a[e] : 0.f; v[4 + e] = (m0 + 4 + e <= n) ? b[e] : 0.f; }
        *(LAS u32x4*)(WS + n * 136 + m0) = pack8(v);
    }
#pragma unroll
    for (int it = 0; it < 4; ++it) {
        const int item = tid + 512 * it, m = item >> 4, d0 = (item & 15) * 8; float v[8];
#pragma unroll
        for (int e = 0; e < 8; ++e) v[e] = 0.f;
        if (m < rows) {
            unpack8(*(const u32x4*)(Z + (size_t)(zrow0 + m) * INC + 1024 + g * 128 + d0), v);
            const float rs = rsq(ssv[grow0 + m] * (1.f / 1024.f) + EPS);
            const f32x4 g0 = *(const f32x4*)(p.g_sgu + g * 128 + d0), g1 = *(const f32x4*)(p.g_sgu + g * 128 + d0 + 4);
#pragma unroll
            for (int e = 0; e < 4; ++e) { v[e] *= rs * g0[e]; v[4 + e] *= rs * g1[e]; }
            if (vout) { *(f32x4*)(vout + (size_t)m * 1024 + g * 128 + d0) = (f32x4){v[0], v[1], v[2], v[3]}; *(f32x4*)(vout + (size_t)m * 1024 + g * 128 + d0 + 4) = (f32x4){v[4], v[5], v[6], v[7]}; }
        }
        *(LAS u32x4*)(VT + m * 136 + d0) = pack8(v);
    }
    u32x2 uu[8]; float bias = 0.f;
    if (wid * 16 < rows) {
        bias = p.b_s[g * 128 + wid * 16 + fr];
#pragma unroll
        for (int dt = 0; dt < 8; ++dt) uu[dt] = *(const u32x2*)(Z + (size_t)(zrow0 + wid * 16 + fr) * INC + g * 128 + dt * 16 + fq * 4);
    }
    __syncthreads();
    if (wid * 16 < rows) {
        const int nks = (wid >> 1) + 1;
        f32x4 acc[8];
#pragma unroll
        for (int dt = 0; dt < 8; ++dt) acc[dt] = (f32x4){0.f, 0.f, 0.f, 0.f};
        for (int ks = 0; ks < nks; ++ks) {
            const bf16x8 b = *(const LAS bf16x8*)(WS + (wid * 16 + fr) * 136 + ks * 32 + fq * 8);
#pragma unroll
            for (int dt = 0; dt < 8; ++dt) { const bf16x8 a = tr_frag(VT + ks * 32 * 136 + dt * 16, 136, lane); acc[dt] = MFMA16(a, b, acc[dt]); }
        }
        const int n = wid * 16 + fr;
#pragma unroll
        for (int dt = 0; dt < 8; ++dt) {
            bf16_t* up = Z + (size_t)(zrow0 + n) * INC + g * 128 + dt * 16 + fq * 4;
            *(u32x2*)up = (u32x2){pk_bf16(bf_lo(uu[dt][0]) * (acc[dt][0] + bias), bf_hi(uu[dt][0]) * (acc[dt][1] + bias)), pk_bf16(bf_lo(uu[dt][1]) * (acc[dt][2] + bias), bf_hi(uu[dt][1]) * (acc[dt][3] + bias))};
        }
    }
    __syncthreads();
}

__device__ __forceinline__ void phase2(const Ctx& cx, const Params& p, LAS unsigned char* lds, int hf) {
    unsigned char* ws = p.ws; bf16_t* Z = (bf16_t*)(ws + OFF_Z); float* sso = (float*)(ws + OFF_SSO); const float* ssv = (const float*)(ws + OFF_SSV);
    const int rowbase = hf ? NH0 : 0;
    for (int u = cx.bid; u < 256; u += cx.nb) {
        const int slice = u & 7, h = (u >> 3) & 3, bl = u >> 5, b = hf * 8 + bl;
        retention_unit(cx, lds, Z, bl * 2048, rowbase + bl * 2048, 32, 64, 0, h, slice, nullptr, p.out + O_SP + ((size_t)b * 4 + h) * 256 * 512, sso);
    }
    if (hf == 0) {
        for (int u = cx.bid; u < 512; u += cx.nb) {
            const int slice = u & 7, h = (u >> 3) & 3, b = u >> 5;
            retention_unit(cx, lds, Z, 16384 + b * 16, 16384 + b * 16, 1, 16, 1024, h, slice, p.state + ((size_t)b * 4 + h) * 256 * 512,
                           p.out + O_SS + ((size_t)b * 4 + h) * 256 * 512, sso);
        }
    }
    const int nprompt = 128 * 8, nsgu = nprompt + (hf == 0 ? 16 * 8 : 0);
    int last_g = -1;
    for (int u = cx.bid; u < nsgu; u += cx.nb) {
        if (u < nprompt) { const int g = u & 7, ci = u >> 3; sgu_unit(cx, p, lds, Z, ci * 128, rowbase + ci * 128, 128, g, nullptr, ssv, g != last_g); last_g = g; }
        else { const int v = u - nprompt, g = v & 7, b = v >> 3; sgu_unit(cx, p, lds, Z, 16384 + b * 16, 16384 + b * 16, 16, g, p.out + O_SV + (size_t)b * 16 * 1024, ssv, g != last_g); last_g = g; }
    }
}

#define CE_DESC(x, i, l) do { const float _a = fmaxf(x[i], x[l]), _b = fminf(x[i], x[l]); x[i] = _a; x[l] = _b; } while (0)
__device__ __forceinline__ void bitonic_sort16_desc(float (&x)[16]) {
#pragma unroll
    for (int k = 2; k <= 16; k <<= 1)
#pragma unroll
        for (int j = k >> 1; j > 0; j >>= 1)
#pragma unroll
            for (int i = 0; i < 16; ++i) {
                const int l = i ^ j;
                if (l > i) { if ((i & k) == 0 || k == 16) CE_DESC(x, i, l); else CE_DESC(x, l, i); }
            }
}
__device__ __forceinline__ void bitonic_merge16_desc(float (&x)[16]) {
#pragma unroll
    for (int j = 8; j > 0; j >>= 1)
#pragma unroll
        for (int i = 0; i < 16; ++i) { const int l = i ^ j; if (l > i) CE_DESC(x, i, l); }
}
#define TOPK_INS_FROM(L, x, S0) do { float _v = (x); _Pragma("unroll") for (int _i = (S0); _i < 16; ++_i) { const float _h = fmaxf(L[_i], _v); _v = fminf(L[_i], _v); L[_i] = _h; } } while (0)
__device__ __forceinline__ void phase7(const Ctx& cx, const Params& p, LAS unsigned char* lds) {
    unsigned char* ws = p.ws; const bf16_t* QP = (const bf16_t*)(ws + OFF_QP); int* ids = (int*)(ws + OFF_IDS); float* wts = (float*)(ws + OFF_WTS);
    LAS bf16_t* KEYS = (LAS bf16_t*)lds;
    LAS float* SC = (LAS float*)(lds + 69632);
    LAS float* TP = (LAS float*)(lds + 69632 + 67584);
    const int tid = cx.tid, wid = __builtin_amdgcn_readfirstlane(tid >> 6), lane = tid & 63, fr = lane & 15, fq = lane >> 4;
#pragma unroll
    for (int it = 0; it < 8; ++it) {
        const int idx = tid + 512 * it, tab = idx >> 11, row = (idx >> 4) & 127, c8 = (idx & 15) * 8;
        *(LAS u32x4*)(KEYS + tab * 17408 + row * 136 + c8) = *(const u32x4*)((const bf16_t*)(ws + (tab ? OFF_K2 : OFF_K1)) + row * 128 + c8);
    }
    bf16x8 a[2][4], an[2][4];
    auto load_a = [&](int tile, bf16x8 (&d)[2][4]) {
#pragma unroll
        for (int half = 0; half < 2; ++half)
#pragma unroll
            for (int ks = 0; ks < 4; ++ks) d[half][ks] = *(const bf16x8*)(QP + (size_t)(tile * 16 + fr) * 2048 + wid * 256 + half * 128 + ks * 32 + fq * 8);
    };
    if (cx.bid < NTOK / 16) load_a(cx.bid, an);
    __syncthreads();
    const size_t cv_end = CONV_ITEMS * (size_t)(cx.bid + 1) / (size_t)cx.nb; size_t cv_pos = CONV_ITEMS * (size_t)cx.bid / (size_t)cx.nb;
    for (int tile = cx.bid; tile < NTOK / 16; tile += cx.nb) {
        const int row0 = tile * 16;
#pragma unroll
        for (int half = 0; half < 2; ++half)
#pragma unroll
            for (int ks = 0; ks < 4; ++ks) a[half][ks] = an[half][ks];
        if (tile + cx.nb < NTOK / 16) load_a(tile + cx.nb, an);
#pragma unroll
        for (int half = 0; half < 2; ++half) {
#pragma unroll
            for (int nt = 0; nt < 8; ++nt) {
                f32x4 acc = (f32x4){0.f, 0.f, 0.f, 0.f};
#pragma unroll
                for (int ks = 0; ks < 4; ++ks) acc = MFMA16(a[half][ks], *(const LAS bf16x8*)(KEYS + half * 17408 + (nt * 16 + fr) * 136 + ks * 32 + fq * 8), acc);
#pragma unroll
                for (int j = 0; j < 4; ++j) {
                    const int t = fq * 4 + j, list = t * 8 + wid, n = nt * 16 + fr;
                    SC[list * 132 + ((n + 8 * fq) & 127)] = __uint_as_float((__float_as_uint(acc[j]) & ~127u) | (unsigned)n);
                }
            }
            __syncthreads();
            if (tid < 256) {
                const int list = tid >> 1, part = tid & 1; const LAS float* sp = SC + list * 132 + part * 64;
                float T[16];
#pragma unroll
                for (int i = 0; i < 4; ++i) { const f32x4 v = *(const LAS f32x4*)(sp + i * 4); T[4 * i] = v[0]; T[4 * i + 1] = v[1]; T[4 * i + 2] = v[2]; T[4 * i + 3] = v[3]; }
                bitonic_sort16_desc(T);
#pragma unroll 1
                for (int grp = 1; grp < 4; ++grp) {
                    float G[16];
#pragma unroll
                    for (int i = 0; i < 4; ++i) { const f32x4 v = *(const LAS f32x4*)(sp + grp * 16 + i * 4); G[4 * i] = v[0]; G[4 * i + 1] = v[1]; G[4 * i + 2] = v[2]; G[4 * i + 3] = v[3]; }
                    bitonic_sort16_desc(G);
#pragma unroll
                    for (int i = 0; i < 16; ++i) T[i] = fmaxf(T[i], G[15 - i]);
                    bitonic_merge16_desc(T);
                }
                float O[16];
#pragma unroll
                for (int i = 0; i < 16; ++i) O[i] = __int_as_float(__builtin_amdgcn_update_dpp(0, __float_as_int(T[i]), 0xB1, 0xF, 0xF, true));
#pragma unroll
                for (int i = 0; i < 16; ++i) T[i] = fmaxf(T[i], O[15 - i]);
                bitonic_merge16_desc(T);
                if (part == 0) {
#pragma unroll
                    for (int i = 0; i < 4; ++i) *(LAS f32x4*)(TP + (list * 2 + half) * 16 + i * 4) = (f32x4){T[4 * i], T[4 * i + 1], T[4 * i + 2], T[4 * i + 3]};
                }
            } else if (cv_pos + (size_t)(tid - 256) < cv_end) convert_item(p, ws, cv_pos + (size_t)(tid - 256));
            cv_pos += 256;
            __syncthreads();
        }
        if (tid < 128) {
            float v1[16], v2[16], L[16];
#pragma unroll
            for (int i = 0; i < 4; ++i) {
                const f32x4 va = *(const LAS f32x4*)(TP + (tid * 2) * 16 + i * 4), vb = *(const LAS f32x4*)(TP + (tid * 2 + 1) * 16 + i * 4);
#pragma unroll
                for (int e = 0; e < 4; ++e) { v1[4 * i + e] = va[e]; v2[4 * i + e] = vb[e]; }
            }
#pragma unroll
            for (int jj = 0; jj < 16; ++jj) { const float c = v1[0] + v2[jj]; L[jj] = __uint_as_float((__float_as_uint(c) & ~255u) | (unsigned)jj); }
#pragma unroll
            for (int i = 1; i < 16; ++i)
#pragma unroll
                for (int jj = 0; jj < 16; ++jj)
                    if ((i + 1) * (jj + 1) <= 16) { const float c = v1[i] + v2[jj]; TOPK_INS_FROM(L, __uint_as_float((__float_as_uint(c) & ~255u) | (unsigned)(i * 16 + jj)), (i + 1) * (jj + 1) - 1); }
            float ex[16], sum = 0.f;
#pragma unroll
            for (int k = 0; k < 16; ++k) { ex[k] = fexp2((L[k] - L[0]) * 1.44269504f); sum += ex[k]; }
            const float rinv = 1.f / sum;
#pragma unroll
            for (int k = 0; k < 16; ++k) {
                const unsigned code = __float_as_uint(L[k]) & 255u;
                const unsigned e1 = __float_as_uint(TP[(tid * 2) * 16 + (code >> 4)]) & 127u, e2 = __float_as_uint(TP[(tid * 2 + 1) * 16 + (code & 15u)]) & 127u;
                ((LAS int*)SC)[tid * 16 + k] = (int)(e1 * 128u + e2); SC[2048 + tid * 16 + k] = ex[k] * rinv;
            }
        }
        __syncthreads();
        *(u32x4*)(ids + (size_t)row0 * 128 + tid * 4) = *(const LAS u32x4*)((LAS int*)SC + tid * 4);
        *(f32x4*)(wts + (size_t)row0 * 128 + tid * 4) = *(const LAS f32x4*)(SC + 2048 + tid * 4);
        __syncthreads();
    }
    for (size_t it = cv_pos + tid; it < cv_end; it += 512) convert_item(p, ws, it);
}

__device__ __forceinline__ void phase8(const Ctx& cx, const Params& p, LAS unsigned char* lds) {
    unsigned char* ws = p.ws; const unsigned char* EU = ws + OFF_EU; const unsigned char* EV = ws + OFF_EV;
    const int* ids = (const int*)(ws + OFF_IDS); const float* wts = (const float*)(ws + OFF_WTS);
    const float* ss2 = (const float*)(ws + OFF_SS2);
    const int tid = cx.tid, wid = __builtin_amdgcn_readfirstlane(tid >> 6), lane = tid & 63, fr = lane & 15, fq = lane >> 4;
    const int nfull = (NTOK / (cx.nb * 8)) * (cx.nb * 8);
    const unsigned char* ET = ws + OFF_EU;
    int nid0 = 0, nid1 = 0; float nw0 = 0.f, nw1 = 0.f, nr2 = 0.f;
    auto fetch_ids = [&](int r, int& i0_, int& i1_, float& a0, float& a1, float& rr) {
        i0_ = ids[(size_t)r * 128 + lane] & 16383; i1_ = ids[(size_t)r * 128 + 64 + lane] & 16383;
        a0 = wts[(size_t)r * 128 + lane]; a1 = wts[(size_t)r * 128 + 64 + lane];
        rr = rsq(ss2[r] * (1.f / 1024.f) + EPS) * (1.f / EU_SCALE);
    };
    if (cx.bid * 8 + wid < nfull) fetch_ids(cx.bid * 8 + wid, nid0, nid1, nw0, nw1, nr2);
    for (int r = cx.bid * 8 + wid; r < nfull; r += cx.nb * 8) {
        const int id0 = nid0, id1 = nid1; const float w0 = nw0, w1 = nw1, r2 = nr2;
        float* yr = yrow(p, r);
        f32x2 tq[4][8];
#pragma unroll
        for (int j = 0; j < 4; ++j)
#pragma unroll
            for (int q = 0; q < 4; ++q) { const f32x4 v = *(const f32x4*)(yr + (fr + 16 * j) * 16 + q * 4); tq[j][2 * q] = (f32x2){v[0], v[1]}; tq[j][2 * q + 1] = (f32x2){v[2], v[3]}; }
        if (r + cx.nb * 8 < nfull) fetch_ids(r + cx.nb * 8, nid0, nid1, nw0, nw1, nr2);
        f32x2 acc[4][8];
#pragma unroll
        for (int j = 0; j < 4; ++j)
#pragma unroll
            for (int q = 0; q < 8; ++q) acc[j][q] = (f32x2){0.f, 0.f};
#pragma unroll 2
        for (int it = 0; it < 32; ++it) {
            const int src = ((it & 15) << 2) + fq;
            const int e = it < 16 ? shl_(id0, src) : shl_(id1, src);
            const float w = it < 16 ? shl_(w0, src) : shl_(w1, src);
            const unsigned char* rp = ET + (size_t)e * 2048 + fr * 16;
            u32x4 du[4], dv[4];
#pragma unroll
            for (int j = 0; j < 4; ++j) { du[j] = *(const u32x4*)(rp + j * 256); dv[j] = *(const u32x4*)(rp + 1024 + j * 256); }
            f32x2 s2 = (f32x2){0.f, 0.f};
#pragma unroll
            for (int j = 0; j < 4; ++j)
#pragma unroll
                for (int q = 0; q < 4; ++q) {
                    s2 = __builtin_amdgcn_cvt_pk_f32_fp8((int)du[j][q], false) * tq[j][2 * q] + s2;
                    s2 = __builtin_amdgcn_cvt_pk_f32_fp8((int)du[j][q], true) * tq[j][2 * q + 1] + s2;
                }
            const float sd = row16_sum(s2[0] + s2[1]);
            const float c = w * gelu_t(r2 * sd) * (1.f / EV_SCALE); const f32x2 cc = (f32x2){c, c};
#pragma unroll
            for (int j = 0; j < 4; ++j)
#pragma unroll
                for (int q = 0; q < 4; ++q) {
                    acc[j][2 * q] = __builtin_amdgcn_cvt_pk_f32_fp8((int)dv[j][q], false) * cc + acc[j][2 * q];
                    acc[j][2 * q + 1] = __builtin_amdgcn_cvt_pk_f32_fp8((int)dv[j][q], true) * cc + acc[j][2 * q + 1];
                }
        }
        float ss = 0.f;
#pragma unroll
        for (int j = 0; j < 4; ++j)
#pragma unroll
            for (int q = 0; q < 8; ++q)
#pragma unroll
                for (int h2 = 0; h2 < 2; ++h2) { float v = acc[j][q][h2]; v += shx(v, 16, lane); v += shx(v, 32, lane); acc[j][q][h2] = v; }
        if (fq == 0) {
#pragma unroll
            for (int j = 0; j < 4; ++j)
#pragma unroll
                for (int q = 0; q < 4; ++q) {
                    const f32x4 xv = *(const f32x4*)(yr + (fr + 16 * j) * 16 + q * 4);
                    acc[j][2 * q][0] += xv[0]; acc[j][2 * q][1] += xv[1]; acc[j][2 * q + 1][0] += xv[2]; acc[j][2 * q + 1][1] += xv[3];
                    ss += acc[j][2 * q][0] * acc[j][2 * q][0] + acc[j][2 * q][1] * acc[j][2 * q][1] + acc[j][2 * q + 1][0] * acc[j][2 * q + 1][0] + acc[j][2 * q + 1][1] * acc[j][2 * q + 1][1];
                }
        }
        ss = wave_sum(ss, lane);
        const float rs = rsq(ss * (1.f / 1024.f) + EPS);
        if (fq == 0) {
#pragma unroll
            for (int j = 0; j < 4; ++j)
#pragma unroll
                for (int q = 0; q < 4; ++q) {
                    const f32x4 g0 = *(const f32x4*)(p.g_final + (fr + 16 * j) * 16 + q * 4);
                    *(f32x4*)(yr + (fr + 16 * j) * 16 + q * 4) = (f32x4){acc[j][2 * q][0], acc[j][2 * q][1], acc[j][2 * q + 1][0], acc[j][2 * q + 1][1]} * rs * g0;
                }
        }
    }
    LAS float* cfb = (LAS float*)lds; LAS float* part = (LAS float*)(lds + 4096);
    __syncthreads();
    for (int r = nfull + cx.bid; r < NTOK; r += cx.nb) {
        const int id0 = ids[(size_t)r * 128 + lane] & 16383, id1 = ids[(size_t)r * 128 + 64 + lane] & 16383;
        const float w0 = wts[(size_t)r * 128 + lane], w1 = wts[(size_t)r * 128 + 64 + lane];
        const float r2 = rsq(ss2[r] * (1.f / 1024.f) + EPS) * (1.f / EU_SCALE);
        float* yr = yrow(p, r);
        f32x2 tq[4][8];
#pragma unroll
        for (int j = 0; j < 4; ++j)
#pragma unroll
            for (int q = 0; q < 4; ++q) { const f32x4 v = *(const f32x4*)(yr + (fr + 16 * j) * 16 + q * 4); tq[j][2 * q] = (f32x2){v[0], v[1]}; tq[j][2 * q + 1] = (f32x2){v[2], v[3]}; }
#pragma unroll
        for (int i4 = 0; i4 < 4; ++i4) {
            const int it = wid * 4 + i4, src = ((it & 15) << 2) + fq;
            const int e = it < 16 ? shl_(id0, src) : shl_(id1, src);
            const float w = it < 16 ? shl_(w0, src) : shl_(w1, src);
            const unsigned char* rp = ET + (size_t)e * 2048 + fr * 16;
            u32x4 d[4];
#pragma unroll
            for (int j = 0; j < 4; ++j) d[j] = *(const u32x4*)(rp + j * 256);
            f32x2 s2 = (f32x2){0.f, 0.f};
#pragma unroll
            for (int j = 0; j < 4; ++j)
#pragma unroll
                for (int q = 0; q < 4; ++q) {
                    s2 = __builtin_amdgcn_cvt_pk_f32_fp8((int)d[j][q], false) * tq[j][2 * q] + s2;
                    s2 = __builtin_amdgcn_cvt_pk_f32_fp8((int)d[j][q], true) * tq[j][2 * q + 1] + s2;
                }
            const float sd = row16_sum(s2[0] + s2[1]);
            if (fr == 0) cfb[it * 4 + fq] = w * gelu_t(r2 * sd) * (1.f / EV_SCALE);
        }
        __syncthreads();
        const float c0 = cfb[lane], c1 = cfb[64 + lane];
        const int idsel = wid < 4 ? id0 : id1; const float csel = wid < 4 ? c0 : c1;
        f32x2 acc[8];
#pragma unroll
        for (int i = 0; i < 8; ++i) acc[i] = (f32x2){0.f, 0.f};
#pragma unroll
        for (int k16 = 0; k16 < 16; ++k16) {
            const int kk = (wid & 3) * 16 + k16;
            const int e = __builtin_amdgcn_readlane(idsel, kk); const float c = __int_as_float(__builtin_amdgcn_readlane(__float_as_int(csel), kk));
            const u32x4 v = *(const u32x4*)(ET + (size_t)e * 2048 + 1024 + lane * 16); const f32x2 cc = (f32x2){c, c};
#pragma unroll
            for (int q = 0; q < 4; ++q) { acc[2 * q] = __builtin_amdgcn_cvt_pk_f32_fp8((int)v[q], false) * cc + acc[2 * q]; acc[2 * q + 1] = __builtin_amdgcn_cvt_pk_f32_fp8((int)v[q], true) * cc + acc[2 * q + 1]; }
        }
#pragma unroll
        for (int q = 0; q < 4; ++q) *(LAS f32x4*)(part + (wid * 64 + lane) * 16 + q * 4) = (f32x4){acc[2 * q][0], acc[2 * q][1], acc[2 * q + 1][0], acc[2 * q + 1][1]};
        __syncthreads();
        if (wid == 0) {
            float ss = 0.f; f32x4 x[4];
#pragma unroll
            for (int j = 0; j < 4; ++j) {
                x[j] = *(const f32x4*)(yr + lane * 16 + j * 4);
#pragma unroll
                for (int w8 = 0; w8 < 8; ++w8) x[j] += *(const LAS f32x4*)(part + (w8 * 64 + lane) * 16 + j * 4);
                ss += x[j][0] * x[j][0] + x[j][1] * x[j][1] + x[j][2] * x[j][2] + x[j][3] * x[j][3];
            }
            ss = wave_sum(ss, lane);
            const float rs = rsq(ss * (1.f / 1024.f) + EPS);
#pragma unroll
            for (int j = 0; j < 4; ++j) { const f32x4 g0 = *(const f32x4*)(p.g_final + lane * 16 + j * 4); *(f32x4*)(yr + lane * 16 + j * 4) = x[j] * rs * g0; }
        }
        __syncthreads();
    }
}

__device__ __forceinline__ void strip_mma(const bf16_t* A, int lda, const bf16_t* Bt, int ldb, int K, int c, int wid, int fr, int fq, f32x4 (&acc)[2]) {
#pragma unroll 2
    for (int ks = 0; ks < K / 32; ks += 4) {
        bf16x8 a[2][4], b[4];
#pragma unroll
        for (int u = 0; u < 4; ++u) {
            b[u] = *(const bf16x8*)(Bt + (size_t)(16 * c + fr) * ldb + (ks + u) * 32 + fq * 8);
#pragma unroll
            for (int i = 0; i < 2; ++i) a[i][u] = *(const bf16x8*)(A + (size_t)((2 * wid + i) * 16 + fr) * lda + (ks + u) * 32 + fq * 8);
        }
#pragma unroll
        for (int u = 0; u < 4; ++u)
#pragma unroll
            for (int i = 0; i < 2; ++i) acc[i] = MFMA16(a[i][u], b[u], acc[i]);
    }
}
__device__ __forceinline__ void sample_merge(const Ctx& cx, const Params& p) {
    unsigned char* ws = p.ws; const bf16_t* Zs = (const bf16_t*)(ws + OFF_Z) + (size_t)16384 * INC; bf16_t* M1 = (bf16_t*)(ws + OFF_M1) + (size_t)16384 * 1024;
    const int tid = cx.tid, wid = __builtin_amdgcn_readfirstlane(tid >> 6), lane = tid & 63, fr = lane & 15, fq = lane >> 4;
    for (int c = cx.bid; c < 64; c += cx.nb) {
        f32x4 aa[2] = {(f32x4){0.f, 0.f, 0.f, 0.f}, (f32x4){0.f, 0.f, 0.f, 0.f}}, ab[2] = {(f32x4){0.f, 0.f, 0.f, 0.f}, (f32x4){0.f, 0.f, 0.f, 0.f}};
        strip_mma(Zs, INC, (const bf16_t*)(ws + OFF_WA), 1024, 1024, c, wid, fr, fq, aa);
#pragma unroll 1
        for (int hh = 0; hh < 4; ++hh) {
            f32x4 ah[2] = {(f32x4){0.f, 0.f, 0.f, 0.f}, (f32x4){0.f, 0.f, 0.f, 0.f}};
            strip_mma(Zs + 4096 + hh * 512, INC, (const bf16_t*)(ws + OFF_WB) + hh * 512, 2048, 512, c, wid, fr, fq, ah);
#pragma unroll
            for (int i = 0; i < 2; ++i)
#pragma unroll
                for (int j = 0; j < 4; ++j) ab[i][j] += ah[i][j] * rsq(((const float*)(ws + OFF_SSO))[(size_t)(16384 + (2 * wid + i) * 16 + fq * 4 + j) * 4 + hh] * (1.f / 512.f) + EPS);
        }
#pragma unroll
        for (int i = 0; i < 2; ++i)
#pragma unroll
            for (int j = 0; j < 4; ++j) {
                const int row = (2 * wid + i) * 16 + fq * 4 + j, col = 16 * c + fr;
                const float ga = bf_lo((unsigned)Zs[(size_t)row * INC + 8192 + col]), gb = bf_lo((unsigned)Zs[(size_t)row * INC + 9216 + col]);
                M1[(size_t)row * 1024 + col] = f2bf(ga * aa[i][j] + gb * ab[i][j]);
            }
    }
}
__device__ __forceinline__ void sample_x2(const Ctx& cx, const Params& p) {
    unsigned char* ws = p.ws; bf16_t* X2b = (bf16_t*)(ws + OFF_X2B) + (size_t)16384 * 1024; float* ss2 = (float*)(ws + OFF_SS2) + 16384;
    const int tid = cx.tid, wid = __builtin_amdgcn_readfirstlane(tid >> 6), lane = tid & 63, fr = lane & 15, fq = lane >> 4;
    for (int c = cx.bid; c < 64; c += cx.nb) {
        f32x4 acc[2] = {(f32x4){0.f, 0.f, 0.f, 0.f}, (f32x4){0.f, 0.f, 0.f, 0.f}};
        strip_mma((const bf16_t*)(ws + OFF_M1) + (size_t)16384 * 1024, 1024, (const bf16_t*)(ws + OFF_WO), 1024, 1024, c, wid, fr, fq, acc);
#pragma unroll
        for (int i = 0; i < 2; ++i)
#pragma unroll
            for (int j = 0; j < 4; ++j) {
                const int row = (2 * wid + i) * 16 + fq * 4 + j, col = 16 * c + fr;
                const float v = p.xs[(size_t)row * 1024 + col] + acc[i][j];
                p.out[O_YS + (size_t)row * 1024 + col] = v; X2b[(size_t)row * 1024 + col] = f2bf(v);
                const float sq = row16_sum(v * v);
                if (fr == 0) atomicAdd(ss2 + row, sq);
            }
    }
}
__device__ __forceinline__ void sample_query(const Ctx& cx, const Params& p) {
    unsigned char* ws = p.ws; bf16_t* QP = (bf16_t*)(ws + OFF_QP) + (size_t)16384 * 2048; const float* ss2 = (const float*)(ws + OFF_SS2) + 16384;
    const int tid = cx.tid, wid = __builtin_amdgcn_readfirstlane(tid >> 6), lane = tid & 63, fr = lane & 15, fq = lane >> 4;
    for (int c = cx.bid; c < 128; c += cx.nb) {
        f32x4 acc[2] = {(f32x4){0.f, 0.f, 0.f, 0.f}, (f32x4){0.f, 0.f, 0.f, 0.f}};
        strip_mma((const bf16_t*)(ws + OFF_X2B) + (size_t)16384 * 1024, 1024, (const bf16_t*)(ws + OFF_WQ), 1024, 1024, c, wid, fr, fq, acc);
#pragma unroll
        for (int i = 0; i < 2; ++i)
#pragma unroll
            for (int j = 0; j < 4; ++j) {
                const int row = (2 * wid + i) * 16 + fq * 4 + j, col = 16 * c + fr;
                QP[(size_t)row * 2048 + col] = f2bf(acc[i][j] * rsq(ss2[row] * (1.f / 1024.f) + EPS));
            }
    }
}

__device__ __forceinline__ void run_phase(const Params& p, LAS unsigned char* lds, int ph, const Ctx& cx) {
    unsigned char* ws = p.ws; pg8::StaticOrder S; pg8::Gemm g;
    bf16_t* Z = (bf16_t*)(ws + OFF_Z); bf16_t* T1 = (bf16_t*)((unsigned char*)p.out + OUT_T1);
    if (ph == 0) { phase0(cx, p, lds); return; }
    if (ph >= 1 && ph <= 8) {
        const int hf = (ph - 1) >> 2, sub = (ph - 1) & 3, rowbase = hf ? NH0 : 0, nM = hf ? 64 : 65;
        if (sub == 0) {
            g.A = (const bf16_t*)((unsigned char*)p.out + OUT_XB) + (size_t)rowbase * 1024; g.Bt = (const bf16_t*)(ws + OFF_WIN); g.lda = 1024; g.ldb = 1024; g.K = 1024;
            S.init(nM, 40, cx.nb, cx.bid);
            EpiIn E{Z, (const float*)(ws + OFF_R1), (float*)(ws + OFF_SSV), p.b_gate, rowbase};
            pg8::gemm_phase(cx, lds, g, S, E);
        } else if (sub == 1) phase2(cx, p, lds, hf);
#ifdef DBG_SKIP_P3
        else if (sub == 2) { }
#else
        else if (sub == 2) { }
#endif
        else {
            S.init(64, 4, cx.nb, cx.bid);
            g.A = Z; g.Bt = (const bf16_t*)(ws + OFF_WA); g.lda = INC; g.ldb = 1024; g.K = 1024;
            EpiT1 E1{T1, Z}; pg8::gemm_phase(cx, lds, g, S, E1);
            g.A = Z + 4096; g.Bt = (const bf16_t*)(ws + OFF_WB); g.lda = INC; g.ldb = 2048; g.K = 2048;
            EpiM1 E2{T1, Z, (bf16_t*)(ws + OFF_M1), rowbase, (const float*)(ws + OFF_SSO)}; pg8::gemm_phase(cx, lds, g, S, E2);
            if (hf == 0) sample_merge(cx, p);
        }
        return;
    }
#ifdef DBG_YCONST
    if (ph >= 9 && ph <= 11) return;
#endif
    if (ph == 9) {
        g.A = (const bf16_t*)(ws + OFF_M1); g.Bt = (const bf16_t*)(ws + OFF_WO); g.lda = 1024; g.ldb = 1024; g.K = 1024;
        S.init(128, 4, cx.nb, cx.bid, 64);
        EpiX2 E{p.xp, p.xs, p.out, (bf16_t*)(ws + OFF_X2B), (float*)(ws + OFF_SS2)}; pg8::gemm_phase(cx, lds, g, S, E);
        sample_x2(cx, p); return;
    }
    if (ph == 10) {
        g.A = (const bf16_t*)(ws + OFF_X2B); g.Bt = (const bf16_t*)(ws + OFF_WQ); g.lda = 1024; g.ldb = 1024; g.K = 1024;
        S.init(128, 8, cx.nb, cx.bid, 64);
        EpiQP E{(bf16_t*)(ws + OFF_QP), (const float*)(ws + OFF_SS2)}; pg8::gemm_phase(cx, lds, g, S, E);
        sample_query(cx, p); return;
    }
    if (ph == 11) { phase7(cx, p, lds); return; }
    if (ph == 12) { phase8(cx, p, lds); return; }
}
constexpr int NPHASE = 13;

extern __shared__ __attribute__((aligned(16))) unsigned char dyn_smem[];

#if ONE_LAUNCH
__device__ __forceinline__ void grid_barrier(unsigned* ctr, unsigned target, int tid) {
    asm volatile("s_waitcnt vmcnt(0)" ::: "memory");
    __syncthreads();
    if (tid == 0) {
        __builtin_amdgcn_fence(__ATOMIC_RELEASE, "agent");
        asm volatile("s_waitcnt vmcnt(0)" ::: "memory");
        __hip_atomic_fetch_add(ctr, 1u, __ATOMIC_RELAXED, __HIP_MEMORY_SCOPE_AGENT);
        while (__hip_atomic_load(ctr, __ATOMIC_RELAXED, __HIP_MEMORY_SCOPE_AGENT) < target) __builtin_amdgcn_s_sleep(1);
        __builtin_amdgcn_fence(__ATOMIC_ACQUIRE, "agent");
        asm volatile("s_waitcnt vmcnt(0)" ::: "memory");
    }
    __syncthreads();
}
__global__ __launch_bounds__(512, 2) void mega_kernel(Params p) {
#if defined(__HIP_DEVICE_COMPILE__)
    LAS unsigned char* lds = (LAS unsigned char*)dyn_smem;
    cg::grid_group grid = cg::this_grid();
    const int wave0 = __builtin_amdgcn_readfirstlane((int)threadIdx.x >> 6);
    unsigned nbar = 0;
    { int never = 0; asm volatile("" : "+s"(never));
      if (never == 1000) grid.sync(); }
#pragma nounroll
    for (int ph = 0; ph < NPHASE; ++ph) {
        int phv = ph; asm volatile("" : "+s"(phv));
        int wv = wave0; asm volatile("" : "+s"(wv));
        int ln = (int)__builtin_amdgcn_mbcnt_hi(~0u, __builtin_amdgcn_mbcnt_lo(~0u, 0u)); asm volatile("" : "+v"(ln));
        Ctx cx; cx.tid = wv * 64 + ln; cx.bid = blockIdx.x; cx.nb = gridDim.x;
        asm volatile("" : "+s"(cx.bid)); asm volatile("" : "+s"(cx.nb));
        auto ka = __builtin_amdgcn_kernarg_segment_ptr(); asm volatile("" : "+s"(ka));
        const Params pl = *(const Params __attribute__((address_space(4)))*)(unsigned long long)ka;
        unsigned lo = 0; asm volatile("" : "+s"(lo));
        if (ph == 3 || ph == 7) continue;
        run_phase(pl, lds + lo, phv, cx);
        if (ph + 1 < NPHASE) { ++nbar; grid_barrier((unsigned*)(pl.ws + OFF_BAR), nbar * (unsigned)cx.nb, cx.tid); }
    }
#endif
}
#else
__global__ __launch_bounds__(512, 2) void stage_kernel(Params p, int ph) {
    LAS unsigned char* lds = (LAS unsigned char*)dyn_smem;
    Ctx cx; cx.tid = threadIdx.x; cx.bid = blockIdx.x; cx.nb = gridDim.x;
    run_phase(p, lds, ph, cx);
}
#endif

extern "C" void kernel_launch(void* const* d_in, const int* in_sizes, int n_in, void* d_out, int out_size, void* d_ws, size_t ws_size, hipStream_t stream) {
    Params p; memset(&p, 0, sizeof(p));
    p.xp = (const float*)d_in[0]; p.xs = (const float*)d_in[1]; p.state = (const float*)d_in[2]; p.w_in = (const float*)d_in[3]; p.w_s = (const float*)d_in[4];
    p.b_s = (const float*)d_in[5]; p.g_sgu = (const float*)d_in[6]; p.w_pa = (const float*)d_in[7]; p.w_pb = (const float*)d_in[8]; p.b_gate = (const float*)d_in[9];
    p.w_out = (const float*)d_in[10]; p.g_mix = (const float*)d_in[11]; p.g_ffn = (const float*)d_in[12]; p.w_q = (const float*)d_in[13]; p.k1 = (const float*)d_in[14];
    p.k2 = (const float*)d_in[15]; p.eu = (const float*)d_in[16]; p.ev = (const float*)d_in[17]; p.g_final = (const float*)d_in[18];
    p.out = (float*)d_out; p.ws = (unsigned char*)d_ws;
    if (ws_size < WS_NEED) { fprintf(stderr, "workspace too small: %zu < %zu\n", ws_size, (size_t)WS_NEED); return; }
#if ONE_LAUNCH
    static int grid_blocks = 0;
    if (!grid_blocks) {
        (void)hipFuncSetAttribute((const void*)mega_kernel, hipFuncAttributeMaxDynamicSharedMemorySize, LDS_BYTES);
        int dev = 0, cus = 0, per_cu = 0;
        hipGetDevice(&dev); hipDeviceGetAttribute(&cus, hipDeviceAttributeMultiprocessorCount, dev);
        hipOccupancyMaxActiveBlocksPerMultiprocessor(&per_cu, mega_kernel, 512, LDS_BYTES);
        if (per_cu < 1) per_cu = 1;
        grid_blocks = cus * 1;
    }
    (void)hipMemsetAsync((unsigned char*)d_ws + OFF_BAR, 0, 256, stream);
    void* args[] = {&p};
    hipError_t e = hipLaunchCooperativeKernel((const void*)mega_kernel, dim3(grid_blocks), dim3(512), args, LDS_BYTES, stream);
    if (e != hipSuccess) fprintf(stderr, "cooperative launch failed: %s (grid %d)\n", hipGetErrorString(e), grid_blocks);
#else
    static bool attr = false;
    if (!attr) { (void)hipFuncSetAttribute((const void*)stage_kernel, hipFuncAttributeMaxDynamicSharedMemorySize, LDS_BYTES); attr = true; }
    for (int ph = 0; ph < NPHASE; ++ph) hipLaunchKernelGGL(stage_kernel, dim3(256), dim3(512), LDS_BYTES, stream, p, ph);
#endif
}
```

```cpp
#include <hip/hip_runtime.h>
#include <hip/hip_cooperative_groups.h>
#include <cstdio>
#include <cstring>
namespace cg = cooperative_groups;

#ifndef ONE_LAUNCH
#define ONE_LAUNCH 1
#endif

#define LAS __attribute__((address_space(3)))
typedef unsigned short bf16_t;
typedef short bf16x8 __attribute__((ext_vector_type(8)));
typedef float f32x4 __attribute__((ext_vector_type(4)));
typedef unsigned u32x4 __attribute__((ext_vector_type(4)));
typedef unsigned u32x2 __attribute__((ext_vector_type(2)));
typedef __bf16 bf16x2_t __attribute__((ext_vector_type(2)));

constexpr int DM = 1024, NTOK = 33024, NH0 = 16640, INC = 10240;
constexpr float EPS = 1e-6f;
constexpr int LDS_BYTES = 157696;
constexpr float EU_SCALE = 64.f, EV_SCALE = 64.f;

constexpr size_t OFF_WIN = 0;
constexpr size_t OFF_WA  = OFF_WIN + (size_t)10240 * 1024 * 2;
constexpr size_t OFF_WB  = OFF_WA + (size_t)1024 * 1024 * 2;
constexpr size_t OFF_WO  = OFF_WB + (size_t)1024 * 2048 * 2;
constexpr size_t OFF_WQ  = OFF_WO + (size_t)1024 * 1024 * 2;
constexpr size_t OFF_EU  = OFF_WQ + (size_t)2048 * 1024 * 2;
constexpr size_t OFF_EV  = OFF_EU + (size_t)16384 * 1024 * 2;
constexpr size_t OFF_K1  = OFF_EV + (size_t)16384 * 1024 * 2;
constexpr size_t OFF_K2  = OFF_K1 + 32768;
constexpr size_t OFF_M1  = OFF_K2 + 32768;
constexpr size_t OFF_R1  = OFF_M1 + (size_t)NTOK * 1024 * 2;
constexpr size_t OFF_SSV = OFF_R1 + (size_t)NTOK * 4;
constexpr size_t OFF_SS2 = OFF_SSV + (size_t)NTOK * 4;
constexpr size_t OFF_SSO = OFF_SS2 + (size_t)NTOK * 4;
constexpr size_t OFF_Z   = OFF_SSO + (size_t)NTOK * 16;
constexpr size_t Z_BYTES = (size_t)NH0 * INC * 2;
constexpr size_t OFF_BAR = OFF_Z + Z_BYTES;
constexpr size_t WS_NEED = OFF_BAR + 256;
constexpr size_t OFF_X2B = OFF_Z;
constexpr size_t OFF_QP  = OFF_X2B + (size_t)NTOK * 1024 * 2;
constexpr size_t OFF_IDS = OFF_QP + (size_t)NTOK * 2048 * 2;
constexpr size_t OFF_WTS = OFF_IDS + (size_t)NTOK * 128 * 4;
constexpr size_t OUT_XB = 0;
constexpr size_t OUT_T1 = (size_t)NTOK * 1024 * 2;
constexpr size_t O_YP = 0, O_YS = (size_t)32768 * 1024, O_SP = O_YS + (size_t)256 * 1024, O_SS = O_SP + (size_t)16 * 4 * 256 * 512,
                 O_SV = O_SS + (size_t)16 * 4 * 256 * 512;

struct Params {
    const float *xp, *xs, *state, *w_in, *w_s, *b_s, *g_sgu, *w_pa, *w_pb, *b_gate, *w_out, *g_mix, *g_ffn, *w_q, *k1, *k2, *eu, *ev, *g_final;
    float* out;
    unsigned char* ws;
};

struct Ctx { int tid, bid, nb; };

__device__ __forceinline__ float bf_lo(unsigned u) { return __uint_as_float(u << 16); }
__device__ __forceinline__ float bf_hi(unsigned u) { return __uint_as_float(u & 0xffff0000u); }
typedef float f32x2 __attribute__((ext_vector_type(2)));
__device__ __forceinline__ unsigned pk_bf16(float lo, float hi) {
    f32x2 v = {lo, hi}; bf16x2_t b = __builtin_convertvector(v, bf16x2_t); return __builtin_bit_cast(unsigned, b);
}
__device__ __forceinline__ bf16_t f2bf(float f) { return (bf16_t)(pk_bf16(f, 0.f) & 0xffffu); }
__device__ __forceinline__ float fexp2(float x) { return __builtin_amdgcn_exp2f(x); }
__device__ __forceinline__ float frcp(float x) { return __builtin_amdgcn_rcpf(x); }
__device__ __forceinline__ float sigm(float x) { return frcp(1.f + fexp2(-1.44269504f * x)); }
__device__ __forceinline__ float gelu_t(float x) { const float u = 0.7978845608f * (x + 0.044715f * x * x * x); return x * frcp(1.f + fexp2(-2.88539008f * u)); }
__device__ __forceinline__ float rsq(float x) { return __builtin_amdgcn_rsqf(x); }
__device__ __forceinline__ f32x2 sigm2(f32x2 x) {
    const f32x2 t = x * (-1.44269504f); f32x2 e; e.x = fexp2(t.x); e.y = fexp2(t.y);
    const f32x2 d = e + 1.f; f32x2 r; r.x = frcp(d.x); r.y = frcp(d.y); return r;
}
__device__ __forceinline__ f32x2 gelu_t2(f32x2 x) {
    const f32x2 w = (x * x) * (-0.10294324f) + (-2.3022082f), t = x * w;
    f32x2 e; e.x = fexp2(t.x); e.y = fexp2(t.y);
    const f32x2 d = e + 1.f;
    f32x2 r; r.x = frcp(d.x); r.y = frcp(d.y);
    return x * r;
}
__device__ __forceinline__ const float* xrow(const Params& p, int ir) {
    return ir < 16384 ? p.xp + (size_t)ir * 1024 : (ir < 16640 ? p.xs + (size_t)(ir - 16384) * 1024 : p.xp + (size_t)(ir - 256) * 1024);
}
__device__ __forceinline__ float* yrow(const Params& p, int ir) {
    return ir < 16384 ? p.out + O_YP + (size_t)ir * 1024 : (ir < 16640 ? p.out + O_YS + (size_t)(ir - 16384) * 1024 : p.out + O_YP + (size_t)(ir - 256) * 1024);
}
__device__ __forceinline__ float shx(float v, int m, int lane) { return __int_as_float(__builtin_amdgcn_ds_bpermute((lane ^ m) << 2, __float_as_int(v))); }
__device__ __forceinline__ float shl_(float v, int src) { return __int_as_float(__builtin_amdgcn_ds_bpermute(src << 2, __float_as_int(v))); }
__device__ __forceinline__ int shl_(int v, int src) { return __builtin_amdgcn_ds_bpermute(src << 2, v); }
__device__ __forceinline__ float wave_sum(float v, int lane) {
#pragma unroll
    for (int o = 32; o >= 1; o >>= 1) v += shx(v, o, lane);
    return v;
}
__device__ __forceinline__ float row16_sum(float s) {
    s += __int_as_float(__builtin_amdgcn_update_dpp(0, __float_as_int(s), 0xB1, 0xF, 0xF, true));
    s += __int_as_float(__builtin_amdgcn_update_dpp(0, __float_as_int(s), 0x4E, 0xF, 0xF, true));
    s += __int_as_float(__builtin_amdgcn_update_dpp(0, __float_as_int(s), 0x141, 0xF, 0xF, true));
    s += __int_as_float(__builtin_amdgcn_update_dpp(0, __float_as_int(s), 0x140, 0xF, 0xF, true));
    return s;
}
__device__ __forceinline__ float dot2bf(unsigned a, unsigned b, float c) {
    return __builtin_amdgcn_fdot2_f32_bf16(__builtin_bit_cast(bf16x2_t, a), __builtin_bit_cast(bf16x2_t, b), c, false);
}
typedef short s16x4 __attribute__((ext_vector_type(4)));
__device__ __forceinline__ bf16x8 tr_frag(const LAS bf16_t* tile, int stride, int lane) {
    const LAS bf16_t* a0 = tile + (8 * (lane >> 4) + ((lane >> 2) & 3)) * stride + 4 * (lane & 3);
    const s16x4 lo = __builtin_amdgcn_ds_read_tr16_b64_v4i16((LAS s16x4*)a0), hi = __builtin_amdgcn_ds_read_tr16_b64_v4i16((LAS s16x4*)(a0 + 4 * stride));
    return (bf16x8){lo[0], lo[1], lo[2], lo[3], hi[0], hi[1], hi[2], hi[3]};
}
#define MFMA16(a, b, c) __builtin_amdgcn_mfma_f32_16x16x32_bf16((a), (b), (c), 0, 0, 0)

namespace pg8 {
constexpr int BM = 256, BK = 64, HALF = 128, HTB = HALF * BK * 2, STAGE_BYTES = 8 * HTB, NXCD = 8, WGM = 4;
__device__ __forceinline__ int lds_byte(int r, int c) { const int st = (r >> 4) * 2 + (c >> 5), rr = r & 15, cc = c & 31, ob = rr * 64 + cc * 2; return st * 1024 + (ob ^ (((ob >> 9) & 1) << 5)); }
__device__ __forceinline__ void stage_rc(int b, int& R, int& C) { const int st = b / 1024, sb = b % 1024, swz = sb ^ (((sb >> 9) & 1) << 5); R = (st >> 1) * 16 + swz / 64; C = (st & 1) * 32 + (swz % 64) / 2; }
__device__ __forceinline__ int perm32(int rho) { const int n = rho >> 4, i = rho & 15; return 8 * (i >> 2) + 4 * n + (i & 3); }
struct Unit { int pm, pn; };
struct Gemm { const bf16_t* A; const bf16_t* Bt; int lda, ldb, K; };
struct StaticOrder {
    int nM, nN, nwg, G, c, skip;
    __device__ void init(int nM_, int nN_, int G_, int c_, int skip_ = 1 << 30) { nM = nM_; nN = nN_; nwg = nM * nN; G = G_; c = c_; skip = skip_; }
    __device__ bool next(int i, Unit& u) const {
        const long L = (long)i * G + c; if (L >= nwg) return false;
        int wgid = (int)L; { const int q = nwg / NXCD, r = nwg % NXCD, xcd = wgid % NXCD, off = wgid / NXCD; wgid = (xcd < r ? xcd * (q + 1) : r * (q + 1) + (xcd - r) * q) + off; }
        const int nig = WGM * nN, gid = wgid / nig, fm = gid * WGM, gsz = (nM - fm) < WGM ? (nM - fm) : WGM;
        u.pm = fm + ((wgid % nig) % gsz); u.pn = (wgid % nig) / gsz; if (u.pm >= skip) ++u.pm; return true;
    }
};

template <class Epi>
__device__ __forceinline__ void gemm_phase(const Ctx& cx, LAS unsigned char* lds, const Gemm g, const StaticOrder& S, const Epi& E) {
    const int tid = cx.tid, wid = __builtin_amdgcn_readfirstlane(tid >> 6), lane = tid & 63, wr = wid >> 2, wc = wid & 3, fr = lane & 15, fq = lane >> 4;
    const int K = g.K, nt = K / BK;
    unsigned voffA[2], voffB[2];
#pragma unroll
    for (int i = 0; i < 2; ++i) { int R, C; stage_rc(tid * 16 + i * 8192, R, C); const int Rb = (R & ~31) + perm32(R & 31);
        voffA[i] = (unsigned)(R * g.lda + C) * 2u; voffB[i] = (unsigned)(Rb * g.ldb + C) * 2u; }
    const size_t kstep = (size_t)(BK * 2);
    const size_t hstepA = (size_t)HALF * g.lda * 2, hstepB = (size_t)HALF * g.ldb * 2;
    const size_t tstepA = 2 * hstepA, tstepB = 2 * hstepB;
    const unsigned ldsw = (unsigned)wid * 1024u;
    const int aoff = lds_byte(wr * 64 + fr, fq * 8), boff = lds_byte(wc * 32 + fr, fq * 8);
#define PG8_SA(b, h) (((b) * 2 + (h)) * HTB)
#define PG8_SB(b, h) ((4 + (b) * 2 + (h)) * HTB)
#define PG8_STAGE(bufoff, gbase, voff) do { _Pragma("unroll") for (int _i = 0; _i < 2; ++_i) \
        __builtin_amdgcn_global_load_lds((const unsigned*)((const char*)(gbase) + (voff)[_i]), (LAS unsigned*)(lds + (bufoff) + ldsw + _i * 8192), 16, 0, 0); } while (0)
#define PG8_LDA(dst, b, h) do { _Pragma("unroll") for (int m = 0; m < 4; ++m) _Pragma("unroll") for (int k = 0; k < 2; ++k) dst[m][k] = *(const LAS bf16x8*)(lds + PG8_SA(b, h) + aoff + m * 2048 + k * 1024); } while (0)
#define PG8_LDB(dst, b, h) do { _Pragma("unroll") for (int n = 0; n < 2; ++n) _Pragma("unroll") for (int k = 0; k < 2; ++k) dst[n][k] = *(const LAS bf16x8*)(lds + PG8_SB(b, h) + boff + n * 2048 + k * 1024); } while (0)
#define PG8_MMA(ai, bj, At, Bt) do { __builtin_amdgcn_s_setprio(1); _Pragma("unroll") for (int m = 0; m < 4; ++m) _Pragma("unroll") for (int n = 0; n < 2; ++n) _Pragma("unroll") for (int k = 0; k < 2; ++k) \
        acc[ai][bj][m][n] = __builtin_amdgcn_mfma_f32_16x16x32_bf16(Bt[n][k], At[m][k], acc[ai][bj][m][n], 0, 0, 0); __builtin_amdgcn_s_setprio(0); } while (0)
#define PG8_WAIT_V(n) asm volatile("s_waitcnt vmcnt(" #n ")" ::: "memory")
#define PG8_WAIT_L(n) asm volatile("s_waitcnt lgkmcnt(" #n ")" ::: "memory")
#define PG8_BAR __builtin_amdgcn_s_barrier()
#define PG8_SCHED __builtin_amdgcn_sched_barrier(0)
    Unit cur, nxt; int ui = 0;
    if (!S.next(0, cur)) return;
    f32x4 acc[2][2][4][2];
#pragma unroll
    for (int a = 0; a < 2; ++a)
#pragma unroll
        for (int b = 0; b < 2; ++b)
#pragma unroll
            for (int m = 0; m < 4; ++m)
#pragma unroll
                for (int n = 0; n < 2; ++n) acc[a][b][m][n] = (f32x4){0.f, 0.f, 0.f, 0.f};
    bf16x8 At[4][2], B0[2][2], B1[2][2];
    const char* cA = (const char*)g.A + (size_t)cur.pm * tstepA; const char* cB = (const char*)g.Bt + (size_t)cur.pn * tstepB;
    if constexpr (Epi::RESCALE) E.prep((LAS float*)(lds + STAGE_BYTES), cur, tid);
    PG8_STAGE(PG8_SB(0, 0), cB, voffB); PG8_STAGE(PG8_SA(0, 0), cA, voffA); PG8_STAGE(PG8_SB(0, 1), cB + hstepB, voffB); PG8_STAGE(PG8_SA(0, 1), cA + hstepA, voffA);
    if (wr == 1) PG8_BAR;
    PG8_WAIT_V(4); PG8_BAR;
    PG8_STAGE(PG8_SB(1, 0), cB + kstep, voffB); PG8_STAGE(PG8_SA(1, 0), cA + kstep, voffA); PG8_STAGE(PG8_SB(1, 1), cB + hstepB + kstep, voffB);
    PG8_WAIT_V(6); PG8_BAR;
    for (;;) {
        const bool has_next = S.next(ui + 1, nxt);
        if constexpr (Epi::RESCALE) { if (has_next) E.prep((LAS float*)(lds + STAGE_BYTES) + ((ui + 1) & 1) * 1024, nxt, tid); }
        const char* nA = has_next ? (const char*)g.A + (size_t)nxt.pm * tstepA : cA; const char* nB = has_next ? (const char*)g.Bt + (size_t)nxt.pn * tstepB : cB;
        for (int t = 0; t < nt; t += 2) {
            const bool last = (t == nt - 2);
            const char* a1 = cA + (size_t)(t + 1) * kstep;
            const char* a2 = last ? nA : cA + (size_t)(t + 2) * kstep; const char* b2 = last ? nB : cB + (size_t)(t + 2) * kstep;
            const char* a3 = a2 + kstep; const char* b3 = b2 + kstep;
            PG8_LDB(B0, 0, 0); PG8_SCHED; PG8_LDA(At, 0, 0); PG8_STAGE(PG8_SA(1, 1), a1 + hstepA, voffA);
            PG8_WAIT_L(8); PG8_BAR; PG8_WAIT_L(0); PG8_MMA(0, 0, At, B0); PG8_BAR; PG8_SCHED;
            PG8_LDB(B1, 0, 1); PG8_STAGE(PG8_SB(0, 0), b2, voffB);
            PG8_BAR; PG8_WAIT_L(0); PG8_MMA(0, 1, At, B1); PG8_BAR;
            PG8_LDA(At, 0, 1); PG8_STAGE(PG8_SA(0, 0), a2, voffA);
            PG8_BAR; PG8_WAIT_L(0); PG8_MMA(1, 0, At, B0); PG8_BAR; PG8_SCHED;
            PG8_STAGE(PG8_SB(0, 1), b2 + hstepB, voffB);
            PG8_WAIT_V(6); PG8_BAR; PG8_MMA(1, 1, At, B1); PG8_BAR;
            PG8_LDB(B0, 1, 0); PG8_SCHED; PG8_LDA(At, 1, 0); PG8_STAGE(PG8_SA(0, 1), a2 + hstepA, voffA);
            PG8_WAIT_L(8); PG8_BAR; PG8_WAIT_L(0); PG8_MMA(0, 0, At, B0); PG8_BAR; PG8_SCHED;
            PG8_LDB(B1, 1, 1); PG8_STAGE(PG8_SB(1, 0), b3, voffB);
            PG8_BAR; PG8_WAIT_L(0); PG8_MMA(0, 1, At, B1); PG8_BAR;
            PG8_LDA(At, 1, 1); PG8_STAGE(PG8_SA(1, 0), a3, voffA);
            PG8_BAR; PG8_WAIT_L(0); PG8_MMA(1, 0, At, B0); PG8_BAR; PG8_SCHED;
            PG8_STAGE(PG8_SB(1, 1), b3 + hstepB, voffB);
            PG8_WAIT_V(6); PG8_BAR; PG8_MMA(1, 1, At, B1); PG8_BAR;
            if constexpr (Epi::RESCALE) { if (((t + 2) & 7) == 0 && t + 2 < nt) E.mid(acc, (const LAS float*)(lds + STAGE_BYTES) + (ui & 1) * 1024, ((t + 2) >> 3) - 1, wr, fr); }
        }
        if constexpr (Epi::RESCALE) E.fin(acc, (const LAS float*)(lds + STAGE_BYTES) + (ui & 1) * 1024, cur, wr, wc, fr, fq); else E(acc, cur, wr, wc, fr, fq);
        if (!has_next) break;
#pragma unroll
        for (int a = 0; a < 2; ++a)
#pragma unroll
            for (int b = 0; b < 2; ++b)
#pragma unroll
                for (int m = 0; m < 4; ++m)
#pragma unroll
                    for (int n = 0; n < 2; ++n) acc[a][b][m][n] = (f32x4){0.f, 0.f, 0.f, 0.f};
        cur = nxt; cA = nA; cB = nB; ++ui;
    }
    PG8_WAIT_V(0);
    if (wr == 0) PG8_BAR;
    PG8_BAR;
#undef PG8_SA
#undef PG8_SB
#undef PG8_STAGE
#undef PG8_LDA
#undef PG8_LDB
#undef PG8_MMA
#undef PG8_WAIT_V
#undef PG8_WAIT_L
#undef PG8_BAR
#undef PG8_SCHED
}
}
using pg8::Unit;

__device__ __forceinline__ u32x4 pack8(const float (&v)[8]) { return (u32x4){pk_bf16(v[0], v[1]), pk_bf16(v[2], v[3]), pk_bf16(v[4], v[5]), pk_bf16(v[6], v[7])}; }
__device__ __forceinline__ void unpack8(const u32x4 u, float (&v)[8]) {
#pragma unroll
    for (int q = 0; q < 4; ++q) { v[2 * q] = bf_lo(u[q]); v[2 * q + 1] = bf_hi(u[q]); }
}

struct EpiIn {
    static constexpr bool RESCALE = false;
    bf16_t* Z; const float* r1; float* ssv; const float* b_gate; int rowbase;
    __device__ __forceinline__ void operator()(const f32x4 (&acc)[2][2][4][2], const Unit& u, int wr, int wc, int fr, int fq) const {
        const int pn = u.pn, lane = fr + 16 * fq;
        const int kind = pn < 4 ? 0 : pn < 8 ? 1 : pn < 12 ? 2 : pn < 16 ? 3 : pn < 24 ? 4 : pn < 32 ? 5 : 6;
        const int row0 = u.pm * 256 + wr * 64 + fr, col0 = pn * 256 + wc * 32 + 8 * fq;
        if (kind == 2 || kind == 3) {
            const float ksc = kind == 3 ? 0.0625f : 1.f;
            float inv8[8];
#pragma unroll
            for (int e = 0; e < 8; ++e) inv8[e] = fexp2(-(float)(wc * 32 + 8 * fq + e) * (13.287712379549449f / 127.f)) * 0.15915494309189535f;
#pragma unroll
            for (int ai = 0; ai < 2; ++ai)
#pragma unroll
                for (int m = 0; m < 4; ++m) {
                    const int row = row0 + ai * 128 + m * 16, gr = rowbase + row;
                    const float pos = (float)(gr < 16384 ? (gr & 2047) : (gr < 16640 ? 1024 + ((gr - 16384) & 15) : ((gr - 16640) & 2047)));
                    float v0[8], v1[8], o0[8], o1[8];
#pragma unroll
                    for (int e = 0; e < 4; ++e) { v0[e] = acc[ai][0][m][0][e]; v0[4 + e] = acc[ai][0][m][1][e]; v1[e] = acc[ai][1][m][0][e]; v1[4 + e] = acc[ai][1][m][1][e]; }
#pragma unroll
                    for (int e = 0; e < 8; e += 2) {
                        const float t0 = __builtin_amdgcn_fractf(pos * inv8[e]), t1 = __builtin_amdgcn_fractf(pos * inv8[e + 1]);
                        const f32x2 sn = (f32x2){__builtin_amdgcn_sinf(t0), __builtin_amdgcn_sinf(t1)}, cs = (f32x2){__builtin_amdgcn_cosf(t0), __builtin_amdgcn_cosf(t1)};
                        const f32x2 a = (f32x2){v0[e], v0[e + 1]} * ksc, b = (f32x2){v1[e], v1[e + 1]} * ksc;
                        const f32x2 r0 = a * cs - b * sn, r1 = a * sn + b * cs;
                        o0[e] = r0[0]; o0[e + 1] = r0[1]; o1[e] = r1[0]; o1[e + 1] = r1[1];
                    }
                    *(u32x4*)(Z + (size_t)row * INC + col0) = pack8(o0); *(u32x4*)(Z + (size_t)row * INC + col0 + 128) = pack8(o1);
                }
            return;
        }
#pragma unroll
        for (int ai = 0; ai < 2; ++ai)
#pragma unroll
            for (int m = 0; m < 4; ++m) {
                const int row = row0 + ai * 128 + m * 16; float ss = 0.f;
#pragma unroll
                for (int bj = 0; bj < 2; ++bj) {
                    const int col = col0 + bj * 128; float v[8];
#pragma unroll
                    for (int e = 0; e < 4; ++e) { v[e] = acc[ai][bj][m][0][e]; v[4 + e] = acc[ai][bj][m][1][e]; }
                    if (kind == 0 || kind == 1) {
#pragma unroll
                        for (int e = 0; e < 4; ++e) { const f32x2 gq = gelu_t2((f32x2){v[2 * e], v[2 * e + 1]}); v[2 * e] = gq[0]; v[2 * e + 1] = gq[1]; }
                        if (kind == 1) {
#pragma unroll
                            for (int e = 0; e < 8; ++e) ss += v[e] * v[e];
                        }
                    } else if (kind == 3) {
#pragma unroll
                        for (int e = 0; e < 8; ++e) v[e] *= 0.0625f;
                    } else if (kind == 5) {
#pragma unroll
                        for (int e = 0; e < 4; ++e) { const f32x2 xx = (f32x2){v[2 * e], v[2 * e + 1]}, q2 = xx * sigm2(xx); v[2 * e] = q2[0]; v[2 * e + 1] = q2[1]; }
                    } else if (kind == 6) {
                        const f32x4 b0 = *(const f32x4*)(b_gate + col - 8192), b1 = *(const f32x4*)(b_gate + col - 8192 + 4);
                        const float bb[8] = {b0[0], b0[1], b0[2], b0[3], b1[0], b1[1], b1[2], b1[3]};
#pragma unroll
                        for (int e = 0; e < 4; ++e) { const f32x2 q2 = sigm2((f32x2){v[2 * e] + bb[2 * e], v[2 * e + 1] + bb[2 * e + 1]}); v[2 * e] = q2[0]; v[2 * e + 1] = q2[1]; }
                    }
                    *(u32x4*)(Z + (size_t)row * INC + col) = pack8(v);
                }
                if (kind == 1) { ss += shx(ss, 16, lane); ss += shx(ss, 32, lane); if (fq == 0) atomicAdd(ssv + rowbase + row, ss); }
            }
    }
};
struct EpiT1 {
    static constexpr bool RESCALE = false;
    bf16_t* T1; const bf16_t* Z;
    __device__ __forceinline__ void operator()(const f32x4 (&acc)[2][2][4][2], const Unit& u, int wr, int wc, int fr, int fq) const {
        const int row0 = u.pm * 256 + wr * 64 + fr, col0 = u.pn * 256 + wc * 32 + 8 * fq;
#pragma unroll
        for (int ai = 0; ai < 2; ++ai)
#pragma unroll
            for (int m = 0; m < 4; ++m) {
                const int row = row0 + ai * 128 + m * 16;
#pragma unroll
                for (int bj = 0; bj < 2; ++bj) {
                    const int col = col0 + bj * 128; float v[8], gt[8];
                    unpack8(*(const u32x4*)(Z + (size_t)row * INC + 8192 + col), gt);
#pragma unroll
                    for (int e = 0; e < 4; ++e) { v[e] = acc[ai][bj][m][0][e] * gt[e]; v[4 + e] = acc[ai][bj][m][1][e] * gt[4 + e]; }
                    *(u32x4*)(T1 + (size_t)row * 1024 + col) = pack8(v);
                }
            }
    }
};
struct EpiM1 {
    static constexpr bool RESCALE = true;
    const bf16_t* T1; const bf16_t* Z; bf16_t* M1; int rowbase; const float* sso;
    __device__ __forceinline__ void prep(LAS float* tab, const Unit& u, int tid) const {
        if (tid < 256) {
            const f32x4 sv = *(const f32x4*)(sso + (size_t)(rowbase + u.pm * 256 + tid) * 4);
            const float c0 = sv[0] * (1.f / 512.f) + EPS, c1 = sv[1] * (1.f / 512.f) + EPS, c2 = sv[2] * (1.f / 512.f) + EPS, c3 = sv[3] * (1.f / 512.f) + EPS;
            *(LAS f32x4*)(tab + tid * 4) = (f32x4){__builtin_sqrtf(c1 * frcp(c0)), __builtin_sqrtf(c2 * frcp(c1)), __builtin_sqrtf(c3 * frcp(c2)), rsq(c3)};
        }
    }
    __device__ __forceinline__ void mid(f32x4 (&acc)[2][2][4][2], const LAS float* tab, int seg, int wr, int fr) const {
#pragma unroll
        for (int ai = 0; ai < 2; ++ai)
#pragma unroll
            for (int m = 0; m < 4; ++m) {
                const float f = tab[(ai * 128 + wr * 64 + m * 16 + fr) * 4 + seg];
#pragma unroll
                for (int bj = 0; bj < 2; ++bj)
#pragma unroll
                    for (int n = 0; n < 2; ++n) acc[ai][bj][m][n] = acc[ai][bj][m][n] * f;
            }
    }
    __device__ __forceinline__ void operator()(const f32x4 (&acc)[2][2][4][2], const Unit& u, int wr, int wc, int fr, int fq) const {}
    __device__ __forceinline__ void fin(const f32x4 (&acc)[2][2][4][2], const LAS float* tab, const Unit& u, int wr, int wc, int fr, int fq) const {
        const int row0 = u.pm * 256 + wr * 64 + fr, col0 = u.pn * 256 + wc * 32 + 8 * fq;
#pragma unroll
        for (int ai = 0; ai < 2; ++ai)
#pragma unroll
            for (int m = 0; m < 4; ++m) {
                const int row = row0 + ai * 128 + m * 16; const float rn3 = tab[(ai * 128 + wr * 64 + m * 16 + fr) * 4 + 3];
#pragma unroll
                for (int bj = 0; bj < 2; ++bj) {
                    const int col = col0 + bj * 128; float v[8], gt[8], t1[8];
                    unpack8(*(const u32x4*)(Z + (size_t)row * INC + 9216 + col), gt);
                    unpack8(*(const u32x4*)(T1 + (size_t)row * 1024 + col), t1);
#pragma unroll
                    for (int e = 0; e < 4; ++e) { v[e] = t1[e] + acc[ai][bj][m][0][e] * rn3 * gt[e]; v[4 + e] = t1[4 + e] + acc[ai][bj][m][1][e] * rn3 * gt[4 + e]; }
                    *(u32x4*)(M1 + (size_t)(rowbase + row) * 1024 + col) = pack8(v);
                }
            }
    }
};
struct EpiX2 {
    static constexpr bool RESCALE = false;
    const float* xp; const float* xs; float* out; bf16_t* X2b; float* ss2;
    __device__ __forceinline__ void operator()(const f32x4 (&acc)[2][2][4][2], const Unit& u, int wr, int wc, int fr, int fq) const {
        const int row0 = u.pm * 256 + wr * 64 + fr, col0 = u.pn * 256 + wc * 32 + 8 * fq, lane = fr + 16 * fq;
#pragma unroll
        for (int ai = 0; ai < 2; ++ai)
#pragma unroll
            for (int m = 0; m < 4; ++m) {
                const int row = row0 + ai * 128 + m * 16;
                const float* xr = row < 16384 ? xp + (size_t)row * 1024 : (row < 16640 ? xs + (size_t)(row - 16384) * 1024 : xp + (size_t)(row - 256) * 1024);
                float* yr = row < 16384 ? out + O_YP + (size_t)row * 1024 : (row < 16640 ? out + O_YS + (size_t)(row - 16384) * 1024 : out + O_YP + (size_t)(row - 256) * 1024);
                float ss = 0.f;
#pragma unroll
                for (int bj = 0; bj < 2; ++bj) {
                    const int col = col0 + bj * 128; float v[8];
                    const f32x4 x0 = *(const f32x4*)(xr + col), x1 = *(const f32x4*)(xr + col + 4);
#pragma unroll
                    for (int e = 0; e < 4; ++e) { v[e] = acc[ai][bj][m][0][e] + x0[e]; v[4 + e] = acc[ai][bj][m][1][e] + x1[e]; }
#pragma unroll
                    for (int e = 0; e < 8; ++e) ss += v[e] * v[e];
                    *(f32x4*)(yr + col) = (f32x4){v[0], v[1], v[2], v[3]}; *(f32x4*)(yr + col + 4) = (f32x4){v[4], v[5], v[6], v[7]};
                    *(u32x4*)(X2b + (size_t)row * 1024 + col) = pack8(v);
                }
                ss += shx(ss, 16, lane); ss += shx(ss, 32, lane); if (fq == 0) atomicAdd(ss2 + row, ss);
            }
    }
};
struct EpiQP {
    static constexpr bool RESCALE = false;
    bf16_t* QP; const float* ss2;
    __device__ __forceinline__ void operator()(const f32x4 (&acc)[2][2][4][2], const Unit& u, int wr, int wc, int fr, int fq) const {
        const int row0 = u.pm * 256 + wr * 64 + fr, col0 = u.pn * 256 + wc * 32 + 8 * fq;
#pragma unroll
        for (int ai = 0; ai < 2; ++ai)
#pragma unroll
            for (int m = 0; m < 4; ++m) {
                const int row = row0 + ai * 128 + m * 16; const float rs = rsq(ss2[row] * (1.f / 1024.f) + EPS);
#pragma unroll
                for (int bj = 0; bj < 2; ++bj) {
                    const int col = col0 + bj * 128; float v[8];
#pragma unroll
                    for (int e = 0; e < 4; ++e) { v[e] = acc[ai][bj][m][0][e] * rs; v[4 + e] = acc[ai][bj][m][1][e] * rs; }
                    *(u32x4*)(QP + (size_t)row * 2048 + col) = pack8(v);
                }
            }
    }
};

__device__ __forceinline__ void convert_item(const Params& p, unsigned char* ws, size_t i) {
        const int d = (int)((i * 16) & 1023);
        unsigned ou[4], ov[4];
#pragma unroll
        for (int q = 0; q < 4; ++q) {
            const f32x4 a = *(const f32x4*)(p.eu + i * 16 + q * 4), g0 = *(const f32x4*)(p.g_ffn + d + q * 4), c = *(const f32x4*)(p.ev + i * 16 + q * 4);
            int u = __builtin_amdgcn_cvt_pk_fp8_f32(a[0] * g0[0] * EU_SCALE, a[1] * g0[1] * EU_SCALE, 0, false);
            u = __builtin_amdgcn_cvt_pk_fp8_f32(a[2] * g0[2] * EU_SCALE, a[3] * g0[3] * EU_SCALE, u, true);
            int v = __builtin_amdgcn_cvt_pk_fp8_f32(c[0] * EV_SCALE, c[1] * EV_SCALE, 0, false);
            v = __builtin_amdgcn_cvt_pk_fp8_f32(c[2] * EV_SCALE, c[3] * EV_SCALE, v, true);
            ou[q] = (unsigned)u; ov[q] = (unsigned)v;
        }
        *(u32x4*)(ws + OFF_EU + (i >> 6) * 2048 + (i & 63) * 16) = (u32x4){ou[0], ou[1], ou[2], ou[3]};
        *(u32x4*)(ws + OFF_EU + (i >> 6) * 2048 + 1024 + (i & 63) * 16) = (u32x4){ov[0], ov[1], ov[2], ov[3]};
    }
constexpr size_t CONV_ITEMS = (size_t)16384 * 64;

__device__ __forceinline__ void transpose_tile(const Ctx& cx, const float* src, bf16_t* dst, const float* scale, int K, int N, int tile, LAS float* tl) {
    const int tn = N / 64, k0 = (tile / tn) * 64, n0 = (tile % tn) * 64, tid = cx.tid;
    const int n4 = (tid & 15) * 4, kr = tid >> 4;
#pragma unroll
    for (int i = 0; i < 2; ++i) {
        const int kk = kr + 32 * i; f32x4 v = *(const f32x4*)(src + (size_t)(k0 + kk) * N + n0 + n4);
        if (scale) v = v * scale[k0 + kk];
        tl[kk * 65 + n4] = v[0]; tl[kk * 65 + n4 + 1] = v[1]; tl[kk * 65 + n4 + 2] = v[2]; tl[kk * 65 + n4 + 3] = v[3];
    }
    __syncthreads();
    const int n = tid >> 3, kc = (tid & 7) * 8; float o[8];
#pragma unroll
    for (int e = 0; e < 8; ++e) o[e] = tl[(kc + e) * 65 + n];
    *(u32x4*)(dst + (size_t)(n0 + n) * K + k0 + kc) = pack8(o);
    __syncthreads();
}
__device__ __forceinline__ void phase0(const Ctx& cx, const Params& p, LAS unsigned char* lds) {
    unsigned char* ws = p.ws; LAS float* tl = (LAS float*)lds;
    for (int j = cx.bid; j < 4096; j += cx.nb) {
        if (j < 2560) transpose_tile(cx, p.w_in, (bf16_t*)(ws + OFF_WIN), p.g_mix, 1024, 10240, j, tl);
        else if (j < 2816) transpose_tile(cx, p.w_pa, (bf16_t*)(ws + OFF_WA), nullptr, 1024, 1024, j - 2560, tl);
        else if (j < 3328) transpose_tile(cx, p.w_pb, (bf16_t*)(ws + OFF_WB), nullptr, 2048, 1024, j - 2816, tl);
        else if (j < 3584) transpose_tile(cx, p.w_out, (bf16_t*)(ws + OFF_WO), nullptr, 1024, 1024, j - 3328, tl);
        else transpose_tile(cx, p.w_q, (bf16_t*)(ws + OFF_WQ), p.g_ffn, 1024, 2048, j - 3584, tl);
    }
    const size_t gtid = (size_t)cx.bid * 512 + cx.tid, nth = (size_t)cx.nb * 512;
    for (size_t i = gtid; i < 16384; i += nth) { ((bf16_t*)(ws + OFF_K1))[i] = f2bf(p.k1[i]); ((bf16_t*)(ws + OFF_K2))[i] = f2bf(p.k2[i]); }
    for (size_t i = gtid; i < (size_t)NTOK * 6; i += nth) ((float*)(ws + OFF_SSV))[i] = 0.f;
    const int wid = __builtin_amdgcn_readfirstlane(cx.tid >> 6), lane = cx.tid & 63;
    bf16_t* xb = (bf16_t*)((unsigned char*)p.out + OUT_XB);
    for (int r = cx.bid * 8 + wid; r < NTOK; r += cx.nb * 8) {
        const float* xr = xrow(p, r); f32x4 v[4]; float ss = 0.f;
#pragma unroll
        for (int j = 0; j < 4; ++j) { v[j] = *(const f32x4*)(xr + lane * 8 + (j >> 1) * 512 + (j & 1) * 4); ss += v[j][0] * v[j][0] + v[j][1] * v[j][1] + v[j][2] * v[j][2] + v[j][3] * v[j][3]; }
        ss = wave_sum(ss, lane);
        const float rs = rsq(ss * (1.f / 1024.f) + EPS);
#pragma unroll
        for (int j = 0; j < 2; ++j)
            *(u32x4*)(xb + (size_t)r * 1024 + lane * 8 + j * 512) = (u32x4){pk_bf16(v[2 * j][0] * rs, v[2 * j][1] * rs), pk_bf16(v[2 * j][2] * rs, v[2 * j][3] * rs),
                                                                          pk_bf16(v[2 * j + 1][0] * rs, v[2 * j + 1][1] * rs), pk_bf16(v[2 * j + 1][2] * rs, v[2 * j + 1][3] * rs)};
    }
}

__device__ __forceinline__ void retention_unit(const Ctx& cx, LAS unsigned char* lds, bf16_t* Z, int zrow0, int grow0, int nchunks, int Lc, int pos0, int h, int slice,
                               const float* s0, float* s_out, float* sso) {
    LAS bf16_t* Qs = (LAS bf16_t*)lds; LAS bf16_t* Ks = (LAS bf16_t*)(lds + 33792); LAS bf16_t* ST = (LAS bf16_t*)(lds + 67584);
    LAS bf16_t* VT = (LAS bf16_t*)(lds + 101376); LAS bf16_t* Ps = (LAS bf16_t*)(lds + 110592);
    const int tid = cx.tid, wid = __builtin_amdgcn_readfirstlane(tid >> 6), lane = tid & 63, fr = lane & 15, fq = lane >> 4;
    const float l2g = log2f(1.f - exp2f(-5.f - (float)h));
    f32x4 accS[2][4];
#pragma unroll
    for (int dt = 0; dt < 2; ++dt)
#pragma unroll
        for (int dvt = 0; dvt < 4; ++dvt) {
#pragma unroll
            for (int j = 0; j < 4; ++j) { const int d = (2 * wid + dt) * 16 + fq * 4 + j; accS[dt][dvt][j] = s0 ? s0[(size_t)d * 512 + slice * 64 + dvt * 16 + fr] : 0.f; }
            *(LAS u32x2*)(ST + (dvt * 16 + fr) * 264 + (2 * wid + dt) * 16 + fq * 4) = (u32x2){pk_bf16(accS[dt][dvt][0], accS[dt][dvt][1]), pk_bf16(accS[dt][dvt][2], accS[dt][dvt][3])};
        }
    const float sdec = fexp2(l2g * (float)Lc);
    __syncthreads();
    u32x4 rq1[2], rq2[2], rk1[2], rk2[2], rv; u32x2 rsg[2];
    const int vm = tid >> 3, vc0 = (tid & 7) * 8;
    auto fetch = [&](int c) {
        const size_t zr = (size_t)(zrow0 + c * 64);
#pragma unroll
        for (int it = 0; it < 2; ++it) {
            const int item = tid + 512 * it, n = item >> 4, dc = (item & 15) * 8;
            rq1[it] = (u32x4){0, 0, 0, 0}; rq2[it] = rq1[it]; rk1[it] = rq1[it]; rk2[it] = rq1[it];
            if (n < Lc) {
                const bf16_t* zp = Z + (zr + n) * INC + 2048 + h * 256 + dc;
                rq1[it] = *(const u32x4*)zp; rq2[it] = *(const u32x4*)(zp + 128); rk1[it] = *(const u32x4*)(zp + 1024); rk2[it] = *(const u32x4*)(zp + 1152);
            }
        }
        rv = (u32x4){0, 0, 0, 0};
        if (vm < Lc) rv = *(const u32x4*)(Z + (zr + vm) * INC + 4096 + h * 512 + slice * 64 + vc0);
#pragma unroll
        for (int i = 0; i < 2; ++i) {
            rsg[i] = (u32x2){0, 0};
            const int n = (wid >> 1) * 16 + fr;
            if (n < Lc) rsg[i] = *(const u32x2*)(Z + (zr + n) * INC + 6144 + h * 512 + slice * 64 + (2 * (wid & 1) + i) * 16 + fq * 4);
        }
    };
    fetch(0);
    for (int c = 0; c < nchunks; ++c) {
        const size_t zr = (size_t)(zrow0 + c * 64);
#pragma unroll
        for (int it = 0; it < 2; ++it) {
            const int item = tid + 512 * it, n = item >> 4, dc = (item & 15) * 8;
            *(LAS u32x4*)(Qs + n * 264 + dc) = rq1[it]; *(LAS u32x4*)(Qs + n * 264 + 128 + dc) = rq2[it];
            *(LAS u32x4*)(Ks + n * 264 + dc) = rk1[it]; *(LAS u32x4*)(Ks + n * 264 + 128 + dc) = rk2[it];
        }
        {
            float v[8]; unpack8(rv, v);
            const float kd = fexp2(l2g * (float)(Lc - 1 - vm));
#pragma unroll
            for (int e = 0; e < 8; ++e) v[e] *= kd;
            *(LAS u32x4*)(VT + vm * 72 + vc0) = pack8(v);
        }
        __syncthreads();
        u32x2 sgc[2] = {rsg[0], rsg[1]};
        if (c + 1 < nchunks) fetch(c + 1);
        const int nt = wid >> 1;
#pragma unroll
        for (int mi = 0; mi < 2; ++mi) {
            const int mt = 2 * (wid & 1) + mi; f32x4 acc = (f32x4){0.f, 0.f, 0.f, 0.f};
            if (mt <= nt) {
#pragma unroll
                for (int ks = 0; ks < 8; ++ks) {
                    const bf16x8 a = *(const LAS bf16x8*)(Qs + (nt * 16 + fr) * 264 + ks * 32 + fq * 8), b = *(const LAS bf16x8*)(Ks + (mt * 16 + fr) * 264 + ks * 32 + fq * 8);
                    acc = MFMA16(a, b, acc);
                }
            }
#pragma unroll
            for (int j = 0; j < 4; ++j) {
                const int n = nt * 16 + fq * 4 + j, m = mt * 16 + fr;
                const float val = (m <= n) ? acc[j] * fexp2(l2g * (float)(n - (Lc - 1))) : 0.f;
                Ps[n * 72 + m] = f2bf(val);
            }
        }
        f32x4 accO[2];
#pragma unroll
        for (int i = 0; i < 2; ++i) {
            const int dvt = 2 * (wid & 1) + i; accO[i] = (f32x4){0.f, 0.f, 0.f, 0.f};
#pragma unroll
            for (int ks = 0; ks < 8; ++ks) {
                const bf16x8 a = *(const LAS bf16x8*)(ST + (dvt * 16 + fr) * 264 + ks * 32 + fq * 8), b = *(const LAS bf16x8*)(Qs + (nt * 16 + fr) * 264 + ks * 32 + fq * 8);
                accO[i] = MFMA16(a, b, accO[i]);
            }
            const float qd = fexp2(l2g * (float)(nt * 16 + fr + 1));
            accO[i] = accO[i] * qd;
        }
        __syncthreads();
#pragma unroll
        for (int i = 0; i < 2; ++i) {
            const int dvt = 2 * (wid & 1) + i;
#pragma unroll
            for (int ks = 0; ks < 2; ++ks) {
                const bf16x8 a = tr_frag(VT + ks * 32 * 72 + dvt * 16, 72, lane), b = *(const LAS bf16x8*)(Ps + (nt * 16 + fr) * 72 + ks * 32 + fq * 8);
                accO[i] = MFMA16(a, b, accO[i]);
            }
        }
#pragma unroll
        for (int dt = 0; dt < 2; ++dt)
#pragma unroll
            for (int dvt = 0; dvt < 4; ++dvt) accS[dt][dvt] = accS[dt][dvt] * sdec;
#pragma unroll
        for (int ks = 0; ks < 2; ++ks) {
            bf16x8 bv[4];
#pragma unroll
            for (int dvt = 0; dvt < 4; ++dvt) bv[dvt] = tr_frag(VT + ks * 32 * 72 + dvt * 16, 72, lane);
#pragma unroll
            for (int dt = 0; dt < 2; ++dt) {
                const bf16x8 a = tr_frag(Ks + ks * 32 * 264 + (2 * wid + dt) * 16, 264, lane);
#pragma unroll
                for (int dvt = 0; dvt < 4; ++dvt) accS[dt][dvt] = MFMA16(a, bv[dvt], accS[dt][dvt]);
            }
        }
#pragma unroll
        for (int dt = 0; dt < 2; ++dt)
#pragma unroll
            for (int dvt = 0; dvt < 4; ++dvt)
                *(LAS u32x2*)(ST + (dvt * 16 + fr) * 264 + (2 * wid + dt) * 16 + fq * 4) = (u32x2){pk_bf16(accS[dt][dvt][0], accS[dt][dvt][1]), pk_bf16(accS[dt][dvt][2], accS[dt][dvt][3])};
        {
            float ss = 0.f; const int n = nt * 16 + fr;
#pragma unroll
            for (int i = 0; i < 2; ++i) {
                const int dvt = 2 * (wid & 1) + i;
                ss += accO[i][0] * accO[i][0] + accO[i][1] * accO[i][1] + accO[i][2] * accO[i][2] + accO[i][3] * accO[i][3];
                if (n < Lc) *(u32x2*)(Z + (zr + n) * INC + 4096 + h * 512 + slice * 64 + dvt * 16 + fq * 4) =
                    (u32x2){pk_bf16(accO[i][0] * bf_lo(sgc[i][0]), accO[i][1] * bf_hi(sgc[i][0])), pk_bf16(accO[i][2] * bf_lo(sgc[i][1]), accO[i][3] * bf_hi(sgc[i][1]))};
            }
            ss += shx(ss, 16, lane); ss += shx(ss, 32, lane);
            if (fq == 0 && n < Lc) atomicAdd(sso + (size_t)(grow0 + c * 64 + n) * 4 + h, ss);
        }
        __syncthreads();
    }
#pragma unroll
    for (int dt = 0; dt < 2; ++dt)
#pragma unroll
        for (int dvt = 0; dvt < 4; ++dvt)
#pragma unroll
            for (int j = 0; j < 4; ++j) { const int d = (2 * wid + dt) * 16 + fq * 4 + j; s_out[(size_t)d * 512 + slice * 64 + dvt * 16 + fr] = accS[dt][dvt][j]; }
}

__device__ __forceinline__ void sgu_unit(const Ctx& cx, const Params& p, LAS unsigned char* lds, bf16_t* Z, int zrow0, int grow0, int rows, int g, float* vout, const float* ssv, bool load_w) {
    LAS bf16_t* WS = (LAS bf16_t*)lds; LAS bf16_t* VT = (LAS bf16_t*)(lds + 34816);
    const int tid = cx.tid, wid = __builtin_amdgcn_readfirstlane(tid >> 6), lane = tid & 63, fr = lane & 15, fq = lane >> 4;
    if (load_w)
#pragma unroll
    for (int it = 0; it < 4; ++it) {
        const int item = tid + 512 * it, n = item >> 4, m0 = (item & 15) * 8;
        const float* src = p.w_s + ((size_t)g * 128 + n) * 128 + m0;
        const f32x4 a = *(const f32x4*)src, b = *(const f32x4*)(src + 4); float v[8];
#pragma unroll
        for (int e = 0; e < 4; ++e) { v[e] = (m0 + e <= n) ? a[e] : 0.f; v[4 + e] = (m0 + 4 + e <= n) ? b[e] : 0.f; }
        *(LAS u32x4*)(WS + n * 136 + m0) = pack8(v);
    }
#pragma unroll
    for (int it = 0; it < 4; ++it) {
        const int item = tid + 512 * it, m = item >> 4, d0 = (item & 15) * 8; float v[8];
#pragma unroll
        for (int e = 0; e < 8; ++e) v[e] = 0.f;
        if (m < rows) {
            unpack8(*(const u32x4*)(Z + (size_t)(zrow0 + m) * INC + 1024 + g * 128 + d0), v);
            const float rs = rsq(ssv[grow0 + m] * (1.f / 1024.f) + EPS);
            const f32x4 g0 = *(const f32x4*)(p.g_sgu + g * 128 + d0), g1 = *(const f32x4*)(p.g_sgu + g * 128 + d0 + 4);
#pragma unroll
            for (int e = 0; e < 4; ++e) { v[e] *= rs * g0[e]; v[4 + e] *= rs * g1[e]; }
            if (vout) { *(f32x4*)(vout + (size_t)m * 1024 + g * 128 + d0) = (f32x4){v[0], v[1], v[2], v[3]}; *(f32x4*)(vout + (size_t)m * 1024 + g * 128 + d0 + 4) = (f32x4){v[4], v[5], v[6], v[7]}; }
        }
        *(LAS u32x4*)(VT + m * 136 + d0) = pack8(v);
    }
    u32x2 uu[8]; float bias = 0.f;
    if (wid * 16 < rows) {
        bias = p.b_s[g * 128 + wid * 16 + fr];
#pragma unroll
        for (int dt = 0; dt < 8; ++dt) uu[dt] = *(const u32x2*)(Z + (size_t)(zrow0 + wid * 16 + fr) * INC + g * 128 + dt * 16 + fq * 4);
    }
    __syncthreads();
    if (wid * 16 < rows) {
        const int nks = (wid >> 1) + 1;
        f32x4 acc[8];
#pragma unroll
        for (int dt = 0; dt < 8; ++dt) acc[dt] = (f32x4){0.f, 0.f, 0.f, 0.f};
        for (int ks = 0; ks < nks; ++ks) {
            const bf16x8 b = *(const LAS bf16x8*)(WS + (wid * 16 + fr) * 136 + ks * 32 + fq * 8);
#pragma unroll
            for (int dt = 0; dt < 8; ++dt) { const bf16x8 a = tr_frag(VT + ks * 32 * 136 + dt * 16, 136, lane); acc[dt] = MFMA16(a, b, acc[dt]); }
        }
        const int n = wid * 16 + fr;
#pragma unroll
        for (int dt = 0; dt < 8; ++dt) {
            bf16_t* up = Z + (size_t)(zrow0 + n) * INC + g * 128 + dt * 16 + fq * 4;
            *(u32x2*)up = (u32x2){pk_bf16(bf_lo(uu[dt][0]) * (acc[dt][0] + bias), bf_hi(uu[dt][0]) * (acc[dt][1] + bias)), pk_bf16(bf_lo(uu[dt][1]) * (acc[dt][2] + bias), bf_hi(uu[dt][1]) * (acc[dt][3] + bias))};
        }
    }
    __syncthreads();
}

__device__ __forceinline__ void phase2(const Ctx& cx, const Params& p, LAS unsigned char* lds, int hf) {
    unsigned char* ws = p.ws; bf16_t* Z = (bf16_t*)(ws + OFF_Z); float* sso = (float*)(ws + OFF_SSO); const float* ssv = (const float*)(ws + OFF_SSV);
    const int rowbase = hf ? NH0 : 0;
    for (int u = cx.bid; u < 256; u += cx.nb) {
        const int slice = u & 7, h = (u >> 3) & 3, bl = u >> 5, b = hf * 8 + bl;
        retention_unit(cx, lds, Z, bl * 2048, rowbase + bl * 2048, 32, 64, 0, h, slice, nullptr, p.out + O_SP + ((size_t)b * 4 + h) * 256 * 512, sso);
    }
    if (hf == 0) {
        for (int u = cx.bid; u < 512; u += cx.nb) {
            const int slice = u & 7, h = (u >> 3) & 3, b = u >> 5;
            retention_unit(cx, lds, Z, 16384 + b * 16, 16384 + b * 16, 1, 16, 1024, h, slice, p.state + ((size_t)b * 4 + h) * 256 * 512,
                           p.out + O_SS + ((size_t)b * 4 + h) * 256 * 512, sso);
        }
    }
    const int nprompt = 128 * 8, nsgu = nprompt + (hf == 0 ? 16 * 8 : 0);
    int last_g = -1;
    for (int u = cx.bid; u < nsgu; u += cx.nb) {
        if (u < nprompt) { const int g = u & 7, ci = u >> 3; sgu_unit(cx, p, lds, Z, ci * 128, rowbase + ci * 128, 128, g, nullptr, ssv, g != last_g); last_g = g; }
        else { const int v = u - nprompt, g = v & 7, b = v >> 3; sgu_unit(cx, p, lds, Z, 16384 + b * 16, 16384 + b * 16, 16, g, p.out + O_SV + (size_t)b * 16 * 1024, ssv, g != last_g); last_g = g; }
    }
}

#define CE_DESC(x, i, l) do { const float _a = fmaxf(x[i], x[l]), _b = fminf(x[i], x[l]); x[i] = _a; x[l] = _b; } while (0)
__device__ __forceinline__ void bitonic_sort16_desc(float (&x)[16]) {
#pragma unroll
    for (int k = 2; k <= 16; k <<= 1)
#pragma unroll
        for (int j = k >> 1; j > 0; j >>= 1)
#pragma unroll
            for (int i = 0; i < 16; ++i) {
                const int l = i ^ j;
                if (l > i) { if ((i & k) == 0 || k == 16) CE_DESC(x, i, l); else CE_DESC(x, l, i); }
            }
}
__device__ __forceinline__ void bitonic_merge16_desc(float (&x)[16]) {
#pragma unroll
    for (int j = 8; j > 0; j >>= 1)
#pragma unroll
        for (int i = 0; i < 16; ++i) { const int l = i ^ j; if (l > i) CE_DESC(x, i, l); }
}
#define TOPK_INS_FROM(L, x, S0) do { float _v = (x); _Pragma("unroll") for (int _i = (S0); _i < 16; ++_i) { const float _h = fmaxf(L[_i], _v); _v = fminf(L[_i], _v); L[_i] = _h; } } while (0)
__device__ __forceinline__ void phase7(const Ctx& cx, const Params& p, LAS unsigned char* lds) {
    unsigned char* ws = p.ws; const bf16_t* QP = (const bf16_t*)(ws + OFF_QP); int* ids = (int*)(ws + OFF_IDS); float* wts = (float*)(ws + OFF_WTS);
    LAS bf16_t* KEYS = (LAS bf16_t*)lds;
    LAS float* SC = (LAS float*)(lds + 69632);
    LAS float* TP = (LAS float*)(lds + 69632 + 67584);
    const int tid = cx.tid, wid = __builtin_amdgcn_readfirstlane(tid >> 6), lane = tid & 63, fr = lane & 15, fq = lane >> 4;
#pragma unroll
    for (int it = 0; it < 8; ++it) {
        const int idx = tid + 512 * it, tab = idx >> 11, row = (idx >> 4) & 127, c8 = (idx & 15) * 8;
        *(LAS u32x4*)(KEYS + tab * 17408 + row * 136 + c8) = *(const u32x4*)((const bf16_t*)(ws + (tab ? OFF_K2 : OFF_K1)) + row * 128 + c8);
    }
    bf16x8 a[2][4], an[2][4];
    auto load_a = [&](int tile, bf16x8 (&d)[2][4]) {
#pragma unroll
        for (int half = 0; half < 2; ++half)
#pragma unroll
            for (int ks = 0; ks < 4; ++ks) d[half][ks] = *(const bf16x8*)(QP + (size_t)(tile * 16 + fr) * 2048 + wid * 256 + half * 128 + ks * 32 + fq * 8);
    };
    if (cx.bid < NTOK / 16) load_a(cx.bid, an);
    __syncthreads();
    const size_t cv_end = CONV_ITEMS * (size_t)(cx.bid + 1) / (size_t)cx.nb; size_t cv_pos = CONV_ITEMS * (size_t)cx.bid / (size_t)cx.nb;
    for (int tile = cx.bid; tile < NTOK / 16; tile += cx.nb) {
        const int row0 = tile * 16;
#pragma unroll
        for (int half = 0; half < 2; ++half)
#pragma unroll
            for (int ks = 0; ks < 4; ++ks) a[half][ks] = an[half][ks];
        if (tile + cx.nb < NTOK / 16) load_a(tile + cx.nb, an);
#pragma unroll
        for (int half = 0; half < 2; ++half) {
#pragma unroll
            for (int nt = 0; nt < 8; ++nt) {
                f32x4 acc = (f32x4){0.f, 0.f, 0.f, 0.f};
#pragma unroll
                for (int ks = 0; ks < 4; ++ks) acc = MFMA16(a[half][ks], *(const LAS bf16x8*)(KEYS + half * 17408 + (nt * 16 + fr) * 136 + ks * 32 + fq * 8), acc);
#pragma unroll
                for (int j = 0; j < 4; ++j) {
                    const int t = fq * 4 + j, list = t * 8 + wid, n = nt * 16 + fr;
                    SC[list * 132 + ((n + 8 * fq) & 127)] = __uint_as_float((__float_as_uint(acc[j]) & ~127u) | (unsigned)n);
                }
            }
            __syncthreads();
            if (tid < 256) {
                const int list = tid >> 1, part = tid & 1; const LAS float* sp = SC + list * 132 + part * 64;
                float T[16];
#pragma unroll
                for (int i = 0; i < 4; ++i) { const f32x4 v = *(const LAS f32x4*)(sp + i * 4); T[4 * i] = v[0]; T[4 * i + 1] = v[1]; T[4 * i + 2] = v[2]; T[4 * i + 3] = v[3]; }
                bitonic_sort16_desc(T);
#pragma unroll 1
                for (int grp = 1; grp < 4; ++grp) {
                    float G[16];
#pragma unroll
                    for (int i = 0; i < 4; ++i) { const f32x4 v = *(const LAS f32x4*)(sp + grp * 16 + i * 4); G[4 * i] = v[0]; G[4 * i + 1] = v[1]; G[4 * i + 2] = v[2]; G[4 * i + 3] = v[3]; }
                    bitonic_sort16_desc(G);
#pragma unroll
                    for (int i = 0; i < 16; ++i) T[i] = fmaxf(T[i], G[15 - i]);
                    bitonic_merge16_desc(T);
                }
                float O[16];
#pragma unroll
                for (int i = 0; i < 16; ++i) O[i] = __int_as_float(__builtin_amdgcn_update_dpp(0, __float_as_int(T[i]), 0xB1, 0xF, 0xF, true));
#pragma unroll
                for (int i = 0; i < 16; ++i) T[i] = fmaxf(T[i], O[15 - i]);
                bitonic_merge16_desc(T);
                if (part == 0) {
#pragma unroll
                    for (int i = 0; i < 4; ++i) *(LAS f32x4*)(TP + (list * 2 + half) * 20 + i * 4) = (f32x4){T[4 * i], T[4 * i + 1], T[4 * i + 2], T[4 * i + 3]};
                }
            } else if (cv_pos + (size_t)(tid - 256) < cv_end) convert_item(p, ws, cv_pos + (size_t)(tid - 256));
            cv_pos += 256;
            __syncthreads();
        }
        if (tid < 128) {
            float v1[16], v2[16], L[16];
#pragma unroll
            for (int i = 0; i < 4; ++i) {
                const f32x4 va = *(const LAS f32x4*)(TP + (tid * 2) * 20 + i * 4), vb = *(const LAS f32x4*)(TP + (tid * 2 + 1) * 20 + i * 4);
#pragma unroll
                for (int e = 0; e < 4; ++e) { v1[4 * i + e] = va[e]; v2[4 * i + e] = vb[e]; }
            }
#pragma unroll
            for (int jj = 0; jj < 16; ++jj) { const float c = v1[0] + v2[jj]; L[jj] = __uint_as_float((__float_as_uint(c) & ~255u) | (unsigned)jj); }
#pragma unroll
            for (int i = 1; i < 16; ++i)
#pragma unroll
                for (int jj = 0; jj < 16; ++jj)
                    if ((i + 1) * (jj + 1) <= 16) { const float c = v1[i] + v2[jj]; TOPK_INS_FROM(L, __uint_as_float((__float_as_uint(c) & ~255u) | (unsigned)(i * 16 + jj)), (i + 1) * (jj + 1) - 1); }
            float ex[16], sum = 0.f;
#pragma unroll
            for (int k = 0; k < 16; ++k) { ex[k] = fexp2((L[k] - L[0]) * 1.44269504f); sum += ex[k]; }
            const float rinv = 1.f / sum;
#pragma unroll
            for (int k = 0; k < 16; ++k) {
                const unsigned code = __float_as_uint(L[k]) & 255u;
                const unsigned e1 = __float_as_uint(TP[(tid * 2) * 20 + (code >> 4)]) & 127u, e2 = __float_as_uint(TP[(tid * 2 + 1) * 20 + (code & 15u)]) & 127u;
                ((LAS int*)SC)[tid * 16 + k] = (int)(e1 * 128u + e2); SC[2048 + tid * 16 + k] = ex[k] * rinv;
            }
        }
        __syncthreads();
        *(u32x4*)(ids + (size_t)row0 * 128 + tid * 4) = *(const LAS u32x4*)((LAS int*)SC + tid * 4);
        *(f32x4*)(wts + (size_t)row0 * 128 + tid * 4) = *(const LAS f32x4*)(SC + 2048 + tid * 4);
        __syncthreads();
    }
    for (size_t it = cv_pos + tid; it < cv_end; it += 512) convert_item(p, ws, it);
}

__device__ __forceinline__ void phase8(const Ctx& cx, const Params& p, LAS unsigned char* lds) {
    unsigned char* ws = p.ws; const unsigned char* EU = ws + OFF_EU; const unsigned char* EV = ws + OFF_EV;
    const int* ids = (const int*)(ws + OFF_IDS); const float* wts = (const float*)(ws + OFF_WTS);
    const float* ss2 = (const float*)(ws + OFF_SS2);
    const int tid = cx.tid, wid = __builtin_amdgcn_readfirstlane(tid >> 6), lane = tid & 63, fr = lane & 15, fq = lane >> 4;
    const int nfull = (NTOK / (cx.nb * 8)) * (cx.nb * 8);
    const unsigned char* ET = ws + OFF_EU;
    int nid0 = 0, nid1 = 0; float nw0 = 0.f, nw1 = 0.f, nr2 = 0.f;
    auto fetch_ids = [&](int r, int& i0_, int& i1_, float& a0, float& a1, float& rr) {
        i0_ = ids[(size_t)r * 128 + lane] & 16383; i1_ = ids[(size_t)r * 128 + 64 + lane] & 16383;
        a0 = wts[(size_t)r * 128 + lane]; a1 = wts[(size_t)r * 128 + 64 + lane];
        rr = rsq(ss2[r] * (1.f / 1024.f) + EPS) * (1.f / EU_SCALE);
    };
    if (cx.bid * 8 + wid < nfull) fetch_ids(cx.bid * 8 + wid, nid0, nid1, nw0, nw1, nr2);
    for (int r = cx.bid * 8 + wid; r < nfull; r += cx.nb * 8) {
        const int id0 = nid0, id1 = nid1; const float w0 = nw0, w1 = nw1, r2 = nr2;
        float* yr = yrow(p, r);
        f32x2 tq[4][8];
#pragma unroll
        for (int j = 0; j < 4; ++j)
#pragma unroll
            for (int q = 0; q < 4; ++q) { const f32x4 v = *(const f32x4*)(yr + (fr + 16 * j) * 16 + q * 4); tq[j][2 * q] = (f32x2){v[0], v[1]}; tq[j][2 * q + 1] = (f32x2){v[2], v[3]}; }
        if (r + cx.nb * 8 < nfull) fetch_ids(r + cx.nb * 8, nid0, nid1, nw0, nw1, nr2);
        f32x2 acc[4][8];
#pragma unroll
        for (int j = 0; j < 4; ++j)
#pragma unroll
            for (int q = 0; q < 8; ++q) acc[j][q] = (f32x2){0.f, 0.f};
#pragma unroll 2
        for (int it = 0; it < 32; ++it) {
            const int src = ((it & 15) << 2) + fq;
            const int e = it < 16 ? shl_(id0, src) : shl_(id1, src);
            const float w = it < 16 ? shl_(w0, src) : shl_(w1, src);
            const unsigned char* rp = ET + (size_t)e * 2048 + fr * 16;
            u32x4 du[4], dv[4];
#pragma unroll
            for (int j = 0; j < 4; ++j) { du[j] = *(const u32x4*)(rp + j * 256); dv[j] = *(const u32x4*)(rp + 1024 + j * 256); }
            f32x2 s2 = (f32x2){0.f, 0.f};
#pragma unroll
            for (int j = 0; j < 4; ++j)
#pragma unroll
                for (int q = 0; q < 4; ++q) {
                    s2 = __builtin_amdgcn_cvt_pk_f32_fp8((int)du[j][q], false) * tq[j][2 * q] + s2;
                    s2 = __builtin_amdgcn_cvt_pk_f32_fp8((int)du[j][q], true) * tq[j][2 * q + 1] + s2;
                }
            const float sd = row16_sum(s2[0] + s2[1]);
            const float c = w * gelu_t(r2 * sd) * (1.f / EV_SCALE); const f32x2 cc = (f32x2){c, c};
#pragma unroll
            for (int j = 0; j < 4; ++j)
#pragma unroll
                for (int q = 0; q < 4; ++q) {
                    acc[j][2 * q] = __builtin_amdgcn_cvt_pk_f32_fp8((int)dv[j][q], false) * cc + acc[j][2 * q];
                    acc[j][2 * q + 1] = __builtin_amdgcn_cvt_pk_f32_fp8((int)dv[j][q], true) * cc + acc[j][2 * q + 1];
                }
        }
        float ss = 0.f;
#pragma unroll
        for (int j = 0; j < 4; ++j)
#pragma unroll
            for (int q = 0; q < 8; ++q)
#pragma unroll
                for (int h2 = 0; h2 < 2; ++h2) { float v = acc[j][q][h2]; v += shx(v, 16, lane); v += shx(v, 32, lane); acc[j][q][h2] = v; }
        if (fq == 0) {
#pragma unroll
            for (int j = 0; j < 4; ++j)
#pragma unroll
                for (int q = 0; q < 4; ++q) {
                    const f32x4 xv = *(const f32x4*)(yr + (fr + 16 * j) * 16 + q * 4);
                    acc[j][2 * q][0] += xv[0]; acc[j][2 * q][1] += xv[1]; acc[j][2 * q + 1][0] += xv[2]; acc[j][2 * q + 1][1] += xv[3];
                    ss += acc[j][2 * q][0] * acc[j][2 * q][0] + acc[j][2 * q][1] * acc[j][2 * q][1] + acc[j][2 * q + 1][0] * acc[j][2 * q + 1][0] + acc[j][2 * q + 1][1] * acc[j][2 * q + 1][1];
                }
        }
        ss = wave_sum(ss, lane);
        const float rs = rsq(ss * (1.f / 1024.f) + EPS);
        if (fq == 0) {
#pragma unroll
            for (int j = 0; j < 4; ++j)
#pragma unroll
                for (int q = 0; q < 4; ++q) {
                    const f32x4 g0 = *(const f32x4*)(p.g_final + (fr + 16 * j) * 16 + q * 4);
                    *(f32x4*)(yr + (fr + 16 * j) * 16 + q * 4) = (f32x4){acc[j][2 * q][0], acc[j][2 * q][1], acc[j][2 * q + 1][0], acc[j][2 * q + 1][1]} * rs * g0;
                }
        }
    }
    LAS float* cfb = (LAS float*)lds; LAS float* part = (LAS float*)(lds + 4096);
    __syncthreads();
    for (int r = nfull + cx.bid; r < NTOK; r += cx.nb) {
        const int id0 = ids[(size_t)r * 128 + lane] & 16383, id1 = ids[(size_t)r * 128 + 64 + lane] & 16383;
        const float w0 = wts[(size_t)r * 128 + lane], w1 = wts[(size_t)r * 128 + 64 + lane];
        const float r2 = rsq(ss2[r] * (1.f / 1024.f) + EPS) * (1.f / EU_SCALE);
        float* yr = yrow(p, r);
        f32x2 tq[4][8];
#pragma unroll
        for (int j = 0; j < 4; ++j)
#pragma unroll
            for (int q = 0; q < 4; ++q) { const f32x4 v = *(const f32x4*)(yr + (fr + 16 * j) * 16 + q * 4); tq[j][2 * q] = (f32x2){v[0], v[1]}; tq[j][2 * q + 1] = (f32x2){v[2], v[3]}; }
#pragma unroll
        for (int i4 = 0; i4 < 4; ++i4) {
            const int it = wid * 4 + i4, src = ((it & 15) << 2) + fq;
            const int e = it < 16 ? shl_(id0, src) : shl_(id1, src);
            const float w = it < 16 ? shl_(w0, src) : shl_(w1, src);
            const unsigned char* rp = ET + (size_t)e * 2048 + fr * 16;
            u32x4 d[4];
#pragma unroll
            for (int j = 0; j < 4; ++j) d[j] = *(const u32x4*)(rp + j * 256);
            f32x2 s2 = (f32x2){0.f, 0.f};
#pragma unroll
            for (int j = 0; j < 4; ++j)
#pragma unroll
                for (int q = 0; q < 4; ++q) {
                    s2 = __builtin_amdgcn_cvt_pk_f32_fp8((int)d[j][q], false) * tq[j][2 * q] + s2;
                    s2 = __builtin_amdgcn_cvt_pk_f32_fp8((int)d[j][q], true) * tq[j][2 * q + 1] + s2;
                }
            const float sd = row16_sum(s2[0] + s2[1]);
            if (fr == 0) cfb[it * 4 + fq] = w * gelu_t(r2 * sd) * (1.f / EV_SCALE);
        }
        __syncthreads();
        const float c0 = cfb[lane], c1 = cfb[64 + lane];
        const int idsel = wid < 4 ? id0 : id1; const float csel = wid < 4 ? c0 : c1;
        f32x2 acc[8];
#pragma unroll
        for (int i = 0; i < 8; ++i) acc[i] = (f32x2){0.f, 0.f};
#pragma unroll
        for (int k16 = 0; k16 < 16; ++k16) {
            const int kk = (wid & 3) * 16 + k16;
            const int e = __builtin_amdgcn_readlane(idsel, kk); const float c = __int_as_float(__builtin_amdgcn_readlane(__float_as_int(csel), kk));
            const u32x4 v = *(const u32x4*)(ET + (size_t)e * 2048 + 1024 + lane * 16); const f32x2 cc = (f32x2){c, c};
#pragma unroll
            for (int q = 0; q < 4; ++q) { acc[2 * q] = __builtin_amdgcn_cvt_pk_f32_fp8((int)v[q], false) * cc + acc[2 * q]; acc[2 * q + 1] = __builtin_amdgcn_cvt_pk_f32_fp8((int)v[q], true) * cc + acc[2 * q + 1]; }
        }
#pragma unroll
        for (int q = 0; q < 4; ++q) *(LAS f32x4*)(part + (wid * 64 + lane) * 16 + q * 4) = (f32x4){acc[2 * q][0], acc[2 * q][1], acc[2 * q + 1][0], acc[2 * q + 1][1]};
        __syncthreads();
        if (wid == 0) {
            float ss = 0.f; f32x4 x[4];
#pragma unroll
            for (int j = 0; j < 4; ++j) {
                x[j] = *(const f32x4*)(yr + lane * 16 + j * 4);
#pragma unroll
                for (int w8 = 0; w8 < 8; ++w8) x[j] += *(const LAS f32x4*)(part + (w8 * 64 + lane) * 16 + j * 4);
                ss += x[j][0] * x[j][0] + x[j][1] * x[j][1] + x[j][2] * x[j][2] + x[j][3] * x[j][3];
            }
            ss = wave_sum(ss, lane);
            const float rs = rsq(ss * (1.f / 1024.f) + EPS);
#pragma unroll
            for (int j = 0; j < 4; ++j) { const f32x4 g0 = *(const f32x4*)(p.g_final + lane * 16 + j * 4); *(f32x4*)(yr + lane * 16 + j * 4) = x[j] * rs * g0; }
        }
        __syncthreads();
    }
}

__device__ __forceinline__ void strip_mma(const bf16_t* A, int lda, const bf16_t* Bt, int ldb, int K, int c, int wid, int fr, int fq, f32x4 (&acc)[2]) {
#pragma unroll 2
    for (int ks = 0; ks < K / 32; ks += 4) {
        bf16x8 a[2][4], b[4];
#pragma unroll
        for (int u = 0; u < 4; ++u) {
            b[u] = *(const bf16x8*)(Bt + (size_t)(16 * c + fr) * ldb + (ks + u) * 32 + fq * 8);
#pragma unroll
            for (int i = 0; i < 2; ++i) a[i][u] = *(const bf16x8*)(A + (size_t)((2 * wid + i) * 16 + fr) * lda + (ks + u) * 32 + fq * 8);
        }
#pragma unroll
        for (int u = 0; u < 4; ++u)
#pragma unroll
            for (int i = 0; i < 2; ++i) acc[i] = MFMA16(a[i][u], b[u], acc[i]);
    }
}
__device__ __forceinline__ void sample_merge(const Ctx& cx, const Params& p) {
    unsigned char* ws = p.ws; const bf16_t* Zs = (const bf16_t*)(ws + OFF_Z) + (size_t)16384 * INC; bf16_t* M1 = (bf16_t*)(ws + OFF_M1) + (size_t)16384 * 1024;
    const int tid = cx.tid, wid = __builtin_amdgcn_readfirstlane(tid >> 6), lane = tid & 63, fr = lane & 15, fq = lane >> 4;
    for (int c = cx.bid; c < 64; c += cx.nb) {
        f32x4 aa[2] = {(f32x4){0.f, 0.f, 0.f, 0.f}, (f32x4){0.f, 0.f, 0.f, 0.f}}, ab[2] = {(f32x4){0.f, 0.f, 0.f, 0.f}, (f32x4){0.f, 0.f, 0.f, 0.f}};
        strip_mma(Zs, INC, (const bf16_t*)(ws + OFF_WA), 1024, 1024, c, wid, fr, fq, aa);
#pragma unroll 1
        for (int hh = 0; hh < 4; ++hh) {
            f32x4 ah[2] = {(f32x4){0.f, 0.f, 0.f, 0.f}, (f32x4){0.f, 0.f, 0.f, 0.f}};
            strip_mma(Zs + 4096 + hh * 512, INC, (const bf16_t*)(ws + OFF_WB) + hh * 512, 2048, 512, c, wid, fr, fq, ah);
#pragma unroll
            for (int i = 0; i < 2; ++i)
#pragma unroll
                for (int j = 0; j < 4; ++j) ab[i][j] += ah[i][j] * rsq(((const float*)(ws + OFF_SSO))[(size_t)(16384 + (2 * wid + i) * 16 + fq * 4 + j) * 4 + hh] * (1.f / 512.f) + EPS);
        }
#pragma unroll
        for (int i = 0; i < 2; ++i)
#pragma unroll
            for (int j = 0; j < 4; ++j) {
                const int row = (2 * wid + i) * 16 + fq * 4 + j, col = 16 * c + fr;
                const float ga = bf_lo((unsigned)Zs[(size_t)row * INC + 8192 + col]), gb = bf_lo((unsigned)Zs[(size_t)row * INC + 9216 + col]);
                M1[(size_t)row * 1024 + col] = f2bf(ga * aa[i][j] + gb * ab[i][j]);
            }
    }
}
__device__ __forceinline__ void sample_x2(const Ctx& cx, const Params& p) {
    unsigned char* ws = p.ws; bf16_t* X2b = (bf16_t*)(ws + OFF_X2B) + (size_t)16384 * 1024; float* ss2 = (float*)(ws + OFF_SS2) + 16384;
    const int tid = cx.tid, wid = __builtin_amdgcn_readfirstlane(tid >> 6), lane = tid & 63, fr = lane & 15, fq = lane >> 4;
    for (int c = cx.bid; c < 64; c += cx.nb) {
        f32x4 acc[2] = {(f32x4){0.f, 0.f, 0.f, 0.f}, (f32x4){0.f, 0.f, 0.f, 0.f}};
        strip_mma((const bf16_t*)(ws + OFF_M1) + (size_t)16384 * 1024, 1024, (const bf16_t*)(ws + OFF_WO), 1024, 1024, c, wid, fr, fq, acc);
#pragma unroll
        for (int i = 0; i < 2; ++i)
#pragma unroll
            for (int j = 0; j < 4; ++j) {
                const int row = (2 * wid + i) * 16 + fq * 4 + j, col = 16 * c + fr;
                const float v = p.xs[(size_t)row * 1024 + col] + acc[i][j];
                p.out[O_YS + (size_t)row * 1024 + col] = v; X2b[(size_t)row * 1024 + col] = f2bf(v);
                const float sq = row16_sum(v * v);
                if (fr == 0) atomicAdd(ss2 + row, sq);
            }
    }
}
__device__ __forceinline__ void sample_query(const Ctx& cx, const Params& p) {
    unsigned char* ws = p.ws; bf16_t* QP = (bf16_t*)(ws + OFF_QP) + (size_t)16384 * 2048; const float* ss2 = (const float*)(ws + OFF_SS2) + 16384;
    const int tid = cx.tid, wid = __builtin_amdgcn_readfirstlane(tid >> 6), lane = tid & 63, fr = lane & 15, fq = lane >> 4;
    for (int c = cx.bid; c < 128; c += cx.nb) {
        f32x4 acc[2] = {(f32x4){0.f, 0.f, 0.f, 0.f}, (f32x4){0.f, 0.f, 0.f, 0.f}};
        strip_mma((const bf16_t*)(ws + OFF_X2B) + (size_t)16384 * 1024, 1024, (const bf16_t*)(ws + OFF_WQ), 1024, 1024, c, wid, fr, fq, acc);
#pragma unroll
        for (int i = 0; i < 2; ++i)
#pragma unroll
            for (int j = 0; j < 4; ++j) {
                const int row = (2 * wid + i) * 16 + fq * 4 + j, col = 16 * c + fr;
                QP[(size_t)row * 2048 + col] = f2bf(acc[i][j] * rsq(ss2[row] * (1.f / 1024.f) + EPS));
            }
    }
}

__device__ __forceinline__ void run_phase(const Params& p, LAS unsigned char* lds, int ph, const Ctx& cx) {
    unsigned char* ws = p.ws; pg8::StaticOrder S; pg8::Gemm g;
    bf16_t* Z = (bf16_t*)(ws + OFF_Z); bf16_t* T1 = (bf16_t*)((unsigned char*)p.out + OUT_T1);
    if (ph == 0) { phase0(cx, p, lds); return; }
    if (ph >= 1 && ph <= 8) {
        const int hf = (ph - 1) >> 2, sub = (ph - 1) & 3, rowbase = hf ? NH0 : 0, nM = hf ? 64 : 65;
        if (sub == 0) {
            g.A = (const bf16_t*)((unsigned char*)p.out + OUT_XB) + (size_t)rowbase * 1024; g.Bt = (const bf16_t*)(ws + OFF_WIN); g.lda = 1024; g.ldb = 1024; g.K = 1024;
            S.init(nM, 40, cx.nb, cx.bid);
            EpiIn E{Z, (const float*)(ws + OFF_R1), (float*)(ws + OFF_SSV), p.b_gate, rowbase};
            pg8::gemm_phase(cx, lds, g, S, E);
        } else if (sub == 1) phase2(cx, p, lds, hf);
#ifdef DBG_SKIP_P3
        else if (sub == 2) { }
#else
        else if (sub == 2) { }
#endif
        else {
            S.init(64, 4, cx.nb, cx.bid);
            g.A = Z; g.Bt = (const bf16_t*)(ws + OFF_WA); g.lda = INC; g.ldb = 1024; g.K = 1024;
            EpiT1 E1{T1, Z}; pg8::gemm_phase(cx, lds, g, S, E1);
            g.A = Z + 4096; g.Bt = (const bf16_t*)(ws + OFF_WB); g.lda = INC; g.ldb = 2048; g.K = 2048;
            EpiM1 E2{T1, Z, (bf16_t*)(ws + OFF_M1), rowbase, (const float*)(ws + OFF_SSO)}; pg8::gemm_phase(cx, lds, g, S, E2);
            if (hf == 0) sample_merge(cx, p);
        }
        return;
    }
#ifdef DBG_YCONST
    if (ph >= 9 && ph <= 11) return;
#endif
    if (ph == 9) {
        g.A = (const bf16_t*)(ws + OFF_M1); g.Bt = (const bf16_t*)(ws + OFF_WO); g.lda = 1024; g.ldb = 1024; g.K = 1024;
        S.init(128, 4, cx.nb, cx.bid, 64);
        EpiX2 E{p.xp, p.xs, p.out, (bf16_t*)(ws + OFF_X2B), (float*)(ws + OFF_SS2)}; pg8::gemm_phase(cx, lds, g, S, E);
        sample_x2(cx, p); return;
    }
    if (ph == 10) {
        g.A = (const bf16_t*)(ws + OFF_X2B); g.Bt = (const bf16_t*)(ws + OFF_WQ); g.lda = 1024; g.ldb = 1024; g.K = 1024;
        S.init(128, 8, cx.nb, cx.bid, 64);
        EpiQP E{(bf16_t*)(ws + OFF_QP), (const float*)(ws + OFF_SS2)}; pg8::gemm_phase(cx, lds, g, S, E);
        sample_query(cx, p); return;
    }
    if (ph == 11) { phase7(cx, p, lds); return; }
    if (ph == 12) { phase8(cx, p, lds); return; }
}
constexpr int NPHASE = 13;

extern __shared__ __attribute__((aligned(16))) unsigned char dyn_smem[];

#if ONE_LAUNCH
__device__ __forceinline__ void grid_barrier(unsigned* ctr, unsigned target, int tid) {
    asm volatile("s_waitcnt vmcnt(0)" ::: "memory");
    __syncthreads();
    if (tid == 0) {
        __builtin_amdgcn_fence(__ATOMIC_RELEASE, "agent");
        asm volatile("s_waitcnt vmcnt(0)" ::: "memory");
        __hip_atomic_fetch_add(ctr, 1u, __ATOMIC_RELAXED, __HIP_MEMORY_SCOPE_AGENT);
        while (__hip_atomic_load(ctr, __ATOMIC_RELAXED, __HIP_MEMORY_SCOPE_AGENT) < target) __builtin_amdgcn_s_sleep(1);
        __builtin_amdgcn_fence(__ATOMIC_ACQUIRE, "agent");
        asm volatile("s_waitcnt vmcnt(0)" ::: "memory");
    }
    __syncthreads();
}
__global__ __launch_bounds__(512, 2) void mega_kernel(Params p) {
#if defined(__HIP_DEVICE_COMPILE__)
    LAS unsigned char* lds = (LAS unsigned char*)dyn_smem;
    cg::grid_group grid = cg::this_grid();
    const int wave0 = __builtin_amdgcn_readfirstlane((int)threadIdx.x >> 6);
    unsigned nbar = 0;
    { int never = 0; asm volatile("" : "+s"(never));
      if (never == 1000) grid.sync(); }
#pragma nounroll
    for (int ph = 0; ph < NPHASE; ++ph) {
        int phv = ph; asm volatile("" : "+s"(phv));
        int wv = wave0; asm volatile("" : "+s"(wv));
        int ln = (int)__builtin_amdgcn_mbcnt_hi(~0u, __builtin_amdgcn_mbcnt_lo(~0u, 0u)); asm volatile("" : "+v"(ln));
        Ctx cx; cx.tid = wv * 64 + ln; cx.bid = blockIdx.x; cx.nb = gridDim.x;
        asm volatile("" : "+s"(cx.bid)); asm volatile("" : "+s"(cx.nb));
        auto ka = __builtin_amdgcn_kernarg_segment_ptr(); asm volatile("" : "+s"(ka));
        const Params pl = *(const Params __attribute__((address_space(4)))*)(unsigned long long)ka;
        unsigned lo = 0; asm volatile("" : "+s"(lo));
        if (ph == 3 || ph == 7) continue;
        run_phase(pl, lds + lo, phv, cx);
        if (ph + 1 < NPHASE) { ++nbar; grid_barrier((unsigned*)(pl.ws + OFF_BAR), nbar * (unsigned)cx.nb, cx.tid); }
    }
#endif
}
#else
__global__ __launch_bounds__(512, 2) void stage_kernel(Params p, int ph) {
    LAS unsigned char* lds = (LAS unsigned char*)dyn_smem;
    Ctx cx; cx.tid = threadIdx.x; cx.bid = blockIdx.x; cx.nb = gridDim.x;
    run_phase(p, lds, ph, cx);
}
#endif

extern "C" void kernel_launch(void* const* d_in, const int* in_sizes, int n_in, void* d_out, int out_size, void* d_ws, size_t ws_size, hipStream_t stream) {
    Params p; memset(&p, 0, sizeof(p));
    p.xp = (const float*)d_in[0]; p.xs = (const float*)d_in[1]; p.state = (const float*)d_in[2]; p.w_in = (const float*)d_in[3]; p.w_s = (const float*)d_in[4];
    p.b_s = (const float*)d_in[5]; p.g_sgu = (const float*)d_in[6]; p.w_pa = (const float*)d_in[7]; p.w_pb = (const float*)d_in[8]; p.b_gate = (const float*)d_in[9];
    p.w_out = (const float*)d_in[10]; p.g_mix = (const float*)d_in[11]; p.g_ffn = (const float*)d_in[12]; p.w_q = (const float*)d_in[13]; p.k1 = (const float*)d_in[14];
    p.k2 = (const float*)d_in[15]; p.eu = (const float*)d_in[16]; p.ev = (const float*)d_in[17]; p.g_final = (const float*)d_in[18];
    p.out = (float*)d_out; p.ws = (unsigned char*)d_ws;
    if (ws_size < WS_NEED) { fprintf(stderr, "workspace too small: %zu < %zu\n", ws_size, (size_t)WS_NEED); return; }
#if ONE_LAUNCH
    static int grid_blocks = 0;
    if (!grid_blocks) {
        (void)hipFuncSetAttribute((const void*)mega_kernel, hipFuncAttributeMaxDynamicSharedMemorySize, LDS_BYTES);
        int dev = 0, cus = 0, per_cu = 0;
        hipGetDevice(&dev); hipDeviceGetAttribute(&cus, hipDeviceAttributeMultiprocessorCount, dev);
        hipOccupancyMaxActiveBlocksPerMultiprocessor(&per_cu, mega_kernel, 512, LDS_BYTES);
        if (per_cu < 1) per_cu = 1;
        grid_blocks = cus * 1;
    }
    (void)hipMemsetAsync((unsigned char*)d_ws + OFF_BAR, 0, 256, stream);
    void* args[] = {&p};
    hipError_t e = hipLaunchCooperativeKernel((const void*)mega_kernel, dim3(grid_blocks), dim3(512), args, LDS_BYTES, stream);
    if (e != hipSuccess) fprintf(stderr, "cooperative launch failed: %s (grid %d)\n", hipGetErrorString(e), grid_blocks);
#else
    static bool attr = false;
    if (!attr) { (void)hipFuncSetAttribute((const void*)stage_kernel, hipFuncAttributeMaxDynamicSharedMemorySize, LDS_BYTES); attr = true; }
    for (int ph = 0; ph < NPHASE; ++ph) hipLaunchKernelGGL(stage_kernel, dim3(256), dim3(512), LDS_BYTES, stream, p, ph);
#endif
}
```
